# Optimizing an MI355X kernel written in HIP

```python
import jax, jax.numpy as jnp
from jax import lax
import numpy as np

D_MODEL = 1024
BATCH = 8
SEQ = 4096
DEPTH = 4

F_WIDTH = D_MODEL
F_GROUP_DIM = 128
F_GROUPS = F_WIDTH // F_GROUP_DIM
RET_HEADS = 4
RET_DK = D_MODEL // RET_HEADS
RET_DV = D_MODEL // RET_HEADS
RET_QK = RET_HEADS * RET_DK
RET_V = RET_HEADS * RET_DV
CHUNK = 128
ROPE_BASE = 10000.0
DECAY_OFFSET_FWD = 0.0
DECAY_OFFSET_BWD = 0.5
D_FF = 2816
CONV_WIDTH = 3
N_MOD = 6
EPS = 1e-6
IN_SIZES = (F_WIDTH, RET_QK, RET_QK, RET_V, RET_V, D_MODEL, D_MODEL)
D_IN = F_WIDTH + 2 * RET_QK + 2 * RET_V + 2 * D_MODEL

kernel_name = 'hybrid_fourier_retention_convffn_encoder'


def rmsnorm(x, g):
    xf = x.astype(jnp.float32)
    y = xf * lax.rsqrt(jnp.mean(xf * xf, axis=-1, keepdims=True) + EPS)
    return (y * g.astype(jnp.float32)).astype(x.dtype)


def decay_logs(offset):
    expo = -(5.0 + offset) - jnp.arange(RET_HEADS, dtype=jnp.float32)
    return jnp.log1p(-jnp.exp2(expo))


def fourier_mix(u):
    B, S, _ = u.shape
    ug = u.astype(jnp.float32).reshape(B, S, F_GROUPS, F_GROUP_DIM)
    y = jnp.fft.fft2(ug, axes=(1, 3), norm='ortho').real
    return y.reshape(B, S, F_WIDTH).astype(u.dtype)


def rotary(t):
    S = t.shape[1]
    half = t.shape[-1] // 2
    inv_freq = ROPE_BASE ** (-jnp.arange(half, dtype=jnp.float32) / half)
    ang = jnp.arange(S, dtype=jnp.float32)[:, None] * inv_freq[None, :]
    cos = jnp.cos(ang)[None, :, None, :]
    sin = jnp.sin(ang)[None, :, None, :]
    t1, t2 = t[..., :half], t[..., half:]
    return jnp.concatenate([t1 * cos - t2 * sin, t1 * sin + t2 * cos], axis=-1)


def chunk_retention(q, k, v, log_gamma, strict):
    B, H, S, dk = q.shape
    dv = v.shape[-1]
    n_chunks = S // CHUNK
    qc = q.reshape(B, H, n_chunks, CHUNK, dk)
    kc = k.reshape(B, H, n_chunks, CHUNK, dk)
    vc = v.reshape(B, H, n_chunks, CHUNK, dv)
    j = jnp.arange(CHUNK, dtype=jnp.float32)
    diff = j[:, None] - j[None, :]
    keep = (diff > 0) if strict else (diff >= 0)
    dmask = jnp.where(keep[None], jnp.exp(log_gamma[:, None, None] * jnp.maximum(diff, 0.0)[None]), 0.0)
    scores = jnp.einsum('bhncd,bhnld->bhncl', qc, kc) * dmask[None, :, None]
    intra = jnp.einsum('bhncl,bhnle->bhnce', scores, vc)
    q_decay = jnp.exp(log_gamma[:, None] * (j + 1.0))[None, :, :, None]
    k_decay = jnp.exp(log_gamma[:, None] * (CHUNK - 1.0 - j))[None, :, :, None]
    chunk_decay = jnp.exp(log_gamma * CHUNK)[None, :, None, None]

    def step(state, xs):
        qi, ki, vi = xs
        cross = jnp.einsum('bhcd,bhde->bhce', qi, state) * q_decay
        state = state * chunk_decay + jnp.einsum('bhcd,bhce->bhde', ki * k_decay, vi)
        return state, cross

    state0 = jnp.zeros((B, H, dk, dv), jnp.float32)
    xs = (jnp.moveaxis(qc, 2, 0), jnp.moveaxis(kc, 2, 0), jnp.moveaxis(vc, 2, 0))
    _, cross = lax.scan(step, state0, xs)
    out = intra + jnp.moveaxis(cross, 0, 2)
    return out.reshape(B, H, S, dv)


def retention_branch(q, k, v, g):
    B, S, _ = q.shape
    dt = q.dtype
    qh = rotary(q.astype(jnp.float32).reshape(B, S, RET_HEADS, RET_DK)) * (RET_DK ** -0.5)
    kh = rotary(k.astype(jnp.float32).reshape(B, S, RET_HEADS, RET_DK))
    vh = v.astype(jnp.float32).reshape(B, S, RET_HEADS, RET_DV)
    qh = jnp.transpose(qh, (0, 2, 1, 3))
    kh = jnp.transpose(kh, (0, 2, 1, 3))
    vh = jnp.transpose(vh, (0, 2, 1, 3))
    fwd = chunk_retention(qh, kh, vh, decay_logs(DECAY_OFFSET_FWD), strict=False)
    bwd = jnp.flip(chunk_retention(jnp.flip(qh, axis=2), jnp.flip(kh, axis=2), jnp.flip(vh, axis=2),
                                   decay_logs(DECAY_OFFSET_BWD), strict=True), axis=2)
    y = jnp.transpose(fwd + bwd, (0, 2, 1, 3))
    mu = jnp.mean(y, axis=-1, keepdims=True)
    var = jnp.mean(jnp.square(y - mu), axis=-1, keepdims=True)
    y = (y - mu) * lax.rsqrt(var + EPS)
    y = y.reshape(B, S, RET_V) * jax.nn.silu(g.astype(jnp.float32))
    return y.astype(dt)


def token_mix(h, w_in, w_fourier, w_ret, w_out):
    proj = h @ w_in
    offsets = np.cumsum(IN_SIZES)[:-1].tolist()
    u_f, q, k, v, g, a_f, a_r = jnp.split(proj, offsets, axis=-1)
    y_f = fourier_mix(u_f) @ w_fourier
    y_r = retention_branch(q, k, v, g) @ w_ret
    merged = jax.nn.sigmoid(a_f) * y_f + jax.nn.sigmoid(a_r) * y_r
    return merged @ w_out


def conv_ffn(h, w_up, conv_w, conv_b, w_down):
    S = h.shape[1]
    u = h @ w_up
    pad = CONV_WIDTH // 2
    up = jnp.pad(u, ((0, 0), (pad, pad), (0, 0)))
    u = sum(up[:, i:i + S] * conv_w[i] for i in range(CONV_WIDTH)) + conv_b
    a, b = jnp.split(u, 2, axis=-1)
    return (jax.nn.gelu(a, approximate=False) * b) @ w_down


def setup_inputs(seed: int = 0) -> dict:
    key = jax.random.key(seed)
    ks = jax.random.split(key, 15)

    def nrm(k, shape, scale):
        return jax.random.normal(k, shape, jnp.float32) * scale

    return {
        'x': nrm(ks[0], (BATCH, SEQ, D_MODEL), 1.0),
        'c': nrm(ks[1], (BATCH, D_MODEL), 1.0),
        'norm1_g': 1.0 + nrm(ks[2], (DEPTH, D_MODEL), 0.02),
        'norm2_g': 1.0 + nrm(ks[3], (DEPTH, D_MODEL), 0.02),
        'ada_w': nrm(ks[4], (DEPTH, D_MODEL, N_MOD * D_MODEL), 0.5 * D_MODEL ** -0.5),
        'ada_b': nrm(ks[5], (DEPTH, N_MOD * D_MODEL), 0.02),
        'w_in': nrm(ks[6], (DEPTH, D_MODEL, D_IN), D_MODEL ** -0.5),
        'w_fourier': nrm(ks[7], (DEPTH, F_WIDTH, D_MODEL), F_WIDTH ** -0.5),
        'w_ret': nrm(ks[8], (DEPTH, RET_V, D_MODEL), RET_V ** -0.5),
        'w_out': nrm(ks[9], (DEPTH, D_MODEL, D_MODEL), D_MODEL ** -0.5),
        'ffn_up': nrm(ks[10], (DEPTH, D_MODEL, 2 * D_FF), D_MODEL ** -0.5),
        'conv_w': nrm(ks[11], (DEPTH, CONV_WIDTH, 2 * D_FF), CONV_WIDTH ** -0.5),
        'conv_b': nrm(ks[12], (DEPTH, 2 * D_FF), 0.02),
        'ffn_down': nrm(ks[13], (DEPTH, D_FF, D_MODEL), D_FF ** -0.5),
        'final_g': 1.0 + nrm(ks[14], (D_MODEL,), 0.02),
    }


def reference(x, c, norm1_g, norm2_g, ada_w, ada_b, w_in, w_fourier, w_ret, w_out,
              ffn_up, conv_w, conv_b, ffn_down, final_g):
    c_act = jax.nn.silu(c)
    for l in range(DEPTH):
        mod = (c_act @ ada_w[l] + ada_b[l])[:, None, :]
        sh1, sc1, g1, sh2, sc2, g2 = jnp.split(mod, N_MOD, axis=-1)
        h = rmsnorm(x, norm1_g[l]) * (1.0 + sc1) + sh1
        x = x + g1 * token_mix(h, w_in[l], w_fourier[l], w_ret[l], w_out[l])
        h = rmsnorm(x, norm2_g[l]) * (1.0 + sc2) + sh2
        x = x + g2 * conv_ffn(h, ffn_up[l], conv_w[l], conv_b[l], ffn_down[l])
    return rmsnorm(x, final_g)
```

```cpp
#include <hip/hip_runtime.h>
#include <hip/hip_cooperative_groups.h>
#include <cstdio>
#include <cstdint>
#include <cmath>
namespace cg = cooperative_groups;

#ifndef MULTI_LAUNCH
#define MULTI_LAUNCH 0
#endif

#define DI __device__ __forceinline__
#define LAS __attribute__((address_space(3)))
typedef _Float16 h16;
typedef h16 h16x2 __attribute__((ext_vector_type(2)));
typedef h16 h16x4 __attribute__((ext_vector_type(4)));
typedef h16 h16x8 __attribute__((ext_vector_type(8)));
typedef float f32x2 __attribute__((ext_vector_type(2)));
typedef float f32x4 __attribute__((ext_vector_type(4)));
typedef unsigned u32x2 __attribute__((ext_vector_type(2)));
typedef unsigned u32x4 __attribute__((ext_vector_type(4)));

constexpr int MTOK = 32768, DM = 1024, SEQ = 4096, NLAYER = 4, DFF = 2816, DIN = 7168;
constexpr float EPS = 1e-6f;

DI int ltid() { int t = threadIdx.x; asm volatile("" : "+v"(t)); return t; }
DI unsigned pkh(float lo, float hi) { h16x2 v = {(h16)lo, (h16)hi}; return __builtin_bit_cast(unsigned, v); }
DI f32x2 unpkh(unsigned u) { h16x2 v = __builtin_bit_cast(h16x2, u); return (f32x2){(float)v.x, (float)v.y}; }
DI float wave_sum(float v) {
#pragma unroll
    for (int o = 1; o < 64; o <<= 1) v += __shfl_xor(v, o);
    return v;
}
DI float sigmoidf_(float x) { return 1.0f / (1.0f + __expf(-x)); }

namespace pg8 {
#define PG8_LAS __attribute__((address_space(3)))
typedef h16 bf16_t;
typedef h16x8 bf16x8;
constexpr int BM = 256, BK = 64, HALF = 128, HTB = HALF * BK * 2, STAGE_BYTES = 8 * HTB, NXCD = 8, WGM = 8;
__host__ __device__ __forceinline__ int lds_byte(int r, int c) { const int st = (r >> 4) * 2 + (c >> 5), rr = r & 15, cc = c & 31, ob = rr * 64 + cc * 2; return st * 1024 + (ob ^ (((ob >> 9) & 1) << 5)); }
__host__ __device__ __forceinline__ void stage_rc(int b, int& R, int& C) { const int st = b / 1024, sb = b % 1024, swz = sb ^ (((sb >> 9) & 1) << 5); R = (st >> 1) * 16 + swz / 64; C = (st & 1) * 32 + (swz % 64) / 2; }
__host__ __device__ __forceinline__ int perm32(int rho) { const int n = rho >> 4, i = rho & 15; return 8 * (i >> 2) + 4 * n + (i & 3); }
struct Unit { int pm, pn; };
struct Gemm { const bf16_t* A; const bf16_t* Bt; int M, N, K; };
struct StaticOrder {
    int nM, nN, nwg, G, c;
    __host__ __device__ void init(int M, int N, int G_, int c_) { nM = M / BM; nN = N / BM; nwg = nM * nN; G = G_; c = c_; }
    __host__ __device__ bool next(int i, Unit& u) const {
        const long L = (long)i * G + c; if (L >= nwg) return false;
        int wgid = (int)L; { const int q = nwg / NXCD, r = nwg % NXCD, xcd = wgid % NXCD, off = wgid / NXCD; wgid = (xcd < r ? xcd * (q + 1) : r * (q + 1) + (xcd - r) * q) + off; }
        const int nig = WGM * nN, gid = wgid / nig, fm = gid * WGM, gsz = (nM - fm) < WGM ? (nM - fm) : WGM;
        u.pm = fm + ((wgid % nig) % gsz); u.pn = (wgid % nig) / gsz; return true;
    }
    __device__ __forceinline__ void a_ready(const Unit&) const {}
    __device__ __forceinline__ void done(const Unit&) const {}
};
template <class Epi, class Sched, bool STAMP = false>
__device__ __forceinline__ void gemm_phase(PG8_LAS unsigned char* lds, const Gemm g, const Sched& S, const Epi& E, unsigned long long* stamps) {
    const int tid = ltid(), wid = __builtin_amdgcn_readfirstlane(tid >> 6), lane = tid & 63, wr = wid >> 2, wc = wid & 3, fr = lane & 15, fq = lane >> 4;
    const int K = g.K, nt = K / BK;
    int ts_lo = 0, ts_hi = 0, nts = 0; const unsigned long long rt_entry = STAMP ? (unsigned long long)wall_clock64() : 0ull;
#define PG8_STAMP() do { if (STAMP && wid == 0 && nts < 64) { const unsigned long long _c = (unsigned long long)clock64(); \
        ts_lo = (lane == nts) ? (int)(unsigned)_c : ts_lo; ts_hi = (lane == nts) ? (int)(unsigned)(_c >> 32) : ts_hi; ++nts; } } while (0)
    PG8_STAMP();
    unsigned voffA[2], voffB[2];
#pragma unroll
    for (int i = 0; i < 2; ++i) { int R, C; stage_rc(tid * 16 + i * 8192, R, C); const int Rb = Epi::PERM ? ((R & ~31) + perm32(R & 31)) : R;
        voffA[i] = (unsigned)(R * K + C) * 2u; voffB[i] = (unsigned)(Rb * K + C) * 2u; }
    const size_t kstep = (size_t)(BK * 2);
    const size_t hstep = (size_t)HALF * K * 2;
    const size_t tstep = 2 * hstep;
    const unsigned ldsw = (unsigned)wid * 1024u;
    const int aoff = lds_byte(wr * 64 + fr, fq * 8), boff = lds_byte(wc * 32 + fr, fq * 8);
#define PG8_SA(b, h) (((b) * 2 + (h)) * HTB)
#define PG8_SB(b, h) ((4 + (b) * 2 + (h)) * HTB)
#define PG8_STAGE(bufoff, gbase, voff) do { _Pragma("unroll") for (int _i = 0; _i < 2; ++_i) \
        __builtin_amdgcn_global_load_lds((const unsigned*)((const char*)(gbase) + (voff)[_i]), (PG8_LAS unsigned*)(lds + (bufoff) + ldsw + _i * 8192), 16, 0, 0); } while (0)
#define PG8_LDA(dst, b, h) do { _Pragma("unroll") for (int m = 0; m < 4; ++m) _Pragma("unroll") for (int k = 0; k < 2; ++k) dst[m][k] = *(const PG8_LAS bf16x8*)(lds + PG8_SA(b, h) + aoff + m * 2048 + k * 1024); } while (0)
#define PG8_LDB(dst, b, h) do { _Pragma("unroll") for (int n = 0; n < 2; ++n) _Pragma("unroll") for (int k = 0; k < 2; ++k) dst[n][k] = *(const PG8_LAS bf16x8*)(lds + PG8_SB(b, h) + boff + n * 2048 + k * 1024); } while (0)
#define PG8_MMA(ai, bj, At, Bt) do { __builtin_amdgcn_s_setprio(1); _Pragma("unroll") for (int m = 0; m < 4; ++m) _Pragma("unroll") for (int n = 0; n < 2; ++n) _Pragma("unroll") for (int k = 0; k < 2; ++k) \
        acc[ai][bj][m][n] = __builtin_amdgcn_mfma_f32_16x16x32_f16(Bt[n][k], At[m][k], acc[ai][bj][m][n], 0, 0, 0); __builtin_amdgcn_s_setprio(0); } while (0)
#define PG8_WAIT_V(n) asm volatile("s_waitcnt vmcnt(" #n ")" ::: "memory")
#define PG8_WAIT_L(n) asm volatile("s_waitcnt lgkmcnt(" #n ")" ::: "memory")
#define PG8_BAR __builtin_amdgcn_s_barrier()
#define PG8_SCHED __builtin_amdgcn_sched_barrier(0)
    Unit cur, nxt; int ui = 0;
    if (!S.next(0, cur)) return;
    f32x4 acc[2][2][4][2];
#pragma unroll
    for (int a = 0; a < 2; ++a)
#pragma unroll
        for (int b = 0; b < 2; ++b)
#pragma unroll
            for (int m = 0; m < 4; ++m)
#pragma unroll
                for (int n = 0; n < 2; ++n) acc[a][b][m][n] = (f32x4){0.f, 0.f, 0.f, 0.f};
    bf16x8 At[4][2], B0[2][2], B1[2][2];
    const char* cA = (const char*)g.A + (size_t)cur.pm * tstep; const char* cB = (const char*)g.Bt + (size_t)cur.pn * tstep;
    S.a_ready(cur);
    PG8_STAGE(PG8_SB(0, 0), cB, voffB); PG8_STAGE(PG8_SA(0, 0), cA, voffA); PG8_STAGE(PG8_SB(0, 1), cB + hstep, voffB); PG8_STAGE(PG8_SA(0, 1), cA + hstep, voffA);
    if (wr == 1) PG8_BAR;
    PG8_WAIT_V(4); PG8_BAR;
    PG8_STAGE(PG8_SB(1, 0), cB + kstep, voffB); PG8_STAGE(PG8_SA(1, 0), cA + kstep, voffA); PG8_STAGE(PG8_SB(1, 1), cB + hstep + kstep, voffB);
    PG8_WAIT_V(6); PG8_BAR;
    PG8_STAMP();
    for (;;) {
        const bool has_next = S.next(ui + 1, nxt);
        const char* nA = has_next ? (const char*)g.A + (size_t)nxt.pm * tstep : cA; const char* nB = has_next ? (const char*)g.Bt + (size_t)nxt.pn * tstep : cB;
        for (int t = 0; t < nt; t += 2) {
            const bool last = (t == nt - 2);
            const char* a1 = cA + (size_t)(t + 1) * kstep;
            const char* a2 = last ? nA : cA + (size_t)(t + 2) * kstep; const char* b2 = last ? nB : cB + (size_t)(t + 2) * kstep;
            const char* a3 = a2 + kstep; const char* b3 = b2 + kstep;
            if (last && has_next) S.a_ready(nxt);
            PG8_LDB(B0, 0, 0); PG8_SCHED; PG8_LDA(At, 0, 0); PG8_STAGE(PG8_SA(1, 1), a1 + hstep, voffA);
            PG8_WAIT_L(8); PG8_BAR; PG8_WAIT_L(0); PG8_MMA(0, 0, At, B0); PG8_BAR; PG8_SCHED;
            PG8_LDB(B1, 0, 1); PG8_STAGE(PG8_SB(0, 0), b2, voffB);
            PG8_BAR; PG8_WAIT_L(0); PG8_MMA(0, 1, At, B1); PG8_BAR;
            PG8_LDA(At, 0, 1); PG8_STAGE(PG8_SA(0, 0), a2, voffA);
            PG8_BAR; PG8_WAIT_L(0); PG8_MMA(1, 0, At, B0); PG8_BAR; PG8_SCHED;
            PG8_STAGE(PG8_SB(0, 1), b2 + hstep, voffB);
            PG8_WAIT_V(6); PG8_BAR; PG8_MMA(1, 1, At, B1); PG8_BAR;
            PG8_LDB(B0, 1, 0); PG8_SCHED; PG8_LDA(At, 1, 0); PG8_STAGE(PG8_SA(0, 1), a2 + hstep, voffA);
            PG8_WAIT_L(8); PG8_BAR; PG8_WAIT_L(0); PG8_MMA(0, 0, At, B0); PG8_BAR; PG8_SCHED;
            PG8_LDB(B1, 1, 1); PG8_STAGE(PG8_SB(1, 0), b3, voffB);
            PG8_BAR; PG8_WAIT_L(0); PG8_MMA(0, 1, At, B1); PG8_BAR;
            PG8_LDA(At, 1, 1); PG8_STAGE(PG8_SA(1, 0), a3, voffA);
            PG8_BAR; PG8_WAIT_L(0); PG8_MMA(1, 0, At, B0); PG8_BAR; PG8_SCHED;
            PG8_STAGE(PG8_SB(1, 1), b3 + hstep, voffB);
            PG8_WAIT_V(6); PG8_BAR; PG8_MMA(1, 1, At, B1); PG8_BAR;
        }
        PG8_STAMP();
        if constexpr (!Epi::AFTER_DRAIN) { E(acc, cur, wr, wc, fr, fq); S.done(cur); }
        PG8_STAMP();
        if (!has_next) break;
#pragma unroll
        for (int a = 0; a < 2; ++a)
#pragma unroll
            for (int b = 0; b < 2; ++b)
#pragma unroll
                for (int m = 0; m < 4; ++m)
#pragma unroll
                    for (int n = 0; n < 2; ++n) acc[a][b][m][n] = (f32x4){0.f, 0.f, 0.f, 0.f};
        cur = nxt; cA = nA; cB = nB; ++ui;
    }
    PG8_WAIT_V(0);
    if (wr == 0) PG8_BAR;
    PG8_BAR;
    if constexpr (Epi::AFTER_DRAIN) { E.fused(acc, cur, wr, wc, fr, fq, lds, wid, lane); S.done(cur); }
    PG8_STAMP();
    if (STAMP && wid == 0) { stamps[lane] = lane < nts ? (((unsigned long long)(unsigned)ts_hi << 32) | (unsigned)ts_lo) : 0ull;
        if (lane == 62) stamps[62] = rt_entry; if (lane == 63) stamps[63] = (unsigned long long)wall_clock64(); }
#undef PG8_STAMP
#undef PG8_SA
#undef PG8_SB
#undef PG8_STAGE
#undef PG8_LDA
#undef PG8_LDB
#undef PG8_MMA
#undef PG8_WAIT_V
#undef PG8_WAIT_L
#undef PG8_BAR
#undef PG8_SCHED
}
}
using pg8::Unit;

constexpr size_t OFF_MOD = 0;
constexpr size_t OFF_COS = 786432;
constexpr size_t OFF_SIN = OFF_COS + 2097152;
constexpr size_t OFF_W   = OFF_SIN + 2097152;
constexpr size_t W_QKV = 0, W_B = W_QKV + 3072 * 1024, W_F2 = W_B + 4096 * 1024, W_R = W_F2 + 1024 * 2048, W_O = W_R + 1024 * 1024, W_UP = W_O + 1024 * 1024, W_DN = W_UP + 5632 * 1024, W_END = W_DN + 1024 * 2816;
constexpr size_t OFF_H  = OFF_W + W_END * 2;
constexpr size_t ACT = (size_t)MTOK * DM * 2;
constexpr size_t OFF_RA = OFF_H + ACT;
constexpr size_t OFF_RB = OFF_RA + ACT;
constexpr size_t OFF_RC = OFF_RB + ACT;
constexpr size_t OFF_RD = OFF_RC + ACT;
constexpr size_t OFF_RE = OFF_RD + 2 * ACT;
constexpr size_t WS_END = OFF_RE + ACT;

DI u32x4 pack8(const f32x4& a, const f32x4& b) { u32x4 w; w.x = pkh(a[0], a[1]); w.y = pkh(a[2], a[3]); w.z = pkh(b[0], b[1]); w.w = pkh(b[2], b[3]); return w; }

struct EpiQKV {
    static constexpr bool PERM = true, AFTER_DRAIN = false;
    h16 *Q; const float *cosT, *sinT;
    DI void operator()(const f32x4 (&acc)[2][2][4][2], const Unit& u, int wr, int wc, int fr, int fq) const {
        const int sec = u.pn >> 2, head = u.pn & 3, colh = wc * 32 + 8 * fq;
        h16* base = Q + (size_t)sec * ((size_t)MTOK * DM);
        const float scl = sec == 0 ? 0.0625f : 1.0f;
#pragma unroll
        for (int ai = 0; ai < 2; ++ai)
#pragma unroll
            for (int m = 0; m < 4; ++m) {
                __builtin_amdgcn_sched_barrier(0);
                const int row = u.pm * 256 + ai * 128 + wr * 64 + m * 16 + fr;
                h16* rowp = base + (size_t)row * DM + head * 256 + colh;
                if (sec == 2) {
                    *(u32x4*)(rowp) = pack8(acc[ai][0][m][0], acc[ai][0][m][1]);
                    *(u32x4*)(rowp + 128) = pack8(acc[ai][1][m][0], acc[ai][1][m][1]);
                } else {
                    const int pos = row & (SEQ - 1);
                    f32x4 o1[2], o2[2];
#pragma unroll
                    for (int n = 0; n < 2; ++n) {
                        const f32x4 c = *(const f32x4*)(cosT + pos * 128 + colh + 4 * n), s = *(const f32x4*)(sinT + pos * 128 + colh + 4 * n);
                        const f32x4 t1 = acc[ai][0][m][n], t2 = acc[ai][1][m][n];
                        o1[n] = (t1 * c - t2 * s) * scl; o2[n] = (t1 * s + t2 * c) * scl;
                    }
                    *(u32x4*)(rowp) = pack8(o1[0], o1[1]);
                    *(u32x4*)(rowp + 128) = pack8(o2[0], o2[1]);
                }
            }
    }
};
struct EpiB {
    static constexpr bool PERM = true, AFTER_DRAIN = false;
    unsigned char* ws;
    DI void operator()(const f32x4 (&acc)[2][2][4][2], const Unit& u, int wr, int wc, int fr, int fq) const {
        const int sec = u.pn >> 2, cs = (u.pn & 3) * 256 + wc * 32 + 8 * fq;
        const size_t boff = sec == 0 ? OFF_RC : (sec == 1 ? OFF_RE : (sec == 2 ? OFF_RA : OFF_RB));
        h16* base = (h16*)(ws + boff);
#pragma unroll
        for (int ai = 0; ai < 2; ++ai)
#pragma unroll
            for (int m = 0; m < 4; ++m) {
                __builtin_amdgcn_sched_barrier(0);
                const int row = u.pm * 256 + ai * 128 + wr * 64 + m * 16 + fr;
#pragma unroll
                for (int bj = 0; bj < 2; ++bj) {
                    h16* p = base + (size_t)row * DM + cs + bj * 128;
                    f32x4 v0 = acc[ai][bj][m][0], v1 = acc[ai][bj][m][1];
                    if (sec == 1) {
                        const u32x4 y = *(const u32x4*)p;
#pragma unroll
                        for (int e = 0; e < 2; ++e) {
                            const f32x2 ya = unpkh(y[e]), yb = unpkh(y[2 + e]);
                            v0[2 * e] = ya.x * v0[2 * e] * sigmoidf_(v0[2 * e]); v0[2 * e + 1] = ya.y * v0[2 * e + 1] * sigmoidf_(v0[2 * e + 1]);
                            v1[2 * e] = yb.x * v1[2 * e] * sigmoidf_(v1[2 * e]); v1[2 * e + 1] = yb.y * v1[2 * e + 1] * sigmoidf_(v1[2 * e + 1]);
                        }
                    } else if (sec >= 2) {
#pragma unroll
                        for (int e = 0; e < 4; ++e) { v0[e] = sigmoidf_(v0[e]); v1[e] = sigmoidf_(v1[e]); }
                    }
                    *(u32x4*)p = pack8(v0, v1);
                }
            }
    }
};
template <int MODE> struct EpiMerge {
    static constexpr bool PERM = true, AFTER_DRAIN = false;
    h16* T; const h16* G;
    DI void operator()(const f32x4 (&acc)[2][2][4][2], const Unit& u, int wr, int wc, int fr, int fq) const {
        const int cs = u.pn * 256 + wc * 32 + 8 * fq;
#pragma unroll
        for (int ai = 0; ai < 2; ++ai)
#pragma unroll
            for (int m = 0; m < 4; ++m) {
                __builtin_amdgcn_sched_barrier(0);
                const int row = u.pm * 256 + ai * 128 + wr * 64 + m * 16 + fr;
#pragma unroll
                for (int bj = 0; bj < 2; ++bj) {
                    const size_t o = (size_t)row * DM + cs + bj * 128;
                    const u32x4 g = *(const u32x4*)(G + o);
                    f32x4 v0 = acc[ai][bj][m][0], v1 = acc[ai][bj][m][1];
                    u32x4 t = {0u, 0u, 0u, 0u};
                    if (MODE == 1) t = *(const u32x4*)(T + o);
#pragma unroll
                    for (int e = 0; e < 2; ++e) {
                        const f32x2 ga = unpkh(g[e]), gb = unpkh(g[2 + e]);
                        v0[2 * e] *= ga.x; v0[2 * e + 1] *= ga.y; v1[2 * e] *= gb.x; v1[2 * e + 1] *= gb.y;
                        if (MODE == 1) { const f32x2 ta = unpkh(t[e]), tb = unpkh(t[2 + e]); v0[2 * e] += ta.x; v0[2 * e + 1] += ta.y; v1[2 * e] += tb.x; v1[2 * e + 1] += tb.y; }
                    }
                    *(u32x4*)(T + o) = pack8(v0, v1);
                }
            }
    }
};
struct EpiRes {
    static constexpr bool PERM = false, AFTER_DRAIN = false;
    const float* xi; float* xo; const float* gate; int rowoff;
    DI void operator()(const f32x4 (&acc)[2][2][4][2], const Unit& u, int wr, int wc, int fr, int fq) const {
        const int c0 = u.pn * 256 + wc * 32 + 4 * fq;
#pragma unroll
        for (int ai = 0; ai < 2; ++ai)
#pragma unroll
            for (int m = 0; m < 4; ++m) {
                __builtin_amdgcn_sched_barrier(0);
                const int row = rowoff + u.pm * 256 + ai * 128 + wr * 64 + m * 16 + fr;
                const float* gp = gate + (size_t)(row >> 12) * 6144;
#pragma unroll
                for (int bj = 0; bj < 2; ++bj)
#pragma unroll
                    for (int n = 0; n < 2; ++n) {
                        const int col = c0 + bj * 128 + n * 16;
                        const f32x4 gv = *(const f32x4*)(gp + col), xv = *(const f32x4*)(xi + (size_t)row * DM + col);
                        *(f32x4*)(xo + (size_t)row * DM + col) = xv + gv * acc[ai][bj][m][n];
                    }
            }
    }
};
struct EpiStore {
    static constexpr bool PERM = true, AFTER_DRAIN = false;
    h16* O; int ldc;
    DI void operator()(const f32x4 (&acc)[2][2][4][2], const Unit& u, int wr, int wc, int fr, int fq) const {
        const int cs = u.pn * 256 + wc * 32 + 8 * fq;
#pragma unroll
        for (int ai = 0; ai < 2; ++ai)
#pragma unroll
            for (int m = 0; m < 4; ++m) {
                __builtin_amdgcn_sched_barrier(0);
                const int row = u.pm * 256 + ai * 128 + wr * 64 + m * 16 + fr;
#pragma unroll
                for (int bj = 0; bj < 2; ++bj) *(u32x4*)(O + (size_t)row * ldc + cs + bj * 128) = pack8(acc[ai][bj][m][0], acc[ai][bj][m][1]);
            }
    }
};


struct Params {
    const float *x, *c, *n1g, *n2g, *ada_w, *ada_b, *w_in, *w_f, *w_r, *w_o, *w_up, *conv_w, *conv_b, *w_dn, *fin_g;
    float* out; unsigned char* ws;
    float lgf[4], lgb[4];
    int ph0, ph1;
};

constexpr int LDS_BYTES = 160 * 1024;
constexpr int NTHR = 512;

DI void phase_prep(const Params& p, LAS unsigned char* lds) {
    const int tid = ltid();
    LAS float* cact = (LAS float*)lds;
    LAS float* red = (LAS float*)(lds + 32768);
    for (int i = tid; i < 8 * 1024; i += NTHR) { const float v = p.c[i]; cact[i] = v / (1.0f + __expf(-v)); }
    __syncthreads();
    float* MOD = (float*)(p.ws + OFF_MOD);
    for (int it = blockIdx.x; it < 256; it += gridDim.x) {
        const int l = it >> 6, j0 = (it & 63) * 96;
        if (tid < 480) {
            const int col = tid % 96, part = tid / 96, d0 = part * 205, d1 = (d0 + 205 < 1024) ? d0 + 205 : 1024;
            float a[8];
#pragma unroll
            for (int b = 0; b < 8; ++b) a[b] = 0.f;
            const float* wp = p.ada_w + ((size_t)l * 1024) * 6144 + j0 + col;
            for (int d = d0; d < d1; ++d) {
                const float w = wp[(size_t)d * 6144];
#pragma unroll
                for (int b = 0; b < 8; ++b) a[b] += cact[b * 1024 + d] * w;
            }
#pragma unroll
            for (int b = 0; b < 8; ++b) red[(part * 8 + b) * 96 + col] = a[b];
        }
        __syncthreads();
        for (int i = tid; i < 768; i += NTHR) {
            const int b = i / 96, col = i % 96;
            float s = p.ada_b[l * 6144 + j0 + col];
#pragma unroll
            for (int part = 0; part < 5; ++part) s += red[(part * 8 + b) * 96 + col];
            MOD[((size_t)l * 8 + b) * 6144 + j0 + col] = s;
        }
        __syncthreads();
    }
    float* cosT = (float*)(p.ws + OFF_COS); float* sinT = (float*)(p.ws + OFF_SIN);
    for (int i = blockIdx.x * NTHR + tid; i < SEQ * 128; i += gridDim.x * NTHR) {
        const int pos = i >> 7, j = i & 127;
        const float invf = exp2f(-(float)j * (13.287712379549449f / 128.0f));
        const float ang = (float)pos * invf;
        const double rev = (double)ang * 0.15915494309189535;
        const float fr = (float)(rev - floor(rev));
        cosT[i] = __builtin_amdgcn_cosf(fr); sinT[i] = __builtin_amdgcn_sinf(fr);
    }
}

DI void transpose_item(const float* W, int K, int ldn, int c0, int ncols, h16* WT, int row_off, LAS float* scr, int item, int lane) {
    const int nblk = ncols / 32, kb = item / nblk, nb = item % nblk, k0 = 64 * kb, n0 = 32 * nb;
#pragma unroll 8
    for (int i = 0; i < 32; ++i) { const int kk = 2 * i + (lane >> 5); scr[kk * 33 + (lane & 31)] = W[(size_t)(k0 + kk) * ldn + c0 + n0 + (lane & 31)]; }
    asm volatile("s_waitcnt lgkmcnt(0)" ::: "memory");
    const int c = lane & 7;
#pragma unroll
    for (int j = 0; j < 4; ++j) { const int n = (lane >> 3) + 8 * j; const LAS float* s = scr + (8 * c) * 33 + n;
        u32x4 o; o.x = pkh(s[0 * 33], s[1 * 33]); o.y = pkh(s[2 * 33], s[3 * 33]); o.z = pkh(s[4 * 33], s[5 * 33]); o.w = pkh(s[6 * 33], s[7 * 33]);
        *(u32x4*)(WT + (size_t)(row_off + n0 + n) * K + k0 + 8 * c) = o; }
    asm volatile("s_waitcnt lgkmcnt(0)" ::: "memory");
}

DI void norm_row(const float* xrow, const float* g, const float* sc, const float* sh, h16* orow, int lane) {
    f32x4 v[4]; float s = 0.f;
#pragma unroll
    for (int j = 0; j < 4; ++j) { v[j] = *((const f32x4*)xrow + lane + 64 * j); s += (v[j].x * v[j].x + v[j].y * v[j].y) + (v[j].z * v[j].z + v[j].w * v[j].w); }
    const float r = rsqrtf(wave_sum(s) * (1.0f / DM) + EPS);
#pragma unroll
    for (int j = 0; j < 4; ++j) {
        const int c = 4 * (lane + 64 * j);
        const f32x4 gv = *(const f32x4*)(g + c), scv = *(const f32x4*)(sc + c), shv = *(const f32x4*)(sh + c);
        const f32x4 y = v[j] * r * gv * (scv + 1.0f) + shv;
        u32x2 o; o.x = pkh(y.x, y.y); o.y = pkh(y.z, y.w);
        *(u32x2*)(orow + c) = o;
    }
}

DI void phase_p1(const Params& p, int l, LAS unsigned char* lds) {
    const int tid = ltid(), lane = tid & 63, wave = tid >> 6;
    LAS float* scr = (LAS float*)(lds + wave * 8704);
    LAS float* ctab = (LAS float*)(lds + 8 * 8704);
    if (tid < 128) ctab[tid] = __builtin_amdgcn_cosf((float)tid * (1.0f / 128.0f)) * 0.08838834764831845f;
    __syncthreads();
    h16* W = (h16*)(p.ws + OFF_W);
    const int gw = blockIdx.x * 8 + wave, NGW = gridDim.x * 8;
    constexpr int I1 = 16 * 96, I2 = 16 * 32, I3 = 16 * 96, I4 = 512, I5 = 512, I6 = 16 * 176, I7 = 44 * 32, ITOT = I1 + I2 + I3 + I4 + I5 + I6 + I7;
    const float* win = p.w_in + (size_t)l * DM * DIN;
    for (int it = gw; it < ITOT; it += NGW) {
        int r = it;
        if (r < I1) { transpose_item(win, 1024, DIN, 1024, 3072, W + W_QKV, 0, scr, r, lane); continue; } r -= I1;
        if (r < I2) { transpose_item(win, 1024, DIN, 0, 1024, W + W_B, 0, scr, r, lane); continue; } r -= I2;
        if (r < I3) { transpose_item(win, 1024, DIN, 4096, 3072, W + W_B, 1024, scr, r, lane); continue; } r -= I3;
        if (r < I4) { transpose_item(p.w_r + (size_t)l * DM * DM, 1024, 1024, 0, 1024, W + W_R, 0, scr, r, lane); continue; } r -= I4;
        if (r < I5) { transpose_item(p.w_o + (size_t)l * DM * DM, 1024, 1024, 0, 1024, W + W_O, 0, scr, r, lane); continue; } r -= I5;
        if (r < I6) { transpose_item(p.w_up + (size_t)l * DM * 2 * DFF, 1024, 2 * DFF, 0, 2 * DFF, W + W_UP, 0, scr, r, lane); continue; } r -= I6;
        transpose_item(p.w_dn + (size_t)l * DFF * DM, DFF, 1024, 0, 1024, W + W_DN, 0, scr, r, lane);
    }
    {
        const float* wf = p.w_f + (size_t)l * DM * DM;
        h16* W2 = W + W_F2;
        for (int it = blockIdx.x * NTHR + tid; it < 1024 * 64 * 4; it += gridDim.x * NTHR) {
            const int o = it & 1023, q = it >> 10, hf = q & 1, part = (q >> 1) & 1, cb = q >> 2;
            const int ch0 = cb * 16 + hf * 8, g = ch0 >> 7, c20 = ch0 & 127;
            float a[8];
#pragma unroll
            for (int i = 0; i < 8; ++i) a[i] = 0.f;
            for (int c1 = 0; c1 < 128; ++c1) {
                const float w = wf[(size_t)(g * 128 + c1) * DM + o];
#pragma unroll
                for (int i = 0; i < 8; ++i) { const int t = ((c20 + i) * c1 - (part ? 32 : 0)) & 127; a[i] += ctab[t] * w; }
            }
            u32x4 ov; ov.x = pkh(a[0], a[1]); ov.y = pkh(a[2], a[3]); ov.z = pkh(a[4], a[5]); ov.w = pkh(a[6], a[7]);
            *(u32x4*)(W2 + (size_t)o * 2048 + cb * 32 + part * 16 + hf * 8) = ov;
        }
    }
    const float* xs = (l == 0) ? p.x : p.out;
    const float* MOD = (const float*)(p.ws + OFF_MOD) + (size_t)l * 8 * 6144;
    h16* H = (h16*)(p.ws + OFF_H);
    for (int row = gw; row < MTOK; row += NGW) {
        const float* mb = MOD + (size_t)(row >> 12) * 6144;
        norm_row(xs + (size_t)row * DM, p.n1g + l * DM, mb + 1024, mb, H + (size_t)row * DM, lane);
    }
}
DI void phase_norm2(const Params& p, int l) {
    const int tid = ltid(), lane = tid & 63, wave = tid >> 6;
    const int gw = blockIdx.x * 8 + wave, NGW = gridDim.x * 8;
    const float* MOD = (const float*)(p.ws + OFF_MOD) + (size_t)l * 8 * 6144;
    h16* H = (h16*)(p.ws + OFF_H);
    for (int row = gw; row < MTOK; row += NGW) {
        const float* mb = MOD + (size_t)(row >> 12) * 6144;
        norm_row(p.out + (size_t)row * DM, p.n2g + l * DM, mb + 4096, mb + 3072, H + (size_t)row * DM, lane);
    }
}
DI void phase_final(const Params& p) {
    const int tid = ltid(), lane = tid & 63, wave = tid >> 6;
    const int gw = blockIdx.x * 8 + wave, NGW = gridDim.x * 8;
    for (int row = gw; row < MTOK; row += NGW) {
        float* xr = p.out + (size_t)row * DM;
        f32x4 v[4]; float s = 0.f;
#pragma unroll
        for (int j = 0; j < 4; ++j) { v[j] = *((const f32x4*)xr + lane + 64 * j); s += (v[j].x * v[j].x + v[j].y * v[j].y) + (v[j].z * v[j].z + v[j].w * v[j].w); }
        const float r = rsqrtf(wave_sum(s) * (1.0f / DM) + EPS);
#pragma unroll
        for (int j = 0; j < 4; ++j) { const f32x4 gv = *((const f32x4*)p.fin_g + lane + 64 * j); *((f32x4*)xr + lane + 64 * j) = v[j] * r * gv; }
    }
}

DI void fft4(float& ar, float& ai, float& br, float& bi, float& cr, float& ci, float& dr, float& di) {
    const float t0r = ar + cr, t0i = ai + ci, t1r = ar - cr, t1i = ai - ci, t2r = br + dr, t2i = bi + di, t3r = br - dr, t3i = bi - di;
    ar = t0r + t2r; ai = t0i + t2i;
    br = t1r + t3i; bi = t1i - t3r;
    cr = t0r - t2r; ci = t0i - t2i;
    dr = t1r - t3i; di = t1i + t3r;
}
DI void fft16(float (&re)[16], float (&im)[16]) {
#pragma unroll
    for (int n2 = 0; n2 < 4; ++n2) fft4(re[n2], im[n2], re[4 + n2], im[4 + n2], re[8 + n2], im[8 + n2], re[12 + n2], im[12 + n2]);
    constexpr float C1 = 0.9238795325112867f, S1 = 0.3826834323650898f, C2 = 0.7071067811865476f;
#define TWM(idx, wr_, wi_) { const float xr = re[idx], xi = im[idx]; re[idx] = xr * (wr_) - xi * (wi_); im[idx] = xr * (wi_) + xi * (wr_); }
    TWM(5, C1, -S1) TWM(6, C2, -C2) TWM(7, S1, -C1)
    TWM(9, C2, -C2) TWM(10, 0.f, -1.f) TWM(11, -C2, -C2)
    TWM(13, S1, -C1) TWM(14, -C2, -C2) TWM(15, -C1, S1)
#undef TWM
#pragma unroll
    for (int k1 = 0; k1 < 4; ++k1) fft4(re[4 * k1], im[4 * k1], re[4 * k1 + 1], im[4 * k1 + 1], re[4 * k1 + 2], im[4 * k1 + 2], re[4 * k1 + 3], im[4 * k1 + 3]);
}
template <bool TW> DI void fft_stage(LAS unsigned* X, int rb, int rs, const float (&twr)[16], const float (&twi)[16]) {
    float re[16], im[16];
#pragma unroll
    for (int n = 0; n < 16; ++n) { const f32x2 v = unpkh(X[rb + rs * n]); re[n] = v.x; im[n] = v.y; }
    fft16(re, im);
#pragma unroll
    for (int k = 0; k < 16; ++k) {
        const int idx = 4 * (k & 3) + (k >> 2);
        float orr, oi;
        if (TW) { orr = re[idx] * twr[k] - im[idx] * twi[k]; oi = re[idx] * twi[k] + im[idx] * twr[k]; }
        else { orr = re[idx] * 0.25f; oi = im[idx] * 0.25f; }
        X[rb + rs * k] = pkh(orr, oi);
    }
}
DI void phase_fft(const Params& p, LAS unsigned char* lds) {
    const int tid = ltid(), t = tid & 255, hs = tid >> 8;
    LAS unsigned* X = (LAS unsigned*)lds;
    const h16* UF = (const h16*)(p.ws + OFF_RC);
    h16* PQ = (h16*)(p.ws + OFF_RD);
    float twAr[16], twAi[16], twBr[16], twBi[16];
#pragma unroll
    for (int k = 0; k < 16; ++k) {
        const float fa = (float)(t * k) * (1.0f / 4096.0f), fb = (float)((t & 15) * k) * (1.0f / 256.0f);
        twAr[k] = 0.25f * __builtin_amdgcn_cosf(fa); twAi[k] = -0.25f * __builtin_amdgcn_sinf(fa);
        twBr[k] = 0.25f * __builtin_amdgcn_cosf(fb); twBi[k] = -0.25f * __builtin_amdgcn_sinf(fb);
    }
    for (int it = blockIdx.x; it < 512; it += gridDim.x) {
        const int b = it >> 6, cb = it & 63;
        for (int i = tid; i < 8192; i += NTHR) {
            const int s = i >> 1, hf = i & 1;
            const u32x4 v = *(const u32x4*)(UF + ((size_t)(b * SEQ + s)) * DM + cb * 16 + hf * 8);
            X[(4 * hf + 0) * 4096 + s] = v.x; X[(4 * hf + 1) * 4096 + s] = v.y; X[(4 * hf + 2) * 4096 + s] = v.z; X[(4 * hf + 3) * 4096 + s] = v.w;
        }
        __syncthreads();
#pragma unroll 1
        for (int r = 0; r < 4; ++r) fft_stage<true>(X + (2 * r + hs) * 4096, t, 256, twAr, twAi);
        __syncthreads();
#pragma unroll 1
        for (int r = 0; r < 4; ++r) fft_stage<true>(X + (2 * r + hs) * 4096, 256 * (t >> 4) + (t & 15), 16, twBr, twBi);
        __syncthreads();
#pragma unroll 1
        for (int r = 0; r < 4; ++r) fft_stage<false>(X + (2 * r + hs) * 4096, 16 * t, 1, twBr, twBi);
        __syncthreads();
        for (int i = tid; i < 16384; i += NTHR) {
            const int q = i & 3, idx = i >> 2;
            const int kf = (idx >> 8) + 16 * ((idx >> 4) & 15) + 256 * (idx & 15);
            const int km = (4096 - kf) & 4095;
            const int idm = 256 * (km & 15) + 16 * ((km >> 4) & 15) + (km >> 8);
            const int part = q >> 1, sg0 = (q & 1) * 4;
            unsigned o[4];
#pragma unroll
            for (int j = 0; j < 4; ++j) {
                const f32x2 z = unpkh(X[(sg0 + j) * 4096 + idx]), zm = unpkh(X[(sg0 + j) * 4096 + idm]);
                o[j] = part == 0 ? pkh(0.5f * (z.x + zm.x), 0.5f * (z.y + zm.y)) : pkh(0.5f * (z.y - zm.y), -0.5f * (z.x - zm.x));
            }
            u32x4 ov = {o[0], o[1], o[2], o[3]};
            *(u32x4*)(PQ + ((size_t)(b * SEQ + kf)) * 2048 + cb * 32 + q * 8) = ov;
        }
        __syncthreads();
    }
}

#define MFMA16(a, b, c) __builtin_amdgcn_mfma_f32_16x16x32_f16((a), (b), (c), 0, 0, 0)
DI h16x8 cat4(h16x4 a, h16x4 b) { return __builtin_shufflevector(a, b, 0, 1, 2, 3, 4, 5, 6, 7); }
DI h16x8 packf8(const f32x4& a, const f32x4& b) { const u32x4 w = pack8(a, b); return __builtin_bit_cast(h16x8, w); }
#define TR8(o, base, O0, O1, O2, O3, O4, O5, O6, O7) \
    asm volatile("ds_read_b64_tr_b16 %0, %8 offset:%9\n\tds_read_b64_tr_b16 %1, %8 offset:%10\n\tds_read_b64_tr_b16 %2, %8 offset:%11\n\tds_read_b64_tr_b16 %3, %8 offset:%12\n\t" \
                 "ds_read_b64_tr_b16 %4, %8 offset:%13\n\tds_read_b64_tr_b16 %5, %8 offset:%14\n\tds_read_b64_tr_b16 %6, %8 offset:%15\n\tds_read_b64_tr_b16 %7, %8 offset:%16\n\t" \
                 "s_waitcnt lgkmcnt(0)" : "=&v"(o[0]), "=&v"(o[1]), "=&v"(o[2]), "=&v"(o[3]), "=&v"(o[4]), "=&v"(o[5]), "=&v"(o[6]), "=&v"(o[7]) \
                 : "v"(base), "i"(O0), "i"(O1), "i"(O2), "i"(O3), "i"(O4), "i"(O5), "i"(O6), "i"(O7) : "memory")
#define TR2(o, base, O0, O1) \
    asm volatile("ds_read_b64_tr_b16 %0, %2 offset:%3\n\tds_read_b64_tr_b16 %1, %2 offset:%4\n\ts_waitcnt lgkmcnt(0)" : "=&v"(o[0]), "=&v"(o[1]) : "v"(base), "i"(O0), "i"(O1) : "memory")

constexpr int SC_BIG_STRIDE = 544, SC_V_STRIDE = 288, SC_BIG_BYTES = 64 * SC_BIG_STRIDE, SC_V_BYTES = 64 * SC_V_STRIDE, SC_SET = SC_BIG_BYTES + SC_V_BYTES;

DI void phase_scan(const Params& p, LAS unsigned char* lds) {
    const int tid = ltid(), lane = tid & 63, w = tid >> 6, li = lane & 15, g = lane >> 4;
    const h16* Qb = (const h16*)(p.ws + OFF_RA); const h16* Kb = (const h16*)(p.ws + OFF_RB); const h16* Vb = (const h16*)(p.ws + OFF_RC);
    h16* CR = (h16*)(p.ws + OFF_RD);
    const unsigned lbase = (unsigned)(uintptr_t)lds;
    for (int it = blockIdx.x; it < 128; it += gridDim.x) {
        const int b = it >> 4, h = (it >> 2) & 3, dir = (it >> 1) & 1, dvh = it & 1;
        const float lg = dir ? p.lgb[h] : p.lgf[h];
        const float g128 = exp2f(lg * 128.0f);
        h16* CRd = CR + (size_t)dir * MTOK * DM;
        const int dvcol = h * 256 + dvh * 128 + 16 * w;
        f32x4 F[16];
#pragma unroll
        for (int i = 0; i < 16; ++i) F[i] = (f32x4){0.f, 0.f, 0.f, 0.f};
        u32x4 rbig[4], rv[2];
#define SC_LOAD(gs_) do { const int i_ = (gs_) >> 2, ss_ = (gs_) & 3, c_ = dir ? 31 - i_ : i_; \
            const size_t row0_ = (size_t)b * SEQ + 128 * c_ + 64 * (ss_ & 1); const h16* src_ = (ss_ < 2 ? Qb : Kb) + row0_ * DM + h * 256; \
            _Pragma("unroll") for (int k_ = 0; k_ < 4; ++k_) { const int pc_ = tid + 512 * k_; rbig[k_] = *(const u32x4*)(src_ + (size_t)(pc_ >> 5) * DM + (pc_ & 31) * 8); } \
            if (ss_ >= 2) { const h16* vs_ = Vb + row0_ * DM + h * 256 + dvh * 128; \
                _Pragma("unroll") for (int k_ = 0; k_ < 2; ++k_) { const int pc_ = tid + 512 * k_; rv[k_] = *(const u32x4*)(vs_ + (size_t)(pc_ >> 4) * DM + (pc_ & 15) * 8); } } } while (0)
#define SC_WRITE(gs_) do { LAS unsigned char* sb_ = lds + ((gs_) & 1) * SC_SET; \
            _Pragma("unroll") for (int k_ = 0; k_ < 4; ++k_) { const int pc_ = tid + 512 * k_; *(LAS u32x4*)(sb_ + (pc_ >> 5) * SC_BIG_STRIDE + (pc_ & 31) * 16) = rbig[k_]; } \
            if (((gs_) & 3) >= 2) { _Pragma("unroll") for (int k_ = 0; k_ < 2; ++k_) { const int pc_ = tid + 512 * k_; *(LAS u32x4*)(sb_ + SC_BIG_BYTES + (pc_ >> 4) * SC_V_STRIDE + (pc_ & 15) * 16) = rv[k_]; } } } while (0)
        SC_LOAD(0); SC_WRITE(0);
        __syncthreads();
#pragma unroll 1
        for (int gs = 0; gs < 128; ++gs) {
            if (gs + 1 < 128) SC_LOAD(gs + 1);
            const int i = gs >> 2, ss = gs & 3, c = dir ? 31 - i : i;
            LAS unsigned char* sb = lds + (gs & 1) * SC_SET;
            if (ss < 2) {
#pragma unroll
                for (int mf = 0; mf < 4; ++mf) {
                    __builtin_amdgcn_sched_barrier(0);
                    f32x4 d = (f32x4){0.f, 0.f, 0.f, 0.f};
                    const LAS unsigned char* qr = sb + (16 * mf + li) * SC_BIG_STRIDE + 8 * g;
#pragma unroll
                    for (int ks = 0; ks < 8; ++ks) {
                        const h16x4 q0 = *(const LAS h16x4*)(qr + 64 * ks), q1 = *(const LAS h16x4*)(qr + 64 * ks + 32);
                        d = MFMA16(packf8(F[2 * ks], F[2 * ks + 1]), cat4(q0, q1), d);
                    }
                    const int j = 64 * ss + 16 * mf + li;
                    const float a = exp2f(lg * (dir ? (float)(128 - j) : (float)(j + 1)));
                    u32x2 o; o.x = pkh(d[0] * a, d[1] * a); o.y = pkh(d[2] * a, d[3] * a);
                    *(u32x2*)(CRd + ((size_t)b * SEQ + 128 * c + j) * DM + dvcol + 4 * g) = o;
                }
            } else {
                if (ss == 2) {
#pragma unroll
                    for (int fm = 0; fm < 16; ++fm) F[fm] *= g128;
                }
                const unsigned kb = lbase + (gs & 1) * SC_SET + (4 * g + (li >> 2)) * SC_BIG_STRIDE + (li & 3) * 8;
                const unsigned vb = lbase + (gs & 1) * SC_SET + SC_BIG_BYTES + (4 * g + (li >> 2)) * SC_V_STRIDE + (16 * w + (li & 3) * 4) * 2;
#pragma unroll
                for (int ks2 = 0; ks2 < 2; ++ks2) {
                    h16x4 vt[2];
                    TR2(vt, vb, ks2 * 32 * SC_V_STRIDE, ks2 * 32 * SC_V_STRIDE + 16 * SC_V_STRIDE);
                    h16x8 vf = cat4(vt[0], vt[1]);
#pragma unroll
                    for (int e = 0; e < 8; ++e) {
                        const int j = 64 * (ss - 2) + 32 * ks2 + 4 * g + (e & 3) + 16 * (e >> 2);
                        const float bj = exp2f(lg * (dir ? (float)j : (float)(127 - j)));
                        vf[e] = (h16)((float)vf[e] * bj);
                    }
#pragma unroll
                    for (int f4 = 0; f4 < 4; ++f4) {
                        h16x4 kt[8];
                        TR8(kt, kb, ks2 * 32 * SC_BIG_STRIDE + (4 * f4 + 0) * 32, ks2 * 32 * SC_BIG_STRIDE + (4 * f4 + 0) * 32 + 16 * SC_BIG_STRIDE,
                                    ks2 * 32 * SC_BIG_STRIDE + (4 * f4 + 1) * 32, ks2 * 32 * SC_BIG_STRIDE + (4 * f4 + 1) * 32 + 16 * SC_BIG_STRIDE,
                                    ks2 * 32 * SC_BIG_STRIDE + (4 * f4 + 2) * 32, ks2 * 32 * SC_BIG_STRIDE + (4 * f4 + 2) * 32 + 16 * SC_BIG_STRIDE,
                                    ks2 * 32 * SC_BIG_STRIDE + (4 * f4 + 3) * 32, ks2 * 32 * SC_BIG_STRIDE + (4 * f4 + 3) * 32 + 16 * SC_BIG_STRIDE);
#pragma unroll
                        for (int q = 0; q < 4; ++q) F[4 * f4 + q] = MFMA16(cat4(kt[2 * q], kt[2 * q + 1]), vf, F[4 * f4 + q]);
                    }
                }
            }
            if (gs + 1 < 128) SC_WRITE(gs + 1);
            __syncthreads();
        }
#undef SC_LOAD
#undef SC_WRITE
    }
}

constexpr int CH_K_STRIDE = 528, CH_V_STRIDE = 544, CH_K_BYTES = 128 * CH_K_STRIDE;
DI void phase_chunk(const Params& p, LAS unsigned char* lds) {
    const int tid = ltid(), lane = tid & 63, w = tid >> 6, li = lane & 15, g = lane >> 4;
    const h16* Qb = (const h16*)(p.ws + OFF_RA); const h16* Kb = (const h16*)(p.ws + OFF_RB); const h16* Vb = (const h16*)(p.ws + OFF_RC);
    const h16* CR = (const h16*)(p.ws + OFF_RD); h16* YR = (h16*)(p.ws + OFF_RE);
    const unsigned lbase = (unsigned)(uintptr_t)lds;
    for (int it = blockIdx.x; it < 1024; it += gridDim.x) {
        const int b = it >> 7, h = (it >> 5) & 3, c = it & 31;
        const size_t row0 = (size_t)b * SEQ + 128 * c;
        const float lgf = p.lgf[h], lgb = p.lgb[h];
        __syncthreads();
        {
            const h16* ks = Kb + row0 * DM + h * 256; const h16* vs = Vb + row0 * DM + h * 256;
            u32x4 r[8];
#pragma unroll
            for (int k = 0; k < 8; ++k) { const int pc = tid + 512 * k; r[k] = *(const u32x4*)(ks + (size_t)(pc >> 5) * DM + (pc & 31) * 8); }
#pragma unroll
            for (int k = 0; k < 8; ++k) { const int pc = tid + 512 * k; *(LAS u32x4*)(lds + (pc >> 5) * CH_K_STRIDE + (pc & 31) * 16) = r[k]; }
#pragma unroll
            for (int k = 0; k < 8; ++k) { const int pc = tid + 512 * k; r[k] = *(const u32x4*)(vs + (size_t)(pc >> 5) * DM + (pc & 31) * 8); }
#pragma unroll
            for (int k = 0; k < 8; ++k) { const int pc = tid + 512 * k; *(LAS u32x4*)(lds + CH_K_BYTES + (pc >> 5) * CH_V_STRIDE + (pc & 31) * 16) = r[k]; }
        }
        const int jabs = 16 * w + li;
        const size_t prow = row0 + jabs;
        h16x8 qf[8];
#pragma unroll
        for (int ks = 0; ks < 8; ++ks) qf[ks] = *(const h16x8*)(Qb + prow * DM + h * 256 + 32 * ks + 8 * g);
        __syncthreads();
        h16x8 pf[4];
#pragma unroll
        for (int mf2 = 0; mf2 < 4; ++mf2) {
            f32x4 s2[2];
#pragma unroll
            for (int hh = 0; hh < 2; ++hh) {
                const int mf = 2 * mf2 + hh;
                f32x4 s = (f32x4){0.f, 0.f, 0.f, 0.f};
                const LAS unsigned char* kr = lds + (16 * mf + li) * CH_K_STRIDE + 16 * g;
#pragma unroll
                for (int ks = 0; ks < 8; ++ks) s = MFMA16(*(const LAS h16x8*)(kr + 64 * ks), qf[ks], s);
#pragma unroll
                for (int r = 0; r < 4; ++r) {
                    const int m = 16 * mf + 4 * g + r, df = jabs - m;
                    const float dec = df >= 0 ? exp2f(lgf * (float)df) : exp2f(lgb * (float)(-df));
                    s[r] *= dec;
                }
                s2[hh] = s;
            }
            pf[mf2] = packf8(s2[0], s2[1]);
        }
        f32x4 O[16];
        const unsigned vb = lbase + CH_K_BYTES + (4 * g + (li >> 2)) * CH_V_STRIDE + (li & 3) * 8;
#pragma unroll
        for (int df = 0; df < 16; ++df) {
            h16x4 vt[8];
            TR8(vt, vb, df * 32 + 0 * 32 * CH_V_STRIDE, df * 32 + 0 * 32 * CH_V_STRIDE + 16 * CH_V_STRIDE,
                        df * 32 + 1 * 32 * CH_V_STRIDE, df * 32 + 1 * 32 * CH_V_STRIDE + 16 * CH_V_STRIDE,
                        df * 32 + 2 * 32 * CH_V_STRIDE, df * 32 + 2 * 32 * CH_V_STRIDE + 16 * CH_V_STRIDE,
                        df * 32 + 3 * 32 * CH_V_STRIDE, df * 32 + 3 * 32 * CH_V_STRIDE + 16 * CH_V_STRIDE);
            f32x4 o = (f32x4){0.f, 0.f, 0.f, 0.f};
#pragma unroll
            for (int ks = 0; ks < 4; ++ks) o = MFMA16(cat4(vt[2 * ks], vt[2 * ks + 1]), pf[ks], o);
            O[df] = o;
        }
        const h16* c0 = CR + prow * DM + h * 256 + 4 * g; const h16* c1 = c0 + (size_t)MTOK * DM;
        float s = 0.f;
#pragma unroll
        for (int df = 0; df < 16; ++df) {
            const u32x2 a = *(const u32x2*)(c0 + 16 * df), bq = *(const u32x2*)(c1 + 16 * df);
            const f32x2 a0 = unpkh(a.x), a1 = unpkh(a.y), b0 = unpkh(bq.x), b1 = unpkh(bq.y);
            O[df][0] += a0.x + b0.x; O[df][1] += a0.y + b0.y; O[df][2] += a1.x + b1.x; O[df][3] += a1.y + b1.y;
            s += (O[df][0] + O[df][1]) + (O[df][2] + O[df][3]);
        }
        s += __shfl_xor(s, 16); s += __shfl_xor(s, 32);
        const float mu = s * (1.0f / 256.0f);
        float q2 = 0.f;
#pragma unroll
        for (int df = 0; df < 16; ++df) { O[df] = O[df] - mu; q2 += (O[df][0] * O[df][0] + O[df][1] * O[df][1]) + (O[df][2] * O[df][2] + O[df][3] * O[df][3]); }
        q2 += __shfl_xor(q2, 16); q2 += __shfl_xor(q2, 32);
        const float rs = rsqrtf(q2 * (1.0f / 256.0f) + EPS);
        h16* yo = YR + prow * DM + h * 256 + 4 * g;
#pragma unroll
        for (int df = 0; df < 16; ++df) { u32x2 o; o.x = pkh(O[df][0] * rs, O[df][1] * rs); o.y = pkh(O[df][2] * rs, O[df][3] * rs); *(u32x2*)(yo + 16 * df) = o; }
    }
}

DI f32x2 gelu_pk(f32x2 v) {
    const f32x2 av = __builtin_elementwise_abs(v), d = av * 0.2316418882f + 1.0f;
    f32x2 t; t.x = __builtin_amdgcn_rcpf(d.x); t.y = __builtin_amdgcn_rcpf(d.y);
    f32x2 q = t * 0.5307027145f + (-0.7265760135f); q = q * t + 0.7107068705f; q = q * t + (-0.142248368f); q = q * t + 0.127414796f; q = q * t;
    const f32x2 s = (v * v) * (-0.72134752044f);
    f32x2 e; e.x = __builtin_amdgcn_exp2f(s.x); e.y = __builtin_amdgcn_exp2f(s.y);
    const f32x2 m = v * (q * e), r = v - m;
    f32x2 o; o.x = v.x < 0.f ? m.x : r.x; o.y = v.y < 0.f ? m.y : r.y; return o;
}
DI void ld8(const h16* p, bool ok, float (&o)[8]) {
    u32x4 v = {0u, 0u, 0u, 0u};
    if (ok) v = *(const u32x4*)p;
#pragma unroll
    for (int e = 0; e < 4; ++e) { const f32x2 t = unpkh(v[e]); o[2 * e] = t.x; o[2 * e + 1] = t.y; }
}
DI void phase_conv(const Params& p, int l, int half) {
    const h16* U = (const h16*)(p.ws + OFF_RA); h16* HID = (h16*)(p.ws + OFF_RD);
    const float* cw = p.conv_w + (size_t)l * 3 * 2 * DFF; const float* cbias = p.conv_b + (size_t)l * 2 * DFF;
    constexpr int RB = 16, NCG = DFF / 8, NU = (MTOK / 2 / RB) * NCG;
    const int tid = ltid();
    for (int un = blockIdx.x * NTHR + tid; un < NU; un += gridDim.x * NTHR) {
        const int rb = un / NCG, cg_ = un - rb * NCG, r0 = rb * RB, n0 = cg_ * 8;
        float wa[3][8], wb[3][8], ba[8], bb[8];
#pragma unroll
        for (int i = 0; i < 3; ++i)
#pragma unroll
            for (int e = 0; e < 8; e += 4) {
                const f32x4 x = *(const f32x4*)(cw + i * 2 * DFF + n0 + e), y = *(const f32x4*)(cw + i * 2 * DFF + DFF + n0 + e);
                wa[i][e] = x.x; wa[i][e + 1] = x.y; wa[i][e + 2] = x.z; wa[i][e + 3] = x.w; wb[i][e] = y.x; wb[i][e + 1] = y.y; wb[i][e + 2] = y.z; wb[i][e + 3] = y.w;
            }
#pragma unroll
        for (int e = 0; e < 8; e += 4) {
            const f32x4 x = *(const f32x4*)(cbias + n0 + e), y = *(const f32x4*)(cbias + DFF + n0 + e);
            ba[e] = x.x; ba[e + 1] = x.y; ba[e + 2] = x.z; ba[e + 3] = x.w; bb[e] = y.x; bb[e + 1] = y.y; bb[e + 2] = y.z; bb[e + 3] = y.w;
        }
        const int pos0 = r0 & (SEQ - 1);
        float pa[8], pb[8], ca[8], cb[8], na[8], nb[8];
        const h16* ur = U + (size_t)r0 * (2 * DFF) + n0;
        ld8(ur - 2 * DFF, pos0 != 0, pa); ld8(ur - 2 * DFF + DFF, pos0 != 0, pb);
        ld8(ur, true, ca); ld8(ur + DFF, true, cb);
#pragma unroll 4
        for (int r = 0; r < RB; ++r) {
            const bool okn = (pos0 + r + 1) < SEQ;
            ld8(ur + (size_t)(r + 1) * (2 * DFF), okn, na); ld8(ur + (size_t)(r + 1) * (2 * DFF) + DFF, okn, nb);
            unsigned o[4];
#pragma unroll
            for (int e = 0; e < 8; e += 2) {
                f32x2 a, bq;
                a.x = wa[0][e] * pa[e] + wa[1][e] * ca[e] + wa[2][e] * na[e] + ba[e]; a.y = wa[0][e + 1] * pa[e + 1] + wa[1][e + 1] * ca[e + 1] + wa[2][e + 1] * na[e + 1] + ba[e + 1];
                bq.x = wb[0][e] * pb[e] + wb[1][e] * cb[e] + wb[2][e] * nb[e] + bb[e]; bq.y = wb[0][e + 1] * pb[e + 1] + wb[1][e + 1] * cb[e + 1] + wb[2][e + 1] * nb[e + 1] + bb[e + 1];
                const f32x2 gl = gelu_pk(a);
                o[e >> 1] = pkh(gl.x * bq.x, gl.y * bq.y);
            }
            u32x4 ov = {o[0], o[1], o[2], o[3]};
            *(u32x4*)(HID + (size_t)(r0 + r) * DFF + n0) = ov;
#pragma unroll
            for (int e = 0; e < 8; ++e) { pa[e] = ca[e]; pb[e] = cb[e]; ca[e] = na[e]; cb[e] = nb[e]; }
        }
    }
}

template <class Epi> DI void run_gemm(LAS unsigned char* lds, const h16* A, const h16* Bt, int M, int N, int K, const Epi& E) {
    pg8::Gemm g; g.A = A; g.Bt = Bt; g.M = M; g.N = N; g.K = K;
    pg8::StaticOrder S; S.init(M, N, (int)gridDim.x, (int)blockIdx.x);
    pg8::gemm_phase<Epi, pg8::StaticOrder, false>(lds, g, S, E, nullptr);
}

DI void run_phase(const Params& p, int ph, LAS unsigned char* lds) {
    unsigned char* ws = p.ws;
    h16* W = (h16*)(ws + OFF_W); h16* H = (h16*)(ws + OFF_H);
    h16* RA = (h16*)(ws + OFF_RA); h16* RB = (h16*)(ws + OFF_RB); h16* RC = (h16*)(ws + OFF_RC); h16* RD = (h16*)(ws + OFF_RD); h16* RE = (h16*)(ws + OFF_RE);
#ifndef PHMASK
#define PHMASK 0xFFFFF
#endif
#define PHON(k) ((PHMASK >> (k)) & 1)
    if (ph == 0) { if (PHON(16)) phase_prep(p, lds); return; }
    if (ph == 1 + 16 * NLAYER) { if (PHON(17)) phase_final(p); return; }
    const int l = (ph - 1) >> 4, st = (ph - 1) & 15;
    const float* MODl = (const float*)(ws + OFF_MOD) + (size_t)l * 8 * 6144;
    switch (st) {
    case 0: if (PHON(0)) phase_p1(p, l, lds); break;
    case 1: if (PHON(1)) { EpiQKV E; E.Q = RA; E.cosT = (const float*)(ws + OFF_COS); E.sinT = (const float*)(ws + OFF_SIN); run_gemm(lds, H, W + W_QKV, MTOK, 3072, 1024, E); } break;
    case 2: if (PHON(2)) phase_scan(p, lds); break;
    case 3: if (PHON(3)) phase_chunk(p, lds); break;
    case 4: if (PHON(4)) { EpiB E; E.ws = ws; run_gemm(lds, H, W + W_B, MTOK, 4096, 1024, E); } break;
    case 5: if (PHON(5)) phase_fft(p, lds); break;
    case 6: if (PHON(6)) { EpiMerge<0> E; E.T = RC; E.G = RA; run_gemm(lds, RD, W + W_F2, MTOK, 1024, 2048, E); } break;
    case 7: if (PHON(7)) { EpiMerge<1> E; E.T = RC; E.G = RB; run_gemm(lds, RE, W + W_R, MTOK, 1024, 1024, E); } break;
    case 8: if (PHON(8)) { EpiRes E; E.xi = (l == 0) ? p.x : p.out; E.xo = p.out; E.gate = MODl + 2048; E.rowoff = 0; run_gemm(lds, RC, W + W_O, MTOK, 1024, 1024, E); } break;
    case 9: if (PHON(9)) phase_norm2(p, l); break;
    case 10: case 13: if (PHON(10)) { const int half = st == 13; EpiStore E; E.O = RA; E.ldc = 2 * DFF; run_gemm(lds, H + (size_t)half * (MTOK / 2) * DM, W + W_UP, MTOK / 2, 2 * DFF, 1024, E); } break;
    case 11: case 14: if (PHON(11)) phase_conv(p, l, st == 14); break;
    case 12: case 15: if (PHON(12)) { const int half = st == 15; EpiRes E; E.xi = p.out + (size_t)half * (MTOK / 2) * DM; E.xo = p.out + (size_t)half * (MTOK / 2) * DM; E.gate = MODl + 5120; E.rowoff = 0;
        E.gate = MODl + 5120 + (size_t)half * 4 * 6144; run_gemm(lds, RD, W + W_DN, MTOK / 2, 1024, DFF, E); } break;
    }
}

template <class T> DI T* launder(T* p) {
    unsigned lo = (unsigned)(uintptr_t)p, hi = (unsigned)((uintptr_t)p >> 32);
    asm volatile("" : "+v"(lo), "+v"(hi));
    lo = __builtin_amdgcn_readfirstlane(lo); hi = __builtin_amdgcn_readfirstlane(hi);
    return (T*)(((uintptr_t)hi << 32) | (uintptr_t)lo);
}
__global__ void __launch_bounds__(512, 2) fwd_megakernel(Params p) {
    extern __shared__ __attribute__((aligned(16))) unsigned char smem[];
    LAS unsigned char* lds = (LAS unsigned char*)smem;
    cg::grid_group grid = cg::this_grid();
    for (int ph = p.ph0; ph < p.ph1; ++ph) {
        run_phase(p, ph, lds);
        if (ph + 1 < p.ph1) grid.sync();
    }
}

extern "C" void kernel_launch(void* const* d_in, const int* in_sizes, int n_in, void* d_out, int out_size, void* d_ws, size_t ws_size, hipStream_t stream) {
    static int grid = 0;
    if (grid == 0) {
        int dev = 0, cus = 0, per_cu = 0;
        hipGetDevice(&dev);
        hipDeviceGetAttribute(&cus, hipDeviceAttributeMultiprocessorCount, dev);
        if (hipFuncSetAttribute((const void*)fwd_megakernel, hipFuncAttributeMaxDynamicSharedMemorySize, LDS_BYTES) != hipSuccess) fprintf(stderr, "kernel_launch: hipFuncSetAttribute failed\n");
        hipOccupancyMaxActiveBlocksPerMultiprocessor(&per_cu, (const void*)fwd_megakernel, NTHR, LDS_BYTES);
        if (per_cu < 1) { fprintf(stderr, "kernel_launch: occupancy query says %d blocks per CU\n", per_cu); per_cu = 1; }
        (void)hipGetLastError();
        grid = cus * 1;
        if (ws_size < WS_END) fprintf(stderr, "kernel_launch: workspace too small: %zu < %zu\n", ws_size, (size_t)WS_END);
        fprintf(stderr, "kernel_launch: grid %d (cus %d, per_cu %d), ws %zu need %zu\n", grid, cus, per_cu, ws_size, (size_t)WS_END);
    }
    Params p{};
    const float* const* in = (const float* const*)d_in;
    p.x = in[0]; p.c = in[1]; p.n1g = in[2]; p.n2g = in[3]; p.ada_w = in[4]; p.ada_b = in[5]; p.w_in = in[6]; p.w_f = in[7]; p.w_r = in[8]; p.w_o = in[9];
    p.w_up = in[10]; p.conv_w = in[11]; p.conv_b = in[12]; p.w_dn = in[13]; p.fin_g = in[14];
    p.out = (float*)d_out; p.ws = (unsigned char*)d_ws;
    for (int h = 0; h < 4; ++h) {
        p.lgf[h] = (float)(std::log1p(-std::exp2(-5.0 - h)) / std::log(2.0));
        p.lgb[h] = (float)(std::log1p(-std::exp2(-5.5 - h)) / std::log(2.0));
    }
    constexpr int NPH = 2 + 16 * NLAYER;
#if MULTI_LAUNCH
    for (int ph = 0; ph < NPH; ++ph) {
        p.ph0 = ph; p.ph1 = ph + 1;
        hipLaunchKernelGGL(fwd_megakernel, dim3(grid), dim3(NTHR), LDS_BYTES, stream, p);
    }
#else
    p.ph0 = 0; p.ph1 = NPH;
    void* args[] = {&p};
    hipError_t e = hipLaunchCooperativeKernel((const void*)fwd_megakernel, dim3(grid), dim3(NTHR), args, LDS_BYTES, stream);
    if (e != hipSuccess) fprintf(stderr, "cooperative launch failed: %s (grid %d)\n", hipGetErrorString(e), grid);
#endif
}
```

```cpp
#include <hip/hip_runtime.h>
#include <hip/hip_cooperative_groups.h>
#include <cstdio>
#include <cstdint>
#include <cmath>
namespace cg = cooperative_groups;

#ifndef MULTI_LAUNCH
#define MULTI_LAUNCH 0
#endif

#define DI __device__ __forceinline__
#define LAS __attribute__((address_space(3)))
typedef _Float16 h16;
typedef h16 h16x2 __attribute__((ext_vector_type(2)));
typedef h16 h16x4 __attribute__((ext_vector_type(4)));
typedef h16 h16x8 __attribute__((ext_vector_type(8)));
typedef float f32x2 __attribute__((ext_vector_type(2)));
typedef float f32x4 __attribute__((ext_vector_type(4)));
typedef unsigned u32x2 __attribute__((ext_vector_type(2)));
typedef unsigned u32x4 __attribute__((ext_vector_type(4)));

constexpr int MTOK = 32768, DM = 1024, SEQ = 4096, NLAYER = 4, DFF = 2816, DIN = 7168;
constexpr float EPS = 1e-6f;

#ifndef TSEL
#define TSEL 0
#endif
#ifndef TBLK
#define TBLK 0
#endif
#ifndef TMAX_US
#define TMAX_US 2000.0f
#endif
#define TWORDS(lds_) ((LAS unsigned long long*)((lds_) + 163840 - 32))
#define TBEG(id, lds_) do { if (TSEL == (id) && blockIdx.x == TBLK && threadIdx.x == (TBLK >= 128 ? 0 : 0)) TWORDS(lds_)[0] = __builtin_amdgcn_s_memrealtime(); } while (0)
#define TEND(id, lds_) do { if (TSEL == (id) && blockIdx.x == TBLK && threadIdx.x == 0) TWORDS(lds_)[1] += __builtin_amdgcn_s_memrealtime() - TWORDS(lds_)[0]; } while (0)
DI int ltid() { int t = threadIdx.x; asm volatile("" : "+v"(t)); return t; }
DI unsigned pkh(float lo, float hi) { h16x2 v = {(h16)lo, (h16)hi}; return __builtin_bit_cast(unsigned, v); }
DI f32x2 unpkh(unsigned u) { h16x2 v = __builtin_bit_cast(h16x2, u); return (f32x2){(float)v.x, (float)v.y}; }
DI float wave_sum(float v) {
#pragma unroll
    for (int o = 1; o < 64; o <<= 1) v += __shfl_xor(v, o);
    return v;
}
DI float sigmoidf_(float x) { return 1.0f / (1.0f + __expf(-x)); }

namespace pg8 {
#define PG8_LAS __attribute__((address_space(3)))
typedef h16 bf16_t;
typedef h16x8 bf16x8;
constexpr int BM = 256, BK = 64, HALF = 128, HTB = HALF * BK * 2, STAGE_BYTES = 8 * HTB, NXCD = 8, WGM = 8;
__host__ __device__ __forceinline__ int lds_byte(int r, int c) { const int st = (r >> 4) * 2 + (c >> 5), rr = r & 15, cc = c & 31, ob = rr * 64 + cc * 2; return st * 1024 + (ob ^ (((ob >> 9) & 1) << 5)); }
__host__ __device__ __forceinline__ void stage_rc(int b, int& R, int& C) { const int st = b / 1024, sb = b % 1024, swz = sb ^ (((sb >> 9) & 1) << 5); R = (st >> 1) * 16 + swz / 64; C = (st & 1) * 32 + (swz % 64) / 2; }
__host__ __device__ __forceinline__ int perm32(int rho) { const int n = rho >> 4, i = rho & 15; return 8 * (i >> 2) + 4 * n + (i & 3); }
struct Unit { int pm, pn; };
struct Gemm { const bf16_t* A; const bf16_t* Bt; int M, N, K; int a_rows; };
struct StaticOrder {
    int nM, nN, nwg, G, c;
    __host__ __device__ void init(int M, int N, int G_, int c_) { nM = M / BM; nN = N / BM; nwg = nM * nN; G = G_; c = c_; }
    __host__ __device__ bool next(int i, Unit& u) const {
        const long L = (long)i * G + c; if (L >= nwg) return false;
        int wgid = (int)L; { const int q = nwg / NXCD, r = nwg % NXCD, xcd = wgid % NXCD, off = wgid / NXCD; wgid = (xcd < r ? xcd * (q + 1) : r * (q + 1) + (xcd - r) * q) + off; }
        const int nig = WGM * nN, gid = wgid / nig, fm = gid * WGM, gsz = (nM - fm) < WGM ? (nM - fm) : WGM;
        u.pm = fm + ((wgid % nig) % gsz); u.pn = (wgid % nig) / gsz; return true;
    }
    __device__ __forceinline__ void a_ready(const Unit&) const {}
    __device__ __forceinline__ void done(const Unit&) const {}
};
template <class Epi, class Sched, bool STAMP = false>
__device__ __forceinline__ void gemm_phase(PG8_LAS unsigned char* lds, const Gemm g, const Sched& S, const Epi& E, unsigned long long* stamps) {
    const int tid = ltid(), wid = __builtin_amdgcn_readfirstlane(tid >> 6), lane = tid & 63, wr = wid >> 2, wc = wid & 3, fr = lane & 15, fq = lane >> 4;
    const int K = g.K, nt = K / BK;
    int ts_lo = 0, ts_hi = 0, nts = 0; const unsigned long long rt_entry = STAMP ? (unsigned long long)wall_clock64() : 0ull;
#define PG8_STAMP() do { if (STAMP && wid == 0 && nts < 64) { const unsigned long long _c = (unsigned long long)clock64(); \
        ts_lo = (lane == nts) ? (int)(unsigned)_c : ts_lo; ts_hi = (lane == nts) ? (int)(unsigned)(_c >> 32) : ts_hi; ++nts; } } while (0)
    PG8_STAMP();
    unsigned voffA[2], voffB[2];
#pragma unroll
    for (int i = 0; i < 2; ++i) { int R, C; stage_rc(tid * 16 + i * 8192, R, C); const int Rb = Epi::PERM ? ((R & ~31) + perm32(R & 31)) : R;
        voffA[i] = (unsigned)(R * K + C) * 2u; voffB[i] = (unsigned)(Rb * K + C) * 2u; }
    const size_t kstep = (size_t)(BK * 2);
    const size_t hstep = (size_t)HALF * K * 2;
    const size_t tstep = 2 * hstep;
    const size_t tstepA = (size_t)g.a_rows * K * 2;
    const unsigned ldsw = (unsigned)wid * 1024u;
    const int aoff = lds_byte(wr * 64 + fr, fq * 8), boff = lds_byte(wc * 32 + fr, fq * 8);
#define PG8_SA(b, h) (((b) * 2 + (h)) * HTB)
#define PG8_SB(b, h) ((4 + (b) * 2 + (h)) * HTB)
#define PG8_STAGE(bufoff, gbase, voff) do { _Pragma("unroll") for (int _i = 0; _i < 2; ++_i) \
        __builtin_amdgcn_global_load_lds((const unsigned*)((const char*)(gbase) + (voff)[_i]), (PG8_LAS unsigned*)(lds + (bufoff) + ldsw + _i * 8192), 16, 0, 0); } while (0)
#define PG8_LDA(dst, b, h) do { _Pragma("unroll") for (int m = 0; m < 4; ++m) _Pragma("unroll") for (int k = 0; k < 2; ++k) dst[m][k] = *(const PG8_LAS bf16x8*)(lds + PG8_SA(b, h) + aoff + m * 2048 + k * 1024); } while (0)
#define PG8_LDB(dst, b, h) do { _Pragma("unroll") for (int n = 0; n < 2; ++n) _Pragma("unroll") for (int k = 0; k < 2; ++k) dst[n][k] = *(const PG8_LAS bf16x8*)(lds + PG8_SB(b, h) + boff + n * 2048 + k * 1024); } while (0)
#define PG8_MMA(ai, bj, At, Bt) do { __builtin_amdgcn_s_setprio(1); _Pragma("unroll") for (int m = 0; m < 4; ++m) _Pragma("unroll") for (int n = 0; n < 2; ++n) _Pragma("unroll") for (int k = 0; k < 2; ++k) \
        acc[ai][bj][m][n] = __builtin_amdgcn_mfma_f32_16x16x32_f16(Bt[n][k], At[m][k], acc[ai][bj][m][n], 0, 0, 0); __builtin_amdgcn_s_setprio(0); } while (0)
#define PG8_WAIT_V(n) asm volatile("s_waitcnt vmcnt(" #n ")" ::: "memory")
#define PG8_WAIT_L(n) asm volatile("s_waitcnt lgkmcnt(" #n ")" ::: "memory")
#define PG8_BAR __builtin_amdgcn_s_barrier()
#define PG8_SCHED __builtin_amdgcn_sched_barrier(0)
    Unit cur, nxt; int ui = 0;
    if (!S.next(0, cur)) return;
    f32x4 acc[2][2][4][2];
#pragma unroll
    for (int a = 0; a < 2; ++a)
#pragma unroll
        for (int b = 0; b < 2; ++b)
#pragma unroll
            for (int m = 0; m < 4; ++m)
#pragma unroll
                for (int n = 0; n < 2; ++n) acc[a][b][m][n] = (f32x4){0.f, 0.f, 0.f, 0.f};
    bf16x8 At[4][2], B0[2][2], B1[2][2];
    const char* cA = (const char*)g.A + (size_t)cur.pm * tstepA; const char* cB = (const char*)g.Bt + (size_t)cur.pn * tstep;
    S.a_ready(cur);
    PG8_STAGE(PG8_SB(0, 0), cB, voffB); PG8_STAGE(PG8_SA(0, 0), cA, voffA); PG8_STAGE(PG8_SB(0, 1), cB + hstep, voffB); PG8_STAGE(PG8_SA(0, 1), cA + hstep, voffA);
    if (wr == 1) PG8_BAR;
    PG8_WAIT_V(4); PG8_BAR;
    PG8_STAGE(PG8_SB(1, 0), cB + kstep, voffB); PG8_STAGE(PG8_SA(1, 0), cA + kstep, voffA); PG8_STAGE(PG8_SB(1, 1), cB + hstep + kstep, voffB);
    PG8_WAIT_V(6); PG8_BAR;
    PG8_STAMP();
    for (;;) {
        const bool has_next = S.next(ui + 1, nxt);
        const char* nA = has_next ? (const char*)g.A + (size_t)nxt.pm * tstepA : cA; const char* nB = has_next ? (const char*)g.Bt + (size_t)nxt.pn * tstep : cB;
        for (int t = 0; t < nt; t += 2) {
            const bool last = (t == nt - 2);
            const char* a1 = cA + (size_t)(t + 1) * kstep;
            const char* a2 = last ? nA : cA + (size_t)(t + 2) * kstep; const char* b2 = last ? nB : cB + (size_t)(t + 2) * kstep;
            const char* a3 = a2 + kstep; const char* b3 = b2 + kstep;
            if (last && has_next) S.a_ready(nxt);
            PG8_LDB(B0, 0, 0); PG8_SCHED; PG8_LDA(At, 0, 0); PG8_STAGE(PG8_SA(1, 1), a1 + hstep, voffA);
            PG8_WAIT_L(8); PG8_BAR; PG8_WAIT_L(0); PG8_MMA(0, 0, At, B0); PG8_BAR; PG8_SCHED;
            PG8_LDB(B1, 0, 1); PG8_STAGE(PG8_SB(0, 0), b2, voffB);
            PG8_BAR; PG8_WAIT_L(0); PG8_MMA(0, 1, At, B1); PG8_BAR;
            PG8_LDA(At, 0, 1); PG8_STAGE(PG8_SA(0, 0), a2, voffA);
            PG8_BAR; PG8_WAIT_L(0); PG8_MMA(1, 0, At, B0); PG8_BAR; PG8_SCHED;
            PG8_STAGE(PG8_SB(0, 1), b2 + hstep, voffB);
            PG8_WAIT_V(6); PG8_BAR; PG8_MMA(1, 1, At, B1); PG8_BAR;
            PG8_LDB(B0, 1, 0); PG8_SCHED; PG8_LDA(At, 1, 0); PG8_STAGE(PG8_SA(0, 1), a2 + hstep, voffA);
            PG8_WAIT_L(8); PG8_BAR; PG8_WAIT_L(0); PG8_MMA(0, 0, At, B0); PG8_BAR; PG8_SCHED;
            PG8_LDB(B1, 1, 1); PG8_STAGE(PG8_SB(1, 0), b3, voffB);
            PG8_BAR; PG8_WAIT_L(0); PG8_MMA(0, 1, At, B1); PG8_BAR;
            PG8_LDA(At, 1, 1); PG8_STAGE(PG8_SA(1, 0), a3, voffA);
            PG8_BAR; PG8_WAIT_L(0); PG8_MMA(1, 0, At, B0); PG8_BAR; PG8_SCHED;
            PG8_STAGE(PG8_SB(1, 1), b3 + hstep, voffB);
            PG8_WAIT_V(6); PG8_BAR; PG8_MMA(1, 1, At, B1); PG8_BAR;
        }
        PG8_STAMP();
        if constexpr (!Epi::AFTER_DRAIN) { E(acc, cur, wr, wc, fr, fq); S.done(cur); }
        PG8_STAMP();
        if (!has_next) break;
#pragma unroll
        for (int a = 0; a < 2; ++a)
#pragma unroll
            for (int b = 0; b < 2; ++b)
#pragma unroll
                for (int m = 0; m < 4; ++m)
#pragma unroll
                    for (int n = 0; n < 2; ++n) acc[a][b][m][n] = (f32x4){0.f, 0.f, 0.f, 0.f};
        cur = nxt; cA = nA; cB = nB; ++ui;
    }
    PG8_WAIT_V(0);
    if (wr == 0) PG8_BAR;
    PG8_BAR;
    if constexpr (Epi::AFTER_DRAIN) { E.fused(acc, cur, wr, wc, fr, fq, lds, wid, lane); S.done(cur); }
    PG8_STAMP();
    if (STAMP && wid == 0) { stamps[lane] = lane < nts ? (((unsigned long long)(unsigned)ts_hi << 32) | (unsigned)ts_lo) : 0ull;
        if (lane == 62) stamps[62] = rt_entry; if (lane == 63) stamps[63] = (unsigned long long)wall_clock64(); }
#undef PG8_STAMP
#undef PG8_SA
#undef PG8_SB
#undef PG8_STAGE
#undef PG8_LDA
#undef PG8_LDB
#undef PG8_MMA
#undef PG8_WAIT_V
#undef PG8_WAIT_L
#undef PG8_BAR
#undef PG8_SCHED
}
}
using pg8::Unit;

constexpr size_t OFF_MOD = 0;
constexpr size_t OFF_COS = 786432;
constexpr size_t OFF_SIN = OFF_COS + 2097152;
constexpr size_t OFF_W   = OFF_SIN + 2097152;
constexpr size_t W_QKV = 0, W_B = W_QKV + 3072 * 1024, W_F2 = W_B + 4096 * 1024, W_R = W_F2 + 1024 * 2048, W_O = W_R + 1024 * 1024, W_UP = W_O + 1024 * 1024, W_DN = W_UP + 5632 * 1024, W_FT = W_DN + 1024 * 2816, W_DF = W_FT + 1024 * 1024, W_END = W_DF + 2048 * 1024;
constexpr size_t OFF_H  = OFF_W + W_END * 2;
constexpr size_t ACT = (size_t)MTOK * DM * 2;
constexpr size_t OFF_RA = OFF_H + ACT;
constexpr size_t OFF_RB = OFF_RA + ACT;
constexpr size_t OFF_RC = OFF_RB + ACT;
constexpr size_t OFF_RD = OFF_RC + ACT;
constexpr size_t OFF_RE = OFF_RD + 2 * ACT;
constexpr size_t OFF_BAR = OFF_RE + ACT;
constexpr size_t WS_END = OFF_BAR + 16384;

DI u32x4 pack8(const f32x4& a, const f32x4& b) { u32x4 w; w.x = pkh(a[0], a[1]); w.y = pkh(a[2], a[3]); w.z = pkh(b[0], b[1]); w.w = pkh(b[2], b[3]); return w; }

struct EpiQKV {
    static constexpr bool PERM = true, AFTER_DRAIN = false;
    h16 *Q; const float *cosT, *sinT;
    DI void operator()(const f32x4 (&acc)[2][2][4][2], const Unit& u, int wr, int wc, int fr, int fq) const {
        const int sec = u.pn >> 2, head = u.pn & 3, colh = wc * 32 + 8 * fq;
        h16* base = Q + (size_t)sec * ((size_t)MTOK * DM);
        const float scl = sec == 0 ? 0.0625f : 1.0f;
#pragma unroll
        for (int ai = 0; ai < 2; ++ai)
#pragma unroll
            for (int m = 0; m < 4; ++m) {
                __builtin_amdgcn_sched_barrier(0);
                const int row = u.pm * 256 + ai * 128 + wr * 64 + m * 16 + fr;
                h16* rowp = base + (size_t)row * DM + head * 256 + colh;
                if (sec == 2) {
                    *(u32x4*)(rowp) = pack8(acc[ai][0][m][0], acc[ai][0][m][1]);
                    *(u32x4*)(rowp + 128) = pack8(acc[ai][1][m][0], acc[ai][1][m][1]);
                } else {
                    const int pos = row & (SEQ - 1);
                    f32x4 o1[2], o2[2];
#pragma unroll
                    for (int n = 0; n < 2; ++n) {
                        const f32x4 c = *(const f32x4*)(cosT + pos * 128 + colh + 4 * n), s = *(const f32x4*)(sinT + pos * 128 + colh + 4 * n);
                        const f32x4 t1 = acc[ai][0][m][n], t2 = acc[ai][1][m][n];
                        o1[n] = (t1 * c - t2 * s) * scl; o2[n] = (t1 * s + t2 * c) * scl;
                    }
                    *(u32x4*)(rowp) = pack8(o1[0], o1[1]);
                    *(u32x4*)(rowp + 128) = pack8(o2[0], o2[1]);
                }
            }
    }
};
struct EpiB {
    static constexpr bool PERM = true, AFTER_DRAIN = false;
    unsigned char* ws;
    DI void operator()(const f32x4 (&acc)[2][2][4][2], const Unit& u, int wr, int wc, int fr, int fq) const {
        const int sec = u.pn >> 2, cs = (u.pn & 3) * 256 + wc * 32 + 8 * fq;
        const size_t boff = sec == 0 ? OFF_RC : (sec == 1 ? OFF_RE : (sec == 2 ? OFF_RA : OFF_RB));
        h16* base = (h16*)(ws + boff);
#pragma unroll
        for (int ai = 0; ai < 2; ++ai)
#pragma unroll
            for (int m = 0; m < 4; ++m) {
                __builtin_amdgcn_sched_barrier(0);
                const int row = u.pm * 256 + ai * 128 + wr * 64 + m * 16 + fr;
#pragma unroll
                for (int bj = 0; bj < 2; ++bj) {
                    h16* p = base + (size_t)row * DM + cs + bj * 128;
                    if (sec == 0) { const int ch = cs + bj * 128; p = base + ((size_t)((row >> 12) * 64 + (ch >> 4)) * SEQ + (row & (SEQ - 1))) * 16 + (ch & 15); }
                    f32x4 v0 = acc[ai][bj][m][0], v1 = acc[ai][bj][m][1];
                    if (sec == 1) {
                        const u32x4 y = *(const u32x4*)p;
#pragma unroll
                        for (int e = 0; e < 2; ++e) {
                            const f32x2 ya = unpkh(y[e]), yb = unpkh(y[2 + e]);
                            v0[2 * e] = ya.x * v0[2 * e] * sigmoidf_(v0[2 * e]); v0[2 * e + 1] = ya.y * v0[2 * e + 1] * sigmoidf_(v0[2 * e + 1]);
                            v1[2 * e] = yb.x * v1[2 * e] * sigmoidf_(v1[2 * e]); v1[2 * e + 1] = yb.y * v1[2 * e + 1] * sigmoidf_(v1[2 * e + 1]);
                        }
                    } else if (sec >= 2) {
#pragma unroll
                        for (int e = 0; e < 4; ++e) { v0[e] = sigmoidf_(v0[e]); v1[e] = sigmoidf_(v1[e]); }
                    }
                    *(u32x4*)p = pack8(v0, v1);
                }
            }
    }
};
template <int MODE> struct EpiMerge {
    static constexpr bool PERM = true, AFTER_DRAIN = false;
    h16* T; const h16* G;
    DI void operator()(const f32x4 (&acc)[2][2][4][2], const Unit& u, int wr, int wc, int fr, int fq) const {
        const int cs = u.pn * 256 + wc * 32 + 8 * fq;
#pragma unroll
        for (int ai = 0; ai < 2; ++ai)
#pragma unroll
            for (int m = 0; m < 4; ++m) {
                __builtin_amdgcn_sched_barrier(0);
                const int row = u.pm * 256 + ai * 128 + wr * 64 + m * 16 + fr;
#pragma unroll
                for (int bj = 0; bj < 2; ++bj) {
                    const size_t o = (size_t)row * DM + cs + bj * 128;
                    const u32x4 g = *(const u32x4*)(G + o);
                    f32x4 v0 = acc[ai][bj][m][0], v1 = acc[ai][bj][m][1];
                    u32x4 t = {0u, 0u, 0u, 0u};
                    if (MODE == 1) t = *(const u32x4*)(T + o);
#pragma unroll
                    for (int e = 0; e < 2; ++e) {
                        const f32x2 ga = unpkh(g[e]), gb = unpkh(g[2 + e]);
                        v0[2 * e] *= ga.x; v0[2 * e + 1] *= ga.y; v1[2 * e] *= gb.x; v1[2 * e + 1] *= gb.y;
                        if (MODE == 1) { const f32x2 ta = unpkh(t[e]), tb = unpkh(t[2 + e]); v0[2 * e] += ta.x; v0[2 * e + 1] += ta.y; v1[2 * e] += tb.x; v1[2 * e + 1] += tb.y; }
                    }
                    *(u32x4*)(T + o) = pack8(v0, v1);
                }
            }
    }
};
struct EpiRes {
    static constexpr bool PERM = false, AFTER_DRAIN = false;
    const float* xi; float* xo; const float* gate; int rowoff;
    DI void operator()(const f32x4 (&acc)[2][2][4][2], const Unit& u, int wr, int wc, int fr, int fq) const {
        const int c0 = u.pn * 256 + wc * 32 + 4 * fq;
#pragma unroll
        for (int ai = 0; ai < 2; ++ai)
#pragma unroll
            for (int m = 0; m < 4; ++m) {
                __builtin_amdgcn_sched_barrier(0);
                const int row = rowoff + u.pm * 256 + ai * 128 + wr * 64 + m * 16 + fr;
                const float* gp = gate + (size_t)(row >> 12) * 6144;
#pragma unroll
                for (int bj = 0; bj < 2; ++bj)
#pragma unroll
                    for (int n = 0; n < 2; ++n) {
                        const int col = c0 + bj * 128 + n * 16;
                        const f32x4 gv = *(const f32x4*)(gp + col), xv = *(const f32x4*)(xi + (size_t)row * DM + col);
                        *(f32x4*)(xo + (size_t)row * DM + col) = xv + gv * acc[ai][bj][m][n];
                    }
            }
    }
};
DI f32x2 gelu_pk(f32x2 v) {
    const f32x2 av = __builtin_elementwise_abs(v), d = av * 0.2316418882f + 1.0f;
    f32x2 t; t.x = __builtin_amdgcn_rcpf(d.x); t.y = __builtin_amdgcn_rcpf(d.y);
    f32x2 q = t * 0.5307027145f + (-0.7265760135f); q = q * t + 0.7107068705f; q = q * t + (-0.142248368f); q = q * t + 0.127414796f; q = q * t;
    const f32x2 s = (v * v) * (-0.72134752044f);
    f32x2 e; e.x = __builtin_amdgcn_exp2f(s.x); e.y = __builtin_amdgcn_exp2f(s.y);
    const f32x2 m = v * (q * e), r = v - m;
    f32x2 o; o.x = v.x < 0.f ? m.x : r.x; o.y = v.y < 0.f ? m.y : r.y; return o;
}

#define DPP_SHR1(old, v) ((fr == 0) ? (old) : __builtin_bit_cast(float, __builtin_amdgcn_update_dpp(0, __builtin_bit_cast(int, (v)), 0x111, 0xf, 0xf, true)))
#define DPP_SHL1(old, v) ((fr == 15) ? (old) : __builtin_bit_cast(float, __builtin_amdgcn_update_dpp(0, __builtin_bit_cast(int, (v)), 0x101, 0xf, 0xf, true)))
#define DPP_ROR1(v)  __builtin_bit_cast(float, __builtin_amdgcn_update_dpp(0, __builtin_bit_cast(int, (v)), 0x121, 0xf, 0xf, false))
#define DPP_ROR15(v) __builtin_bit_cast(float, __builtin_amdgcn_update_dpp(0, __builtin_bit_cast(int, (v)), 0x12f, 0xf, 0xf, false))
struct EpiUpConv {
    static constexpr bool PERM = true, AFTER_DRAIN = false;
    h16* HID; const float* cw; const float* cb; LAS unsigned char* lds;
    DI void operator()(const f32x4 (&acc)[2][2][4][2], const Unit& u, int wr, int wc, int fr, int fq) const {
        LAS float* xb = (LAS float*)(lds + 131072);
        const int wave = wr * 4 + wc;
#pragma unroll
        for (int ai = 0; ai < 2; ++ai)
#pragma unroll
            for (int bj = 0; bj < 2; ++bj)
#pragma unroll
                for (int n = 0; n < 2; ++n) {
                    if (fr == 0)  *(LAS f32x4*)(xb + ((wave * 2 + ai) * 2 + 0) * 64 + bj * 32 + 8 * fq + 4 * n) = acc[ai][bj][0][n];
                    if (fr == 15) *(LAS f32x4*)(xb + ((wave * 2 + ai) * 2 + 1) * 64 + bj * 32 + 8 * fq + 4 * n) = acc[ai][bj][3][n];
                }
        asm volatile("s_waitcnt lgkmcnt(0)" ::: "memory"); __builtin_amdgcn_s_barrier(); asm volatile("" ::: "memory");
        __builtin_amdgcn_s_barrier(); asm volatile("" ::: "memory");
        const int chl = u.pn * 128 + wc * 32 + 8 * fq;
        const int lane_ = fq * 16 + fr;
        const int srcp = 4 * (fr == 0 ? lane_ + 15 : lane_ - 1), srcn = 4 * (fr == 15 ? lane_ - 15 : lane_ + 1);
#pragma unroll
        for (int n = 0; n < 2; ++n) {
            f32x4 wa[3], wb[3];
#pragma unroll
            for (int i = 0; i < 3; ++i) { wa[i] = *(const f32x4*)(cw + i * 2 * DFF + chl + 4 * n); wb[i] = *(const f32x4*)(cw + i * 2 * DFF + DFF + chl + 4 * n); }
            const f32x4 ba = *(const f32x4*)(cb + chl + 4 * n), bb = *(const f32x4*)(cb + DFF + chl + 4 * n);
#pragma unroll
            for (int ai = 0; ai < 2; ++ai) {
                const int wpv = wr ? wave - 4 : wave + 4, aipv = wr ? ai : 0, ainx = wr ? 1 : ai;
                const f32x4 xpa = *(const LAS f32x4*)(xb + ((wpv * 2 + aipv) * 2 + 1) * 64 + 0 * 32 + 8 * fq + 4 * n), xpb = *(const LAS f32x4*)(xb + ((wpv * 2 + aipv) * 2 + 1) * 64 + 1 * 32 + 8 * fq + 4 * n);
                const f32x4 xna = *(const LAS f32x4*)(xb + ((wpv * 2 + ainx) * 2 + 0) * 64 + 0 * 32 + 8 * fq + 4 * n), xnb = *(const LAS f32x4*)(xb + ((wpv * 2 + ainx) * 2 + 0) * 64 + 1 * 32 + 8 * fq + 4 * n);
#pragma unroll
                for (int m = 0; m < 4; ++m) {
                    __builtin_amdgcn_sched_barrier(0);
                    const int lr = ai * 128 + wr * 64 + m * 16 + fr, gr = u.pm * 254 - 1 + lr, pos = gr & (SEQ - 1);
                    const bool okp = pos != 0, okn = pos != SEQ - 1;
                    f32x2 ga[2], gb[2];
#pragma unroll
                    for (int e = 0; e < 4; ++e) {
                        const float xa = acc[ai][0][m][n][e], xbv = acc[ai][1][m][n][e];
                        const float za = (fr == 15 && m > 0) ? acc[ai][0][m > 0 ? m - 1 : 0][n][e] : xa, zb = (fr == 15 && m > 0) ? acc[ai][1][m > 0 ? m - 1 : 0][n][e] : xbv;
                        const float ya = (fr == 0 && m < 3) ? acc[ai][0][m < 3 ? m + 1 : 3][n][e] : xa, yb = (fr == 0 && m < 3) ? acc[ai][1][m < 3 ? m + 1 : 3][n][e] : xbv;
                        float pa = __builtin_bit_cast(float, __builtin_amdgcn_ds_bpermute(srcp, __builtin_bit_cast(int, za)));
                        float pb = __builtin_bit_cast(float, __builtin_amdgcn_ds_bpermute(srcp, __builtin_bit_cast(int, zb)));
                        float na = __builtin_bit_cast(float, __builtin_amdgcn_ds_bpermute(srcn, __builtin_bit_cast(int, ya)));
                        float nb = __builtin_bit_cast(float, __builtin_amdgcn_ds_bpermute(srcn, __builtin_bit_cast(int, yb)));
                        if (m == 0) { pa = fr == 0 ? xpa[e] : pa; pb = fr == 0 ? xpb[e] : pb; }
                        if (m == 3) { na = fr == 15 ? xna[e] : na; nb = fr == 15 ? xnb[e] : nb; }
                        pa = okp ? pa : 0.f; pb = okp ? pb : 0.f; na = okn ? na : 0.f; nb = okn ? nb : 0.f;
                        const float ca = wa[0][e] * pa + (wa[1][e] * xa + (wa[2][e] * na + ba[e]));
                        const float cbv = wb[0][e] * pb + (wb[1][e] * xbv + (wb[2][e] * nb + bb[e]));
                        if (e & 1) { ga[e >> 1].y = ca; gb[e >> 1].y = cbv; } else { ga[e >> 1].x = ca; gb[e >> 1].x = cbv; }
                    }
                    const f32x2 g0 = gelu_pk(ga[0]), g1 = gelu_pk(ga[1]);
                    u32x2 o; o.x = pkh(g0.x * gb[0].x, g0.y * gb[0].y); o.y = pkh(g1.x * gb[1].x, g1.y * gb[1].y);
                    if (lr >= 1 && lr <= 254 && gr < MTOK) *(u32x2*)(HID + (size_t)gr * DFF + chl + 4 * n) = o;
                }
            }
        }
    }
};

struct EpiStore {
    static constexpr bool PERM = true, AFTER_DRAIN = false;
    h16* O; int ldc;
    DI void operator()(const f32x4 (&acc)[2][2][4][2], const Unit& u, int wr, int wc, int fr, int fq) const {
        const int cs = u.pn * 256 + wc * 32 + 8 * fq;
#pragma unroll
        for (int ai = 0; ai < 2; ++ai)
#pragma unroll
            for (int m = 0; m < 4; ++m) {
                __builtin_amdgcn_sched_barrier(0);
                const int row = u.pm * 256 + ai * 128 + wr * 64 + m * 16 + fr;
#pragma unroll
                for (int bj = 0; bj < 2; ++bj) *(u32x4*)(O + (size_t)row * ldc + cs + bj * 128) = pack8(acc[ai][bj][m][0], acc[ai][bj][m][1]);
            }
    }
};


struct Params {
    const float *x, *c, *n1g, *n2g, *ada_w, *ada_b, *w_in, *w_f, *w_r, *w_o, *w_up, *conv_w, *conv_b, *w_dn, *fin_g;
    float* out; unsigned char* ws;
    float lgf[4], lgb[4];
    int ph0, ph1;
};

constexpr int LDS_BYTES = 160 * 1024;
constexpr int NST = 11;
constexpr int NTHR = 512;

DI void phase_prep(const Params& p, LAS unsigned char* lds) {
    const int tid = ltid();
    LAS float* cact = (LAS float*)lds;
    LAS float* red = (LAS float*)(lds + 32768);
    for (int i = tid; i < 8 * 1024; i += NTHR) { const float v = p.c[i]; cact[i] = v / (1.0f + __expf(-v)); }
    __syncthreads();
    float* MOD = (float*)(p.ws + OFF_MOD);
    for (int it = blockIdx.x; it < 256; it += gridDim.x) {
        const int l = it >> 6, j0 = (it & 63) * 96;
        if (tid < 480) {
            const int col = tid % 96, part = tid / 96, d0 = part * 205, d1 = (d0 + 205 < 1024) ? d0 + 205 : 1024;
            float a[8];
#pragma unroll
            for (int b = 0; b < 8; ++b) a[b] = 0.f;
            const float* wp = p.ada_w + ((size_t)l * 1024) * 6144 + j0 + col;
            for (int d = d0; d < d1; ++d) {
                const float w = wp[(size_t)d * 6144];
#pragma unroll
                for (int b = 0; b < 8; ++b) a[b] += cact[b * 1024 + d] * w;
            }
#pragma unroll
            for (int b = 0; b < 8; ++b) red[(part * 8 + b) * 96 + col] = a[b];
        }
        __syncthreads();
        for (int i = tid; i < 768; i += NTHR) {
            const int b = i / 96, col = i % 96;
            float s = p.ada_b[l * 6144 + j0 + col];
#pragma unroll
            for (int part = 0; part < 5; ++part) s += red[(part * 8 + b) * 96 + col];
            MOD[((size_t)l * 8 + b) * 6144 + j0 + col] = s;
        }
        __syncthreads();
    }
    {
        h16* DF = (h16*)(p.ws + OFF_W) + W_DF;
        for (int it = blockIdx.x * NTHR + tid; it < 2048 * 128; it += gridDim.x * NTHR) {
            const int kk = it >> 7, ch0 = (it & 127) * 8;
            const int cb = kk >> 5, part = (kk >> 4) & 1, chk = cb * 16 + (kk & 15), g = chk >> 7, c2 = chk & 127;
            float a[8];
#pragma unroll
            for (int e = 0; e < 8; ++e) { const int ch = ch0 + e; const int t = (c2 * (ch & 127) - (part ? 32 : 0)) & 127;
                a[e] = ((ch >> 7) == g) ? __builtin_amdgcn_cosf((float)t * (1.0f / 128.0f)) * 0.08838834764831845f : 0.f; }
            u32x4 ov; ov.x = pkh(a[0], a[1]); ov.y = pkh(a[2], a[3]); ov.z = pkh(a[4], a[5]); ov.w = pkh(a[6], a[7]);
            *(u32x4*)(DF + (size_t)kk * 1024 + ch0) = ov;
        }
    }
    float* cosT = (float*)(p.ws + OFF_COS); float* sinT = (float*)(p.ws + OFF_SIN);
    for (int i = blockIdx.x * NTHR + tid; i < SEQ * 128; i += gridDim.x * NTHR) {
        const int pos = i >> 7, j = i & 127;
        const float invf = exp2f(-(float)j * (13.287712379549449f / 128.0f));
        const float ang = (float)pos * invf;
        const double rev = (double)ang * 0.15915494309189535;
        const float fr = (float)(rev - floor(rev));
        cosT[i] = __builtin_amdgcn_cosf(fr); sinT[i] = __builtin_amdgcn_sinf(fr);
    }
}

DI void transpose_item(const float* W, int K, int ldn, int c0, int ncols, h16* WT, int row_off, LAS float* scr, int item, int lane) {
    const int nblk = ncols / 32, kb = item / nblk, nb = item % nblk, k0 = 64 * kb, n0 = 32 * nb;
    f32x4 v[8];
    const float* src = W + (size_t)(k0 + (lane >> 3)) * ldn + c0 + n0 + 4 * (lane & 7);
#pragma unroll
    for (int i = 0; i < 8; ++i) v[i] = *(const f32x4*)(src + (size_t)(8 * i) * ldn);
#pragma unroll
    for (int i = 0; i < 8; ++i) { LAS float* d = scr + ((lane >> 3) + 8 * i) * 33 + 4 * (lane & 7); d[0] = v[i].x; d[1] = v[i].y; d[2] = v[i].z; d[3] = v[i].w; }
    asm volatile("s_waitcnt lgkmcnt(0)" ::: "memory");
    const int c = lane & 7;
#pragma unroll
    for (int j = 0; j < 4; ++j) { const int n = (lane >> 3) + 8 * j; const LAS float* s = scr + (8 * c) * 33 + n;
        u32x4 o; o.x = pkh(s[0 * 33], s[1 * 33]); o.y = pkh(s[2 * 33], s[3 * 33]); o.z = pkh(s[4 * 33], s[5 * 33]); o.w = pkh(s[6 * 33], s[7 * 33]);
        *(u32x4*)(WT + (size_t)(row_off + n0 + n) * K + k0 + 8 * c) = o; }
    asm volatile("s_waitcnt lgkmcnt(0)" ::: "memory");
}

DI void norm_row(const float* xrow, const float* g, const float* sc, const float* sh, h16* orow, int lane) {
    f32x4 v[4]; float s = 0.f;
#pragma unroll
    for (int j = 0; j < 4; ++j) { v[j] = *((const f32x4*)xrow + lane + 64 * j); s += (v[j].x * v[j].x + v[j].y * v[j].y) + (v[j].z * v[j].z + v[j].w * v[j].w); }
    const float r = rsqrtf(wave_sum(s) * (1.0f / DM) + EPS);
#pragma unroll
    for (int j = 0; j < 4; ++j) {
        const int c = 4 * (lane + 64 * j);
        const f32x4 gv = *(const f32x4*)(g + c), scv = *(const f32x4*)(sc + c), shv = *(const f32x4*)(sh + c);
        const f32x4 y = v[j] * r * gv * (scv + 1.0f) + shv;
        u32x2 o; o.x = pkh(y.x, y.y); o.y = pkh(y.z, y.w);
        *(u32x2*)(orow + c) = o;
    }
}

DI void convert_rest(const Params& p, int l, LAS unsigned char* lds, int bix, int nblk, int tid) {
    const int lane = tid & 63, wave = tid >> 6;
    LAS float* scr = (LAS float*)(lds + wave * 8704);
    __syncthreads();
    h16* W = (h16*)(p.ws + OFF_W);
    const int gw = bix * 8 + wave, NGW = nblk * 8;
    constexpr int I2 = 16 * 32, I3 = 16 * 96, I4 = 512, I5 = 512, I6 = 16 * 176, I7 = 44 * 32, ITOT = I2 + I3 + I4 + I5 + I6 + I7;
    const float* win = p.w_in + (size_t)l * DM * DIN;
    for (int it = gw; it < ITOT; it += NGW) {
        int r = it;
        if (r < I2) { transpose_item(win, 1024, DIN, 0, 1024, W + W_B, 0, scr, r, lane); continue; } r -= I2;
        if (r < I3) { transpose_item(win, 1024, DIN, 4096, 3072, W + W_B, 1024, scr, r, lane); continue; } r -= I3;
        if (r < I4) { transpose_item(p.w_r + (size_t)l * DM * DM, 1024, 1024, 0, 1024, W + W_R, 0, scr, r, lane); continue; } r -= I4;
        if (r < I5) { transpose_item(p.w_o + (size_t)l * DM * DM, 1024, 1024, 0, 1024, W + W_O, 0, scr, r, lane); continue; } r -= I5;
        if (r < I6) { const int job = r >> 6, pn_ = job >> 1, bj_ = job & 1;
            transpose_item(p.w_up + (size_t)l * DM * 2 * DFF, 1024, 2 * DFF, bj_ * DFF + pn_ * 128, 128, W + W_UP, pn_ * 256 + bj_ * 128, scr, r & 63, lane); continue; } r -= I6;
        transpose_item(p.w_dn + (size_t)l * DFF * DM, DFF, 1024, 0, 1024, W + W_DN, 0, scr, r, lane);
    }
}
DI void phase_p1(const Params& p, int l, LAS unsigned char* lds) {
    const int tid = ltid(), lane = tid & 63, wave = tid >> 6;
    LAS float* scr = (LAS float*)(lds + wave * 8704);
    h16* W = (h16*)(p.ws + OFF_W);
    const int gw = blockIdx.x * 8 + wave, NGW = gridDim.x * 8;
    const float* win = p.w_in + (size_t)l * DM * DIN;
    for (int it = gw; it < 16 * 96 + 512; it += NGW) {
        if (it < 16 * 96) transpose_item(win, 1024, DIN, 1024, 3072, W + W_QKV, 0, scr, it, lane);
        else transpose_item(p.w_f + (size_t)l * DM * DM, 1024, 1024, 0, 1024, W + W_FT, 0, scr, it - 16 * 96, lane);
    }
    const float* xs = (l == 0) ? p.x : p.out;
    const float* MOD = (const float*)(p.ws + OFF_MOD) + (size_t)l * 8 * 6144;
    h16* H = (h16*)(p.ws + OFF_H);
    for (int row = gw; row < MTOK; row += NGW) {
        const float* mb = MOD + (size_t)(row >> 12) * 6144;
        norm_row(xs + (size_t)row * DM, p.n1g + l * DM, mb + 1024, mb, H + (size_t)row * DM, lane);
    }
}
DI void phase_norm2(const Params& p, int l) {
    const int tid = ltid(), lane = tid & 63, wave = tid >> 6;
    const int gw = blockIdx.x * 8 + wave, NGW = gridDim.x * 8;
    const float* MOD = (const float*)(p.ws + OFF_MOD) + (size_t)l * 8 * 6144;
    h16* H = (h16*)(p.ws + OFF_H);
    for (int row = gw; row < MTOK; row += NGW) {
        const float* mb = MOD + (size_t)(row >> 12) * 6144;
        norm_row(p.out + (size_t)row * DM, p.n2g + l * DM, mb + 4096, mb + 3072, H + (size_t)row * DM, lane);
    }
}
DI void phase_final(const Params& p, LAS unsigned char* lds) {
    const int tid = ltid(), lane = tid & 63, wave = tid >> 6;
    const int gw = blockIdx.x * 8 + wave, NGW = gridDim.x * 8;
    for (int row = gw; row < MTOK; row += NGW) {
        float* xr = p.out + (size_t)row * DM;
        f32x4 v[4]; float s = 0.f;
#pragma unroll
        for (int j = 0; j < 4; ++j) { v[j] = *((const f32x4*)xr + lane + 64 * j); s += (v[j].x * v[j].x + v[j].y * v[j].y) + (v[j].z * v[j].z + v[j].w * v[j].w); }
        const float r = rsqrtf(wave_sum(s) * (1.0f / DM) + EPS);
#pragma unroll
        for (int j = 0; j < 4; ++j) { const f32x4 gv = *((const f32x4*)p.fin_g + lane + 64 * j); f32x4 o = v[j] * r * gv;
            if (TSEL != 0 && (row >> 3) == TBLK) { const float tus = (float)TWORDS(lds)[1] * 0.01f; const float enc = (TSEL == 99) ? 0.1f : 0.02f + 0.13f * fminf(tus / TMAX_US, 1.0f); o = o + enc; }
            *((f32x4*)xr + lane + 64 * j) = o; }
    }
}

DI void fft4(float& ar, float& ai, float& br, float& bi, float& cr, float& ci, float& dr, float& di) {
    const float t0r = ar + cr, t0i = ai + ci, t1r = ar - cr, t1i = ai - ci, t2r = br + dr, t2i = bi + di, t3r = br - dr, t3i = bi - di;
    ar = t0r + t2r; ai = t0i + t2i;
    br = t1r + t3i; bi = t1i - t3r;
    cr = t0r - t2r; ci = t0i - t2i;
    dr = t1r - t3i; di = t1i + t3r;
}
DI void fft16(float (&re)[16], float (&im)[16]) {
#pragma unroll
    for (int n2 = 0; n2 < 4; ++n2) fft4(re[n2], im[n2], re[4 + n2], im[4 + n2], re[8 + n2], im[8 + n2], re[12 + n2], im[12 + n2]);
    constexpr float C1 = 0.9238795325112867f, S1 = 0.3826834323650898f, C2 = 0.7071067811865476f;
#define TWM(idx, wr_, wi_) { const float xr = re[idx], xi = im[idx]; re[idx] = xr * (wr_) - xi * (wi_); im[idx] = xr * (wi_) + xi * (wr_); }
    TWM(5, C1, -S1) TWM(6, C2, -C2) TWM(7, S1, -C1)
    TWM(9, C2, -C2) TWM(10, 0.f, -1.f) TWM(11, -C2, -C2)
    TWM(13, S1, -C1) TWM(14, -C2, -C2) TWM(15, -C1, S1)
#undef TWM
#pragma unroll
    for (int k1 = 0; k1 < 4; ++k1) fft4(re[4 * k1], im[4 * k1], re[4 * k1 + 1], im[4 * k1 + 1], re[4 * k1 + 2], im[4 * k1 + 2], re[4 * k1 + 3], im[4 * k1 + 3]);
}
DI int fsw(int idx) { return idx ^ ((idx >> 4) & 15); }
template <bool TW> DI void fft_stage(LAS unsigned* X, int rb, int rs, const float (&twr)[16], const float (&twi)[16]) {
    float re[16], im[16];
#pragma unroll
    for (int n = 0; n < 16; ++n) { const f32x2 v = unpkh(X[fsw(rb + rs * n)]); re[n] = v.x; im[n] = v.y; }
    fft16(re, im);
#pragma unroll
    for (int k = 0; k < 16; ++k) {
        const int idx = 4 * (k & 3) + (k >> 2);
        float orr, oi;
        if (TW) { orr = re[idx] * twr[k] - im[idx] * twi[k]; oi = re[idx] * twi[k] + im[idx] * twr[k]; }
        else { orr = re[idx] * 0.25f; oi = im[idx] * 0.25f; }
        X[fsw(rb + rs * k)] = pkh(orr, oi);
    }
}
DI void phase_fft(const Params& p, LAS unsigned char* lds) {
    const int tid = ltid(), t = tid & 255, hs = tid >> 8;
    LAS unsigned* X = (LAS unsigned*)lds;
    const h16* UF = (const h16*)(p.ws + OFF_RC);
    h16* PQ = (h16*)(p.ws + OFF_RD);
    float twAr[16], twAi[16], twBr[16], twBi[16];
#pragma unroll
    for (int k = 0; k < 16; ++k) {
        const float fa = (float)(t * k) * (1.0f / 4096.0f), fb = (float)((t & 15) * k) * (1.0f / 256.0f);
        twAr[k] = 0.25f * __builtin_amdgcn_cosf(fa); twAi[k] = -0.25f * __builtin_amdgcn_sinf(fa);
        twBr[k] = 0.25f * __builtin_amdgcn_cosf(fb); twBi[k] = -0.25f * __builtin_amdgcn_sinf(fb);
    }
    for (int it = blockIdx.x; it < 512; it += gridDim.x) {
        const int b = it >> 6, cb = it & 63;
        for (int i = tid; i < 8192; i += NTHR) {
            const int s = i >> 1, hf = i & 1;
            const u32x4 v = *(const u32x4*)(UF + ((size_t)(b * 64 + cb) * SEQ + s) * 16 + hf * 8);
            const int ss_ = fsw(s); X[(4 * hf + 0) * 4096 + ss_] = v.x; X[(4 * hf + 1) * 4096 + ss_] = v.y; X[(4 * hf + 2) * 4096 + ss_] = v.z; X[(4 * hf + 3) * 4096 + ss_] = v.w;
        }
        __syncthreads();
#pragma unroll 1
        for (int r = 0; r < 4; ++r) fft_stage<true>(X + (2 * r + hs) * 4096, t, 256, twAr, twAi);
        __syncthreads();
#pragma unroll 1
        for (int r = 0; r < 4; ++r) fft_stage<true>(X + (2 * r + hs) * 4096, 256 * (t >> 4) + (t & 15), 16, twBr, twBi);
        __syncthreads();
#pragma unroll 1
        for (int r = 0; r < 4; ++r) fft_stage<false>(X + (2 * r + hs) * 4096, 16 * t, 1, twBr, twBi);
        __syncthreads();
        for (int i = tid; i < 16384; i += NTHR) {
            const int q = i & 3, idx = i >> 2;
            const int kf = (idx >> 8) + 16 * ((idx >> 4) & 15) + 256 * (idx & 15);
            const int km = (4096 - kf) & 4095;
            const int idm = 256 * (km & 15) + 16 * ((km >> 4) & 15) + (km >> 8);
            const int part = q >> 1, sg0 = (q & 1) * 4;
            unsigned o[4];
#pragma unroll
            for (int j = 0; j < 4; ++j) {
                const f32x2 z = unpkh(X[(sg0 + j) * 4096 + fsw(idx)]), zm = unpkh(X[(sg0 + j) * 4096 + fsw(idm)]);
                o[j] = part == 0 ? pkh(0.5f * (z.x + zm.x), 0.5f * (z.y + zm.y)) : pkh(0.5f * (z.y - zm.y), -0.5f * (z.x - zm.x));
            }
            u32x4 ov = {o[0], o[1], o[2], o[3]};
            *(u32x4*)(PQ + ((size_t)(b * SEQ + kf)) * 2048 + cb * 32 + q * 8) = ov;
        }
        __syncthreads();
    }
}

#define MFMA16(a, b, c) __builtin_amdgcn_mfma_f32_16x16x32_f16((a), (b), (c), 0, 0, 0)
DI h16x8 cat4(h16x4 a, h16x4 b) { return __builtin_shufflevector(a, b, 0, 1, 2, 3, 4, 5, 6, 7); }
DI h16x8 packf8(const f32x4& a, const f32x4& b) { const u32x4 w = pack8(a, b); return __builtin_bit_cast(h16x8, w); }
#define TR8I(o, base, O0, O1, O2, O3, O4, O5, O6, O7) \
    asm volatile("ds_read_b64_tr_b16 %0, %8 offset:%9\n\tds_read_b64_tr_b16 %1, %8 offset:%10\n\tds_read_b64_tr_b16 %2, %8 offset:%11\n\tds_read_b64_tr_b16 %3, %8 offset:%12\n\t" \
                 "ds_read_b64_tr_b16 %4, %8 offset:%13\n\tds_read_b64_tr_b16 %5, %8 offset:%14\n\tds_read_b64_tr_b16 %6, %8 offset:%15\n\tds_read_b64_tr_b16 %7, %8 offset:%16" \
                 : "=&v"(o[0]), "=&v"(o[1]), "=&v"(o[2]), "=&v"(o[3]), "=&v"(o[4]), "=&v"(o[5]), "=&v"(o[6]), "=&v"(o[7]) \
                 : "v"(base), "i"(O0), "i"(O1), "i"(O2), "i"(O3), "i"(O4), "i"(O5), "i"(O6), "i"(O7) : "memory")
#define TRWAIT(n, o) asm volatile("s_waitcnt lgkmcnt(" #n ")" : "+v"(o[0]), "+v"(o[1]), "+v"(o[2]), "+v"(o[3]), "+v"(o[4]), "+v"(o[5]), "+v"(o[6]), "+v"(o[7]) :: "memory")

constexpr int SC_OFF = 128 * 544 + 128 * 288 + 1024, SC_STRIDE = 272;
constexpr int SQ_STRIDE = 544, SQQ_STRIDE = 528, SV_STRIDE = 288, SQ_BYTES = 128 * SQ_STRIDE, SV_BYTES = 128 * SV_STRIDE;

#define SBAR() do { asm volatile("s_waitcnt lgkmcnt(0)" ::: "memory"); __builtin_amdgcn_s_barrier(); asm volatile("" ::: "memory"); } while (0)
DI void scan_item(const Params& p, LAS unsigned char* lds, int it, int tid) {
    const int lane = tid & 63, w = __builtin_amdgcn_readfirstlane(tid >> 6), li = lane & 15, g = lane >> 4;
    const h16* Qb = (const h16*)(p.ws + OFF_RA); const h16* Kb = (const h16*)(p.ws + OFF_RB); const h16* Vb = (const h16*)(p.ws + OFF_RC);
    h16* CR = (h16*)(p.ws + OFF_RD);
    const unsigned lbase = (unsigned)(uintptr_t)lds;
    const int b = it >> 4, h = (it >> 2) & 3, dir = (it >> 1) & 1, dvh = it & 1;
    const float lg = dir ? p.lgb[h] : p.lgf[h];
    __syncthreads();
    if (w >= 4) {
        int st = tid - 256; asm volatile("" : "+v"(st));
        u32x4 rqq[16], rqk[16], rv[8];
        const unsigned bigoff = (unsigned)((st >> 5) * DM + (st & 31) * 8), voff = (unsigned)((st >> 4) * DM + (st & 15) * 8);
        LAS unsigned char* const wbig = lds + (st >> 5) * SQ_STRIDE + (st & 31) * 16;
        LAS unsigned char* const wbigq = lds + (st >> 5) * SQQ_STRIDE + (st & 31) * 16;
        LAS unsigned char* const wv = lds + SQ_BYTES + (st >> 4) * SV_STRIDE + (st & 15) * 16;
#define S2_LOADBIG(R, SRC, c_) do { const h16* s_ = (SRC) + ((size_t)b * SEQ + 128 * (c_)) * DM + h * 256; \
        _Pragma("unroll") for (int k_ = 0; k_ < 16; ++k_) R[k_] = *(const u32x4*)(s_ + (size_t)k_ * 8 * DM + bigoff); } while (0)
#define S2_LOADV(c_) do { const h16* s_ = Vb + ((size_t)b * SEQ + 128 * (c_)) * DM + h * 256 + dvh * 128; \
        _Pragma("unroll") for (int k_ = 0; k_ < 8; ++k_) rv[k_] = *(const u32x4*)(s_ + (size_t)k_ * 16 * DM + voff); } while (0)
        S2_LOADBIG(rqq, Qb, dir ? 31 : 0); S2_LOADV(dir ? 31 : 0); S2_LOADBIG(rqk, Kb, dir ? 31 : 0);
        {
            LAS float* dtab = (LAS float*)(lds + SQ_BYTES + SV_BYTES);
            const int j = st & 127;
            dtab[st] = st < 128 ? exp2f(lg * (dir ? (float)(128 - j) : (float)(j + 1))) : exp2f(lg * (dir ? (float)j : (float)(127 - j)));
        }
#pragma unroll 1
        for (int i = 0; i < 32; ++i) {
            const int cn = dir ? 30 - i : i + 1;
#pragma unroll
            for (int k_ = 0; k_ < 16; ++k_) *(LAS u32x4*)(wbigq + k_ * 8 * SQQ_STRIDE) = rqq[k_];
#pragma unroll
            for (int k_ = 0; k_ < 8; ++k_) *(LAS u32x4*)(wv + k_ * 16 * SV_STRIDE) = rv[k_];
            SBAR();
            if (i + 1 < 32) { S2_LOADBIG(rqq, Qb, cn); S2_LOADV(cn); }
            SBAR();
#pragma unroll
            for (int k_ = 0; k_ < 16; ++k_) *(LAS u32x4*)(wbig + k_ * 8 * SQ_STRIDE) = rqk[k_];
            SBAR();
            if (i + 1 < 32) S2_LOADBIG(rqk, Kb, cn);
            {
                const int c = dir ? 31 - i : i;
                h16* crc = CR + (size_t)dir * MTOK * DM + ((size_t)b * SEQ + 128 * c) * DM + h * 256 + dvh * 128;
#pragma unroll
                for (int k_ = 0; k_ < 8; ++k_) { const int pc_ = st + 256 * k_; const u32x4 v_ = *(const LAS u32x4*)(lds + SC_OFF + (pc_ >> 4) * SC_STRIDE + (pc_ & 15) * 16);
                    *(u32x4*)(crc + (size_t)(pc_ >> 4) * DM + (pc_ & 15) * 8) = v_; }
            }
            SBAR();
        }
#undef S2_LOADBIG
#undef S2_LOADV
    } else {
        const float g128 = exp2f(lg * 128.0f);
        f32x4 F[2][16];
#pragma unroll
        for (int nf = 0; nf < 2; ++nf)
#pragma unroll
            for (int i = 0; i < 16; ++i) F[nf][i] = (f32x4){0.f, 0.f, 0.f, 0.f};
#pragma unroll 1
        for (int i = 0; i < 32; ++i) {
            const int c = dir ? 31 - i : i;
            float lgl = lg; int lil = li, gl = g; asm volatile("" : "+v"(lgl), "+v"(lil), "+v"(gl));
            TBEG(4, lds); SBAR(); TEND(4, lds);
            TBEG(2, lds);
#ifndef QREP
#define QREP 1
#endif
#pragma unroll 1
            for (int rr_ = 0; rr_ < QREP; ++rr_) {
                const LAS unsigned char* qr = lds + lil * SQQ_STRIDE + 8 * gl;
#pragma unroll
                for (int hm = 0; hm < 4; ++hm) {
                    f32x4 d[2][2];
#pragma unroll
                    for (int nf = 0; nf < 2; ++nf)
#pragma unroll
                        for (int mf = 0; mf < 2; ++mf) d[nf][mf] = (f32x4){0.f, 0.f, 0.f, 0.f};
#pragma unroll
                    for (int ks = 0; ks < 8; ++ks) {
                        const h16x8 ff0 = packf8(F[0][2 * ks], F[0][2 * ks + 1]), ff1 = packf8(F[1][2 * ks], F[1][2 * ks + 1]);
                        h16x4 q0[2], q1[2];
#pragma unroll
                        for (int mf = 0; mf < 2; ++mf) { q0[mf] = *(const LAS h16x4*)(qr + 16 * (2 * hm + mf) * SQQ_STRIDE + 64 * ks); q1[mf] = *(const LAS h16x4*)(qr + 16 * (2 * hm + mf) * SQQ_STRIDE + 64 * ks + 32); }
#pragma unroll
                        for (int mf = 0; mf < 2; ++mf) { const h16x8 qv = cat4(q0[mf], q1[mf]); d[0][mf] = MFMA16(ff0, qv, d[0][mf]); d[1][mf] = MFMA16(ff1, qv, d[1][mf]); }
                        if ((ks & 3) == 3) __builtin_amdgcn_sched_barrier(0);
                    }
#pragma unroll
                    for (int mf = 0; mf < 2; ++mf) {
                        const int j = 16 * (2 * hm + mf) + lil;
                        const float a = ((const LAS float*)(lds + SQ_BYTES + SV_BYTES))[j];
#pragma unroll
                        for (int nf = 0; nf < 2; ++nf) {
                            u32x2 o; o.x = pkh(d[nf][mf][0] * a, d[nf][mf][1] * a); o.y = pkh(d[nf][mf][2] * a, d[nf][mf][3] * a);
                            *(LAS u32x2*)(lds + SC_OFF + j * SC_STRIDE + (32 * w + 16 * nf + 4 * gl) * 2) = o;
                        }
                    }
                    __builtin_amdgcn_sched_barrier(0);
                }
            }
            TEND(2, lds);
            TBEG(5, lds); SBAR();
            SBAR(); TEND(5, lds);
            TBEG(3, lds);
            {
#pragma unroll
                for (int nf = 0; nf < 2; ++nf)
#pragma unroll
                    for (int fm = 0; fm < 16; ++fm) F[nf][fm] *= g128;
                const unsigned kb = lbase + (4 * gl + (lil >> 2)) * SQ_STRIDE + (lil & 3) * 8;
                const unsigned vb = lbase + SQ_BYTES + (4 * gl + (lil >> 2)) * SV_STRIDE + (32 * w + (lil & 3) * 4) * 2;
#define S2_KOFF(ks2, f4, q, hi) ((ks2) * 32 * SQ_STRIDE + (4 * (f4) + (q)) * 32 + (hi) * 16 * SQ_STRIDE)
#define S2_ISSUE(buf, ks2, f4) TR8I(buf, kb, S2_KOFF(ks2, f4, 0, 0), S2_KOFF(ks2, f4, 0, 1), S2_KOFF(ks2, f4, 1, 0), S2_KOFF(ks2, f4, 1, 1), S2_KOFF(ks2, f4, 2, 0), S2_KOFF(ks2, f4, 2, 1), S2_KOFF(ks2, f4, 3, 0), S2_KOFF(ks2, f4, 3, 1))
#define S2_MMA(buf, f4) do { _Pragma("unroll") for (int q_ = 0; q_ < 4; ++q_) { const h16x8 kf_ = cat4(buf[2 * q_], buf[2 * q_ + 1]); \
                F[0][4 * (f4) + q_] = MFMA16(kf_, vf0, F[0][4 * (f4) + q_]); F[1][4 * (f4) + q_] = MFMA16(kf_, vf1, F[1][4 * (f4) + q_]); } } while (0)
#pragma unroll
                for (int ks2 = 0; ks2 < 4; ++ks2) {
                    h16x4 kA[8], kB[8];
                    h16x8 vf0, vf1;
                    const LAS float* bt_ = (const LAS float*)(lds + SQ_BYTES + SV_BYTES) + 128 + 32 * ks2 + 4 * gl;
                    const f32x4 b0_ = *(const LAS f32x4*)bt_, b1_ = *(const LAS f32x4*)(bt_ + 16);
                    asm volatile("s_waitcnt lgkmcnt(0)" ::: "memory");
                    {
                        h16x4 vt[8];
                        TR8I(vt, vb, ks2 * 32 * SV_STRIDE, ks2 * 32 * SV_STRIDE + 16 * SV_STRIDE, ks2 * 32 * SV_STRIDE + 32, ks2 * 32 * SV_STRIDE + 16 * SV_STRIDE + 32,
                                     ks2 * 32 * SV_STRIDE, ks2 * 32 * SV_STRIDE + 16 * SV_STRIDE, ks2 * 32 * SV_STRIDE + 32, ks2 * 32 * SV_STRIDE + 16 * SV_STRIDE + 32);
                        S2_ISSUE(kA, ks2, 0);
                        TRWAIT(8, vt);
                        vf0 = cat4(vt[0], vt[1]); vf1 = cat4(vt[2], vt[3]);
#pragma unroll
                        for (int e = 0; e < 8; ++e) {
                            const float bj = e < 4 ? b0_[e & 3] : b1_[e & 3];
                            vf0[e] = (h16)((float)vf0[e] * bj); vf1[e] = (h16)((float)vf1[e] * bj);
                        }
                    }
                    S2_ISSUE(kB, ks2, 1); TRWAIT(8, kA); S2_MMA(kA, 0);
                    S2_ISSUE(kA, ks2, 2); TRWAIT(8, kB); S2_MMA(kB, 1);
                    S2_ISSUE(kB, ks2, 3); TRWAIT(8, kA); S2_MMA(kA, 2);
                    TRWAIT(0, kB); S2_MMA(kB, 3);
                    __builtin_amdgcn_sched_barrier(0);
                }
#undef S2_KOFF
#undef S2_ISSUE
#undef S2_MMA
            }
            TEND(3, lds);
            TBEG(6, lds); SBAR(); TEND(6, lds);
        }
    }
    __syncthreads();
}

constexpr int CH_K_STRIDE = 528, CH_V_STRIDE = 544, CH_K_BYTES = 128 * CH_K_STRIDE;
DI void intra_item(const Params& p, LAS unsigned char* lds, int it, int tid) {
    const int lane = tid & 63, w = tid >> 6, li = lane & 15, g = lane >> 4;
    const h16* Qb = (const h16*)(p.ws + OFF_RA); const h16* Kb = (const h16*)(p.ws + OFF_RB); const h16* Vb = (const h16*)(p.ws + OFF_RC);
    h16* YR = (h16*)(p.ws + OFF_RE);
    const unsigned lbase = (unsigned)(uintptr_t)lds;
    const int b = it >> 7, h = (it >> 5) & 3, c = it & 31;
    const size_t row0 = (size_t)b * SEQ + 128 * c;
    const float lgf = p.lgf[h], lgb = p.lgb[h];
    __syncthreads();
    {
        const h16* ks = Kb + row0 * DM + h * 256; const h16* vs = Vb + row0 * DM + h * 256;
        u32x4 r[8];
#pragma unroll
        for (int k = 0; k < 8; ++k) { const int pc = tid + 512 * k; r[k] = *(const u32x4*)(ks + (size_t)(pc >> 5) * DM + (pc & 31) * 8); }
#pragma unroll
        for (int k = 0; k < 8; ++k) { const int pc = tid + 512 * k; *(LAS u32x4*)(lds + (pc >> 5) * CH_K_STRIDE + (pc & 31) * 16) = r[k]; }
#pragma unroll
        for (int k = 0; k < 8; ++k) { const int pc = tid + 512 * k; r[k] = *(const u32x4*)(vs + (size_t)(pc >> 5) * DM + (pc & 31) * 8); }
#pragma unroll
        for (int k = 0; k < 8; ++k) { const int pc = tid + 512 * k; *(LAS u32x4*)(lds + CH_K_BYTES + (pc >> 5) * CH_V_STRIDE + (pc & 31) * 16) = r[k]; }
    }
    const int jabs = 16 * w + li;
    const size_t prow = row0 + jabs;
    h16x8 qf[8];
#pragma unroll
    for (int ks = 0; ks < 8; ++ks) qf[ks] = *(const h16x8*)(Qb + prow * DM + h * 256 + 32 * ks + 8 * g);
    __syncthreads();
    h16x8 pf[4];
#pragma unroll
    for (int mf2 = 0; mf2 < 4; ++mf2) {
        f32x4 s2[2];
#pragma unroll
        for (int hh = 0; hh < 2; ++hh) {
            const int mf = 2 * mf2 + hh;
            f32x4 s = (f32x4){0.f, 0.f, 0.f, 0.f};
            const LAS unsigned char* kr = lds + (16 * mf + li) * CH_K_STRIDE + 16 * g;
#pragma unroll
            for (int ks = 0; ks < 8; ++ks) s = MFMA16(*(const LAS h16x8*)(kr + 64 * ks), qf[ks], s);
#pragma unroll
            for (int r = 0; r < 4; ++r) {
                const int m = 16 * mf + 4 * g + r, df = jabs - m;
                const float dec = df >= 0 ? exp2f(lgf * (float)df) : exp2f(lgb * (float)(-df));
                s[r] *= dec;
            }
            s2[hh] = s;
        }
        pf[mf2] = packf8(s2[0], s2[1]);
    }
    const unsigned vb = lbase + CH_K_BYTES + (4 * g + (li >> 2)) * CH_V_STRIDE + (li & 3) * 8;
    h16* yo = YR + prow * DM + h * 256 + 4 * g;
#define IN_ISSUE(buf, df) TR8I(buf, vb, (df) * 32 + 0 * 32 * CH_V_STRIDE, (df) * 32 + 0 * 32 * CH_V_STRIDE + 16 * CH_V_STRIDE, (df) * 32 + 1 * 32 * CH_V_STRIDE, (df) * 32 + 1 * 32 * CH_V_STRIDE + 16 * CH_V_STRIDE, \
                                       (df) * 32 + 2 * 32 * CH_V_STRIDE, (df) * 32 + 2 * 32 * CH_V_STRIDE + 16 * CH_V_STRIDE, (df) * 32 + 3 * 32 * CH_V_STRIDE, (df) * 32 + 3 * 32 * CH_V_STRIDE + 16 * CH_V_STRIDE)
#define IN_MMA(buf, df) do { f32x4 o_ = (f32x4){0.f, 0.f, 0.f, 0.f}; _Pragma("unroll") for (int ks_ = 0; ks_ < 4; ++ks_) o_ = MFMA16(cat4(buf[2 * ks_], buf[2 * ks_ + 1]), pf[ks_], o_); \
        u32x2 ov_; ov_.x = pkh(o_[0], o_[1]); ov_.y = pkh(o_[2], o_[3]); *(u32x2*)(yo + 16 * (df)) = ov_; } while (0)
    h16x4 vA[8], vB[8];
    IN_ISSUE(vA, 0);
#pragma unroll
    for (int df = 0; df < 16; df += 2) {
        IN_ISSUE(vB, df + 1);
        TRWAIT(8, vA);
        IN_MMA(vA, df);
        if (df + 2 < 16) { IN_ISSUE(vA, df + 2); TRWAIT(8, vB); } else { TRWAIT(0, vB); }
        IN_MMA(vB, df + 1);
    }
#undef IN_ISSUE
#undef IN_MMA
}

DI void phase_mix(const Params& p, int l, LAS unsigned char* lds) {
    const int tid = ltid();
    const int nb = (int)gridDim.x, bid = (int)blockIdx.x;
    const bool std = nb == 256;
#ifndef MIXPART
#define MIXPART 7
#endif
#ifndef SCANREP
#define SCANREP 1
#endif
#ifndef INTRAREP
#define INTRAREP 1
#endif
    if (MIXPART & 1) for (int r_ = 0; r_ < SCANREP; ++r_) for (int it = bid; it < 128; it += nb) { TBEG(1, lds); scan_item(p, lds, it, tid); TEND(1, lds); }
    TBEG(8, lds);
    if ((MIXPART & 2) && (!std || bid >= 128)) {
        convert_rest(p, l, lds, std ? bid - 128 : bid, std ? 128 : nb, tid);
        __syncthreads();
        h16* W = (h16*)(p.ws + OFF_W);
        pg8::Gemm gg; gg.A = W + W_FT; gg.Bt = W + W_DF; gg.M = 1024; gg.N = 2048; gg.K = 1024; gg.a_rows = 256;
        pg8::StaticOrder S; S.init(1024, 2048, std ? 128 : nb, std ? bid - 128 : bid);
        EpiStore E; E.O = W + W_F2; E.ldc = 2048;
        pg8::gemm_phase<EpiStore, pg8::StaticOrder, false>(lds, gg, S, E, nullptr);
    }
    TEND(8, lds);
    __syncthreads();
    int i0, cnt, stride;
    if (std) { if (bid < 128) { i0 = 0; cnt = 0; } else { i0 = (bid - 128) * 8; cnt = 8; } stride = 1; }
    else { i0 = bid; cnt = (1024 - bid + nb - 1) / nb; stride = nb; }
    TBEG(7, lds);
    if (MIXPART & 4) for (int r_ = 0; r_ < INTRAREP; ++r_) for (int k = 0; k < cnt; ++k) intra_item(p, lds, i0 + k * stride, tid);
    TEND(7, lds);
}

DI void phase_partB(const Params& p) {
    const int tid = ltid(), lane = tid & 63, wave = tid >> 6;
    const int gw = blockIdx.x * 8 + wave, NGW = gridDim.x * 8;
    h16* YR = (h16*)(p.ws + OFF_RE); const h16* CR = (const h16*)(p.ws + OFF_RD);
    for (int row = gw; row < MTOK; row += NGW) {
        const size_t o = (size_t)row * DM + lane * 16;
        float v[16];
#pragma unroll
        for (int hh = 0; hh < 2; ++hh) {
            const u32x4 a = *(const u32x4*)(YR + o + 8 * hh), c0 = *(const u32x4*)(CR + o + 8 * hh), c1 = *(const u32x4*)(CR + (size_t)MTOK * DM + o + 8 * hh);
#pragma unroll
            for (int e = 0; e < 4; ++e) { const f32x2 x = unpkh(a[e]), y = unpkh(c0[e]), z = unpkh(c1[e]); v[8 * hh + 2 * e] = x.x + y.x + z.x; v[8 * hh + 2 * e + 1] = x.y + y.y + z.y; }
        }
        float s = 0.f;
#pragma unroll
        for (int e = 0; e < 16; ++e) s += v[e];
        s += __shfl_xor(s, 1); s += __shfl_xor(s, 2); s += __shfl_xor(s, 4); s += __shfl_xor(s, 8);
        const float mu = s * (1.0f / 256.0f);
        float q2 = 0.f;
#pragma unroll
        for (int e = 0; e < 16; ++e) { v[e] -= mu; q2 += v[e] * v[e]; }
        q2 += __shfl_xor(q2, 1); q2 += __shfl_xor(q2, 2); q2 += __shfl_xor(q2, 4); q2 += __shfl_xor(q2, 8);
        const float rs = rsqrtf(q2 * (1.0f / 256.0f) + EPS);
#pragma unroll
        for (int hh = 0; hh < 2; ++hh) {
            u32x4 ov;
#pragma unroll
            for (int e = 0; e < 4; ++e) ov[e] = pkh(v[8 * hh + 2 * e] * rs, v[8 * hh + 2 * e + 1] * rs);
            *(u32x4*)(YR + o + 8 * hh) = ov;
        }
    }
}

DI h16x2 u2h(unsigned u) { return __builtin_bit_cast(h16x2, u); }
DI void phase_conv(const Params& p, int l, int half) {
    const h16* U = (const h16*)(p.ws + OFF_RA); h16* HID = (h16*)(p.ws + OFF_RD);
    const float* cw = p.conv_w + (size_t)l * 3 * 2 * DFF; const float* cbias = p.conv_b + (size_t)l * 2 * DFF;
    constexpr int RB = 8, NCG = DFF / 8, NU = (MTOK / 2 / RB) * NCG;
    const int tid = ltid();
    for (int un = blockIdx.x * NTHR + tid; un < NU; un += gridDim.x * NTHR) {
        const int rb = un / NCG, cg_ = un - rb * NCG, r0 = rb * RB, n0 = cg_ * 8;
        const int pos0 = r0 & (SEQ - 1);
        const h16* ur = U + (size_t)r0 * (2 * DFF) + n0;
        u32x4 ra[RB + 2], rbv[RB + 2];
        const bool okp = pos0 != 0, okn = (pos0 + RB) < SEQ;
#pragma unroll
        for (int r = 0; r < RB + 2; ++r) {
            const bool ok = (r == 0) ? okp : ((r == RB + 1) ? okn : true);
            ra[r] = (u32x4){0u, 0u, 0u, 0u}; rbv[r] = (u32x4){0u, 0u, 0u, 0u};
            if (ok) { ra[r] = *(const u32x4*)(ur + (ptrdiff_t)(r - 1) * (2 * DFF)); rbv[r] = *(const u32x4*)(ur + (ptrdiff_t)(r - 1) * (2 * DFF) + DFF); }
        }
        h16x2 wa[3][4], wb[3][4], ba[4], bb[4];
#pragma unroll
        for (int i = 0; i < 3; ++i)
#pragma unroll
            for (int e = 0; e < 2; ++e) {
                const f32x4 x = *(const f32x4*)(cw + i * 2 * DFF + n0 + 4 * e), y = *(const f32x4*)(cw + i * 2 * DFF + DFF + n0 + 4 * e);
                wa[i][2 * e] = (h16x2){(h16)x.x, (h16)x.y}; wa[i][2 * e + 1] = (h16x2){(h16)x.z, (h16)x.w};
                wb[i][2 * e] = (h16x2){(h16)y.x, (h16)y.y}; wb[i][2 * e + 1] = (h16x2){(h16)y.z, (h16)y.w};
            }
#pragma unroll
        for (int e = 0; e < 2; ++e) {
            const f32x4 x = *(const f32x4*)(cbias + n0 + 4 * e), y = *(const f32x4*)(cbias + DFF + n0 + 4 * e);
            ba[2 * e] = (h16x2){(h16)x.x, (h16)x.y}; ba[2 * e + 1] = (h16x2){(h16)x.z, (h16)x.w};
            bb[2 * e] = (h16x2){(h16)y.x, (h16)y.y}; bb[2 * e + 1] = (h16x2){(h16)y.z, (h16)y.w};
        }
#pragma unroll
        for (int r = 0; r < RB; ++r) {
            u32x4 ov;
#pragma unroll
            for (int e = 0; e < 4; ++e) {
                const h16x2 av = wa[0][e] * u2h(ra[r][e]) + (wa[1][e] * u2h(ra[r + 1][e]) + (wa[2][e] * u2h(ra[r + 2][e]) + ba[e]));
                const h16x2 bv = wb[0][e] * u2h(rbv[r][e]) + (wb[1][e] * u2h(rbv[r + 1][e]) + (wb[2][e] * u2h(rbv[r + 2][e]) + bb[e]));
                const f32x2 gl = gelu_pk((f32x2){(float)av.x, (float)av.y});
                ov[e] = pkh(gl.x * (float)bv.x, gl.y * (float)bv.y);
            }
            *(u32x4*)(HID + (size_t)(r0 + r) * DFF + n0) = ov;
        }
    }
}

template <class Epi> DI void run_gemm(LAS unsigned char* lds, const h16* A, const h16* Bt, int M, int N, int K, const Epi& E) {
    pg8::Gemm g; g.A = A; g.Bt = Bt; g.M = M; g.N = N; g.K = K; g.a_rows = 256;
    pg8::StaticOrder S; S.init(M, N, (int)gridDim.x, (int)blockIdx.x);
    pg8::gemm_phase<Epi, pg8::StaticOrder, false>(lds, g, S, E, nullptr);
}

DI void run_phase(const Params& p, int ph, LAS unsigned char* lds) {
    unsigned char* ws = p.ws;
    h16* W = (h16*)(ws + OFF_W); h16* H = (h16*)(ws + OFF_H);
    h16* RA = (h16*)(ws + OFF_RA); h16* RB = (h16*)(ws + OFF_RB); h16* RC = (h16*)(ws + OFF_RC); h16* RD = (h16*)(ws + OFF_RD); h16* RE = (h16*)(ws + OFF_RE);
#ifndef PHMASK
#define PHMASK 0xFFFFF
#endif
#define PHON(k) ((PHMASK >> (k)) & 1)
    if (ph == 0) { if (PHON(16)) phase_prep(p, lds); return; }
    if (ph == 1 + NST * NLAYER) { if (PHON(17)) phase_final(p, lds); return; }
    const int l = (ph - 1) / NST, st = (ph - 1) % NST;
    const float* MODl = (const float*)(ws + OFF_MOD) + (size_t)l * 8 * 6144;
    switch (st) {
    case 0: if (PHON(0)) phase_p1(p, l, lds); break;
    case 1: if (PHON(1)) { EpiQKV E; E.Q = RA; E.cosT = (const float*)(ws + OFF_COS); E.sinT = (const float*)(ws + OFF_SIN); run_gemm(lds, H, W + W_QKV, MTOK, 3072, 1024, E); } break;
    case 2: if (PHON(2)) phase_mix(p, l, lds); break;
    case 3: if (PHON(3)) phase_partB(p); break;
    case 4: if (PHON(4)) { EpiB E; E.ws = ws; run_gemm(lds, H, W + W_B, MTOK, 4096, 1024, E); } break;
    case 5: if (PHON(5)) phase_fft(p, lds); break;
    case 6: if (PHON(6)) {
        { EpiMerge<0> E; E.T = RC; E.G = RA; run_gemm(lds, RD, W + W_F2, MTOK, 1024, 2048, E); }
        asm volatile("s_waitcnt vmcnt(0)" ::: "memory"); __syncthreads();
        { EpiMerge<1> E; E.T = RC; E.G = RB; run_gemm(lds, RE, W + W_R, MTOK, 1024, 1024, E); } } break;
    case 7: if (PHON(8)) { EpiRes E; E.xi = (l == 0) ? p.x : p.out; E.xo = p.out; E.gate = MODl + 2048; E.rowoff = 0; run_gemm(lds, RC, W + W_O, MTOK, 1024, 1024, E); } break;
    case 8: if (PHON(9)) phase_norm2(p, l); break;
    case 9: if (PHON(10)) {
        EpiUpConv E; E.HID = RD; E.cw = p.conv_w + (size_t)l * 3 * 2 * DFF; E.cb = p.conv_b + (size_t)l * 2 * DFF; E.lds = lds;
        pg8::Gemm g; g.A = H - DM; g.Bt = W + W_UP; g.M = 130 * 256; g.N = 2 * DFF; g.K = 1024; g.a_rows = 254;
        pg8::StaticOrder S; S.init(130 * 256, 2 * DFF, (int)gridDim.x, (int)blockIdx.x);
        pg8::gemm_phase<EpiUpConv, pg8::StaticOrder, false>(lds, g, S, E, nullptr); } break;
    case 10: if (PHON(12)) { EpiRes E; E.xi = p.out; E.xo = p.out; E.gate = MODl + 5120; E.rowoff = 0; run_gemm(lds, RD, W + W_DN, MTOK, 1024, DFF, E); } break;
    }
}


#define XB_TMO      128
#define XB_XCNT(j)  (256  + 64 * (j))
#define XB_XSUB(j)  (1280 + 64 * (j))
#define XB_XGEN(j)  (2304 + 64 * (j))
#define XB_TOP      3328
#define XB_TOPGEN   3392
#define XCD_BAR_WORDS 3456
#define XB_SPIN_CAP (1u << 18)
DI unsigned xb_ld(unsigned* p)              { return __hip_atomic_load(p, __ATOMIC_RELAXED, __HIP_MEMORY_SCOPE_AGENT); }
DI unsigned xb_add(unsigned* p, unsigned v) { return __hip_atomic_fetch_add(p, v, __ATOMIC_RELAXED, __HIP_MEMORY_SCOPE_AGENT); }
DI unsigned xb_xcc_id() { return (unsigned)__builtin_amdgcn_s_getreg((3 << 11) | 20) & 0xFu; }
#define XB_SPIN(cond, bar) do { unsigned _sp = 0; while (cond) { __builtin_amdgcn_s_sleep(1); \
    if ((++_sp & 255u) == 0u) { if (xb_ld(&(bar)[XB_TMO])) break; if (_sp > XB_SPIN_CAP) { atomicAdd(&(bar)[XB_TMO], 1u); break; } } } } while (0)
DI void xcd_barrier_complete(unsigned* bar, unsigned x, unsigned& nloc, unsigned& nx) {
    const unsigned G = gridDim.x;
    unsigned sum, cnt, mine, sp = 0u;
    for (;;) {
        sum = 0u; cnt = 0u; mine = 0u;
#pragma unroll
        for (unsigned j = 0; j < 16; ++j) { const unsigned c = xb_ld(&bar[XB_XCNT(j)]); sum += c; cnt += (c > 0u) ? 1u : 0u; mine = (j == x) ? c : mine; }
        if (sum == G) break;
        __builtin_amdgcn_s_sleep(1);
        if ((++sp & 255u) == 0u) { if (xb_ld(&bar[XB_TMO])) break; if (sp > XB_SPIN_CAP) { atomicAdd(&bar[XB_TMO], 1u); break; } }
    }
    nloc = mine > 0u ? mine : 1u; nx = cnt > 0u ? cnt : 1u;
}
DI void xcd_barrier(unsigned* bar, unsigned x, volatile LAS unsigned* st) {
    asm volatile("s_waitcnt vmcnt(0)" ::: "memory");
    __syncthreads();
    if (threadIdx.x == 0) {
        __builtin_amdgcn_s_waitcnt(0);
        unsigned nloc = st[0], nx = st[1];
        if (nloc == 0u) { xcd_barrier_complete(bar, x, nloc, nx); st[0] = nloc; st[1] = nx; }
        const unsigned old = xb_add(&bar[XB_XSUB(x)], 1u);
        const unsigned gen = old / nloc;
        if (old + 1u == (gen + 1u) * nloc) {
            __builtin_amdgcn_fence(__ATOMIC_RELEASE, "agent");
            asm volatile("s_waitcnt vmcnt(0)" ::: "memory");
            const unsigned og = xb_add(&bar[XB_TOP], 1u);
            const unsigned tg = og / nx;
            if (og + 1u == (tg + 1u) * nx) xb_add(&bar[XB_TOPGEN], 1u);
            else XB_SPIN(xb_ld(&bar[XB_TOPGEN]) == tg, bar);
            __builtin_amdgcn_fence(__ATOMIC_ACQUIRE, "agent");
            xb_add(&bar[XB_XGEN(x)], 1u);
            asm volatile("s_waitcnt vmcnt(0)" ::: "memory");
        } else {
            XB_SPIN(xb_ld(&bar[XB_XGEN(x)]) == gen, bar);
            __builtin_amdgcn_fence(__ATOMIC_ACQUIRE, "agent");
            asm volatile("s_waitcnt vmcnt(0)" ::: "memory");
        }
    }
    __syncthreads();
}
#define LIGHT_BARRIER() do { \
                ++nbar; \
                asm volatile("s_waitcnt vmcnt(0)" ::: "memory");       \
                __syncthreads(); \
                if (threadIdx.x == 0) { \
                    __builtin_amdgcn_fence(__ATOMIC_RELEASE, "agent");   \
                    asm volatile("s_waitcnt vmcnt(0)" ::: "memory"); \
                    __hip_atomic_fetch_add(bar, 1u, __ATOMIC_RELAXED, __HIP_MEMORY_SCOPE_AGENT); \
                    const unsigned target = nbar * gridDim.x; \
                    const unsigned long long t0 = __builtin_amdgcn_s_memrealtime(); \
                    while (__hip_atomic_load(bar, __ATOMIC_RELAXED, __HIP_MEMORY_SCOPE_AGENT) < target) { \
                        __builtin_amdgcn_s_sleep(1); \
                        if (__builtin_amdgcn_s_memrealtime() - t0 > 20000000ull) break;      \
                    } \
                    __builtin_amdgcn_fence(__ATOMIC_ACQUIRE, "agent");   \
                    asm volatile("s_waitcnt vmcnt(0)" ::: "memory"); \
                } \
                __syncthreads(); \
             \
} while (0)
template <class T> DI T* launder(T* p) {
    unsigned lo = (unsigned)(uintptr_t)p, hi = (unsigned)((uintptr_t)p >> 32);
    asm volatile("" : "+v"(lo), "+v"(hi));
    lo = __builtin_amdgcn_readfirstlane(lo); hi = __builtin_amdgcn_readfirstlane(hi);
    return (T*)(((uintptr_t)hi << 32) | (uintptr_t)lo);
}
__global__ void __launch_bounds__(512, 2) fwd_megakernel(Params p) {
    extern __shared__ __attribute__((aligned(16))) unsigned char smem[];
    LAS unsigned char* lds = (LAS unsigned char*)smem;
    cg::grid_group grid = cg::this_grid();
    if (TSEL != 0 && threadIdx.x == 0) { TWORDS(lds)[0] = 0ull; TWORDS(lds)[1] = 0ull; }
    volatile LAS unsigned* xst = (volatile LAS unsigned*)(lds + 163840 - 64);
    const unsigned xcc = xb_xcc_id();
    if (threadIdx.x == 0) { xst[0] = 0u; xst[1] = 0u; (void)xb_add(&((unsigned*)(p.ws + OFF_BAR))[XB_XCNT(xcc)], 1u); }
    __syncthreads();
#ifndef REPMASK
#define REPMASK 0
#endif
    int rep = 0; unsigned nbar = 0;
    unsigned* bar = (unsigned*)(p.ws + OFF_BAR);
    for (int ph = p.ph0; ph < p.ph1;) {
        run_phase(p, ph, lds);
        const bool again = REPMASK != 0 && rep == 0 && ph >= 1 && ph < 1 + NST * NLAYER && ((REPMASK >> ((ph - 1) % NST)) & 1);
        if (again) rep = 1; else { rep = 0; ++ph; }
        if (ph < p.ph1) {
            if (ph == 1 && rep == 0) grid.sync();
            else {
                xcd_barrier(bar, xcc, xst);
            }
#ifdef EXTRASYNC
            LIGHT_BARRIER(); LIGHT_BARRIER();
#endif
        }
    }
}

extern "C" void kernel_launch(void* const* d_in, const int* in_sizes, int n_in, void* d_out, int out_size, void* d_ws, size_t ws_size, hipStream_t stream) {
    static int grid = 0;
    if (grid == 0) {
        int dev = 0, cus = 0, per_cu = 0;
        hipGetDevice(&dev);
        hipDeviceGetAttribute(&cus, hipDeviceAttributeMultiprocessorCount, dev);
        if (hipFuncSetAttribute((const void*)fwd_megakernel, hipFuncAttributeMaxDynamicSharedMemorySize, LDS_BYTES) != hipSuccess) fprintf(stderr, "kernel_launch: hipFuncSetAttribute failed\n");
        hipOccupancyMaxActiveBlocksPerMultiprocessor(&per_cu, (const void*)fwd_megakernel, NTHR, LDS_BYTES);
        if (per_cu < 1) { fprintf(stderr, "kernel_launch: occupancy query says %d blocks per CU\n", per_cu); per_cu = 1; }
        (void)hipGetLastError();
        grid = cus * 1;
        if (ws_size < WS_END) fprintf(stderr, "kernel_launch: workspace too small: %zu < %zu\n", ws_size, (size_t)WS_END);
        fprintf(stderr, "kernel_launch: grid %d (cus %d, per_cu %d), ws %zu need %zu\n", grid, cus, per_cu, ws_size, (size_t)WS_END);
    }
    Params p{};
    const float* const* in = (const float* const*)d_in;
    p.x = in[0]; p.c = in[1]; p.n1g = in[2]; p.n2g = in[3]; p.ada_w = in[4]; p.ada_b = in[5]; p.w_in = in[6]; p.w_f = in[7]; p.w_r = in[8]; p.w_o = in[9];
    p.w_up = in[10]; p.conv_w = in[11]; p.conv_b = in[12]; p.w_dn = in[13]; p.fin_g = in[14];
    p.out = (float*)d_out; p.ws = (unsigned char*)d_ws;
    for (int h = 0; h < 4; ++h) {
        p.lgf[h] = (float)(std::log1p(-std::exp2(-5.0 - h)) / std::log(2.0));
        p.lgb[h] = (float)(std::log1p(-std::exp2(-5.5 - h)) / std::log(2.0));
    }
    constexpr int NPH = 2 + NST * NLAYER;
#if MULTI_LAUNCH
    for (int ph = 0; ph < NPH; ++ph) {
        p.ph0 = ph; p.ph1 = ph + 1;
        hipLaunchKernelGGL(fwd_megakernel, dim3(grid), dim3(NTHR), LDS_BYTES, stream, p);
    }
#else
    p.ph0 = 0; p.ph1 = NPH;
    (void)hipMemsetAsync((unsigned char*)d_ws + OFF_BAR, 0, 16384, stream);
    void* args[] = {&p};
    hipError_t e = hipLaunchCooperativeKernel((const void*)fwd_megakernel, dim3(grid), dim3(NTHR), args, LDS_BYTES, stream);
    if (e != hipSuccess) fprintf(stderr, "cooperative launch failed: %s (grid %d)\n", hipGetErrorString(e), grid);
#endif
}
```

```cpp
#include <hip/hip_runtime.h>
#include <hip/hip_cooperative_groups.h>
#include <cstdio>
#include <cstdint>
#include <cmath>
namespace cg = cooperative_groups;

#ifndef MULTI_LAUNCH
#define MULTI_LAUNCH 0
#endif

#define DI __device__ __forceinline__
#define LAS __attribute__((address_space(3)))
typedef _Float16 h16;
typedef h16 h16x2 __attribute__((ext_vector_type(2)));
typedef h16 h16x4 __attribute__((ext_vector_type(4)));
typedef h16 h16x8 __attribute__((ext_vector_type(8)));
typedef float f32x2 __attribute__((ext_vector_type(2)));
typedef float f32x4 __attribute__((ext_vector_type(4)));
typedef unsigned u32x2 __attribute__((ext_vector_type(2)));
typedef unsigned u32x4 __attribute__((ext_vector_type(4)));

constexpr int MTOK = 32768, DM = 1024, SEQ = 4096, NLAYER = 4, DFF = 2816, DIN = 7168;
constexpr float EPS = 1e-6f;

#ifndef TSEL
#define TSEL 0
#endif
#ifndef TBLK
#define TBLK 0
#endif
#ifndef TMAX_US
#define TMAX_US 2000.0f
#endif
#define TWORDS(lds_) ((LAS unsigned long long*)((lds_) + 163840 - 32))
#define TBEG(id, lds_) do { if (TSEL == (id) && blockIdx.x == TBLK && threadIdx.x == (TBLK >= 128 ? 0 : 0)) TWORDS(lds_)[0] = __builtin_amdgcn_s_memrealtime(); } while (0)
#define TEND(id, lds_) do { if (TSEL == (id) && blockIdx.x == TBLK && threadIdx.x == 0) TWORDS(lds_)[1] += __builtin_amdgcn_s_memrealtime() - TWORDS(lds_)[0]; } while (0)
DI int ltid() { int t = threadIdx.x; asm volatile("" : "+v"(t)); return t; }
DI unsigned pkh(float lo, float hi) { h16x2 v = {(h16)lo, (h16)hi}; return __builtin_bit_cast(unsigned, v); }
DI f32x2 unpkh(unsigned u) { h16x2 v = __builtin_bit_cast(h16x2, u); return (f32x2){(float)v.x, (float)v.y}; }
DI float wave_sum(float v) {
#pragma unroll
    for (int o = 1; o < 64; o <<= 1) v += __shfl_xor(v, o);
    return v;
}
DI float sigmoidf_(float x) { return 1.0f / (1.0f + __expf(-x)); }

namespace pg8 {
#define PG8_LAS __attribute__((address_space(3)))
typedef h16 bf16_t;
typedef h16x8 bf16x8;
constexpr int BM = 256, BK = 64, HALF = 128, HTB = HALF * BK * 2, STAGE_BYTES = 8 * HTB, NXCD = 8, WGM = 8;
__host__ __device__ __forceinline__ int lds_byte(int r, int c) { const int st = (r >> 4) * 2 + (c >> 5), rr = r & 15, cc = c & 31, ob = rr * 64 + cc * 2; return st * 1024 + (ob ^ (((ob >> 9) & 1) << 5)); }
__host__ __device__ __forceinline__ void stage_rc(int b, int& R, int& C) { const int st = b / 1024, sb = b % 1024, swz = sb ^ (((sb >> 9) & 1) << 5); R = (st >> 1) * 16 + swz / 64; C = (st & 1) * 32 + (swz % 64) / 2; }
__host__ __device__ __forceinline__ int perm32(int rho) { const int n = rho >> 4, i = rho & 15; return 8 * (i >> 2) + 4 * n + (i & 3); }
struct Unit { int pm, pn; };
struct Gemm { const bf16_t* A; const bf16_t* Bt; int M, N, K; int a_rows; };
struct StaticOrder {
    int nM, nN, nwg, G, c;
    __host__ __device__ void init(int M, int N, int G_, int c_) { nM = M / BM; nN = N / BM; nwg = nM * nN; G = G_; c = c_; }
    __host__ __device__ bool next(int i, Unit& u) const {
        const long L = (long)i * G + c; if (L >= nwg) return false;
        int wgid = (int)L; { const int q = nwg / NXCD, r = nwg % NXCD, xcd = wgid % NXCD, off = wgid / NXCD; wgid = (xcd < r ? xcd * (q + 1) : r * (q + 1) + (xcd - r) * q) + off; }
        const int nig = WGM * nN, gid = wgid / nig, fm = gid * WGM, gsz = (nM - fm) < WGM ? (nM - fm) : WGM;
        u.pm = fm + ((wgid % nig) % gsz); u.pn = (wgid % nig) / gsz; return true;
    }
    __device__ __forceinline__ void a_ready(const Unit&) const {}
    __device__ __forceinline__ void done(const Unit&) const {}
};
template <class Epi, class Sched, bool STAMP = false>
__device__ __forceinline__ void gemm_phase(PG8_LAS unsigned char* lds, const Gemm g, const Sched& S, const Epi& E, unsigned long long* stamps) {
    const int tid = ltid(), wid = __builtin_amdgcn_readfirstlane(tid >> 6), lane = tid & 63, wr = wid >> 2, wc = wid & 3, fr = lane & 15, fq = lane >> 4;
    const int K = g.K, nt = K / BK;
    int ts_lo = 0, ts_hi = 0, nts = 0; const unsigned long long rt_entry = STAMP ? (unsigned long long)wall_clock64() : 0ull;
#define PG8_STAMP() do { if (STAMP && wid == 0 && nts < 64) { const unsigned long long _c = (unsigned long long)clock64(); \
        ts_lo = (lane == nts) ? (int)(unsigned)_c : ts_lo; ts_hi = (lane == nts) ? (int)(unsigned)(_c >> 32) : ts_hi; ++nts; } } while (0)
    PG8_STAMP();
    unsigned voffA[2], voffB[2];
#pragma unroll
    for (int i = 0; i < 2; ++i) { int R, C; stage_rc(tid * 16 + i * 8192, R, C); const int Rb = Epi::PERM ? ((R & ~31) + perm32(R & 31)) : R;
        voffA[i] = (unsigned)(R * K + C) * 2u; voffB[i] = (unsigned)(Rb * K + C) * 2u; }
    const size_t kstep = (size_t)(BK * 2);
    const size_t hstep = (size_t)HALF * K * 2;
    const size_t tstep = 2 * hstep;
    const size_t tstepA = (size_t)g.a_rows * K * 2;
    const unsigned ldsw = (unsigned)wid * 1024u;
    const int aoff = lds_byte(wr * 64 + fr, fq * 8), boff = lds_byte(wc * 32 + fr, fq * 8);
#define PG8_SA(b, h) (((b) * 2 + (h)) * HTB)
#define PG8_SB(b, h) ((4 + (b) * 2 + (h)) * HTB)
#define PG8_STAGE(bufoff, gbase, voff) do { _Pragma("unroll") for (int _i = 0; _i < 2; ++_i) \
        __builtin_amdgcn_global_load_lds((const unsigned*)((const char*)(gbase) + (voff)[_i]), (PG8_LAS unsigned*)(lds + (bufoff) + ldsw + _i * 8192), 16, 0, 0); } while (0)
#define PG8_LDA(dst, b, h) do { _Pragma("unroll") for (int m = 0; m < 4; ++m) _Pragma("unroll") for (int k = 0; k < 2; ++k) dst[m][k] = *(const PG8_LAS bf16x8*)(lds + PG8_SA(b, h) + aoff + m * 2048 + k * 1024); } while (0)
#define PG8_LDB(dst, b, h) do { _Pragma("unroll") for (int n = 0; n < 2; ++n) _Pragma("unroll") for (int k = 0; k < 2; ++k) dst[n][k] = *(const PG8_LAS bf16x8*)(lds + PG8_SB(b, h) + boff + n * 2048 + k * 1024); } while (0)
#define PG8_MMA(ai, bj, At, Bt) do { __builtin_amdgcn_s_setprio(1); _Pragma("unroll") for (int m = 0; m < 4; ++m) _Pragma("unroll") for (int n = 0; n < 2; ++n) _Pragma("unroll") for (int k = 0; k < 2; ++k) \
        acc[ai][bj][m][n] = __builtin_amdgcn_mfma_f32_16x16x32_f16(Bt[n][k], At[m][k], acc[ai][bj][m][n], 0, 0, 0); __builtin_amdgcn_s_setprio(0); } while (0)
#define PG8_WAIT_V(n) asm volatile("s_waitcnt vmcnt(" #n ")" ::: "memory")
#define PG8_WAIT_L(n) asm volatile("s_waitcnt lgkmcnt(" #n ")" ::: "memory")
#define PG8_BAR __builtin_amdgcn_s_barrier()
#define PG8_SCHED __builtin_amdgcn_sched_barrier(0)
    Unit cur, nxt; int ui = 0;
    if (!S.next(0, cur)) return;
    f32x4 acc[2][2][4][2];
#pragma unroll
    for (int a = 0; a < 2; ++a)
#pragma unroll
        for (int b = 0; b < 2; ++b)
#pragma unroll
            for (int m = 0; m < 4; ++m)
#pragma unroll
                for (int n = 0; n < 2; ++n) acc[a][b][m][n] = (f32x4){0.f, 0.f, 0.f, 0.f};
    bf16x8 At[4][2], B0[2][2], B1[2][2];
    const char* cA = (const char*)g.A + (size_t)cur.pm * tstepA; const char* cB = (const char*)g.Bt + (size_t)cur.pn * tstep;
    S.a_ready(cur);
    PG8_STAGE(PG8_SB(0, 0), cB, voffB); PG8_STAGE(PG8_SA(0, 0), cA, voffA); PG8_STAGE(PG8_SB(0, 1), cB + hstep, voffB); PG8_STAGE(PG8_SA(0, 1), cA + hstep, voffA);
    if (wr == 1) PG8_BAR;
    PG8_WAIT_V(4); PG8_BAR;
    PG8_STAGE(PG8_SB(1, 0), cB + kstep, voffB); PG8_STAGE(PG8_SA(1, 0), cA + kstep, voffA); PG8_STAGE(PG8_SB(1, 1), cB + hstep + kstep, voffB);
    PG8_WAIT_V(6); PG8_BAR;
    PG8_STAMP();
    for (;;) {
        const bool has_next = S.next(ui + 1, nxt);
        const char* nA = has_next ? (const char*)g.A + (size_t)nxt.pm * tstepA : cA; const char* nB = has_next ? (const char*)g.Bt + (size_t)nxt.pn * tstep : cB;
        for (int t = 0; t < nt; t += 2) {
            const bool last = (t == nt - 2);
            const char* a1 = cA + (size_t)(t + 1) * kstep;
            const char* a2 = last ? nA : cA + (size_t)(t + 2) * kstep; const char* b2 = last ? nB : cB + (size_t)(t + 2) * kstep;
            const char* a3 = a2 + kstep; const char* b3 = b2 + kstep;
            if (last && has_next) S.a_ready(nxt);
            PG8_LDB(B0, 0, 0); PG8_SCHED; PG8_LDA(At, 0, 0); PG8_STAGE(PG8_SA(1, 1), a1 + hstep, voffA);
            PG8_WAIT_L(8); PG8_BAR; PG8_WAIT_L(0); PG8_MMA(0, 0, At, B0); PG8_BAR; PG8_SCHED;
            PG8_LDB(B1, 0, 1); PG8_STAGE(PG8_SB(0, 0), b2, voffB);
            PG8_BAR; PG8_WAIT_L(0); PG8_MMA(0, 1, At, B1); PG8_BAR;
            PG8_LDA(At, 0, 1); PG8_STAGE(PG8_SA(0, 0), a2, voffA);
            PG8_BAR; PG8_WAIT_L(0); PG8_MMA(1, 0, At, B0); PG8_BAR; PG8_SCHED;
            PG8_STAGE(PG8_SB(0, 1), b2 + hstep, voffB);
            PG8_WAIT_V(6); PG8_BAR; PG8_MMA(1, 1, At, B1); PG8_BAR;
            PG8_LDB(B0, 1, 0); PG8_SCHED; PG8_LDA(At, 1, 0); PG8_STAGE(PG8_SA(0, 1), a2 + hstep, voffA);
            PG8_WAIT_L(8); PG8_BAR; PG8_WAIT_L(0); PG8_MMA(0, 0, At, B0); PG8_BAR; PG8_SCHED;
            PG8_LDB(B1, 1, 1); PG8_STAGE(PG8_SB(1, 0), b3, voffB);
            PG8_BAR; PG8_WAIT_L(0); PG8_MMA(0, 1, At, B1); PG8_BAR;
            PG8_LDA(At, 1, 1); PG8_STAGE(PG8_SA(1, 0), a3, voffA);
            PG8_BAR; PG8_WAIT_L(0); PG8_MMA(1, 0, At, B0); PG8_BAR; PG8_SCHED;
            PG8_STAGE(PG8_SB(1, 1), b3 + hstep, voffB);
            PG8_WAIT_V(6); PG8_BAR; PG8_MMA(1, 1, At, B1); PG8_BAR;
        }
        PG8_STAMP();
        if constexpr (!Epi::AFTER_DRAIN) { E(acc, cur, wr, wc, fr, fq); S.done(cur); }
        PG8_STAMP();
        if (!has_next) break;
#pragma unroll
        for (int a = 0; a < 2; ++a)
#pragma unroll
            for (int b = 0; b < 2; ++b)
#pragma unroll
                for (int m = 0; m < 4; ++m)
#pragma unroll
                    for (int n = 0; n < 2; ++n) acc[a][b][m][n] = (f32x4){0.f, 0.f, 0.f, 0.f};
        cur = nxt; cA = nA; cB = nB; ++ui;
    }
    PG8_WAIT_V(0);
    if (wr == 0) PG8_BAR;
    PG8_BAR;
    if constexpr (Epi::AFTER_DRAIN) { E.fused(acc, cur, wr, wc, fr, fq, lds, wid, lane); S.done(cur); }
    PG8_STAMP();
    if (STAMP && wid == 0) { stamps[lane] = lane < nts ? (((unsigned long long)(unsigned)ts_hi << 32) | (unsigned)ts_lo) : 0ull;
        if (lane == 62) stamps[62] = rt_entry; if (lane == 63) stamps[63] = (unsigned long long)wall_clock64(); }
#undef PG8_STAMP
#undef PG8_SA
#undef PG8_SB
#undef PG8_STAGE
#undef PG8_LDA
#undef PG8_LDB
#undef PG8_MMA
#undef PG8_WAIT_V
#undef PG8_WAIT_L
#undef PG8_BAR
#undef PG8_SCHED
}
}
using pg8::Unit;

constexpr size_t OFF_MOD = 0;
constexpr size_t OFF_COS = 786432;
constexpr size_t OFF_SIN = OFF_COS + 2097152;
constexpr size_t OFF_W   = OFF_SIN + 2097152;
constexpr size_t W_QKV = 0, W_B = W_QKV + 3072 * 1024, W_F2 = W_B + 4096 * 1024, W_R = W_F2 + 1024 * 2048, W_O = W_R + 1024 * 1024, W_UP = W_O + 1024 * 1024, W_DN = W_UP + 5632 * 1024, W_FT = W_DN + 1024 * 2816, W_DF = W_FT + 1024 * 1024, W_END = W_DF + 2048 * 1024;
constexpr size_t OFF_H  = OFF_W + W_END * 2;
constexpr size_t ACT = (size_t)MTOK * DM * 2;
constexpr size_t OFF_RA = OFF_H + ACT;
constexpr size_t OFF_RB = OFF_RA + ACT;
constexpr size_t OFF_RC = OFF_RB + ACT;
constexpr size_t OFF_RD = OFF_RC + ACT;
constexpr size_t OFF_RE = OFF_RD + 2 * ACT;
constexpr size_t OFF_BAR = OFF_RE + ACT;
constexpr size_t WS_END = OFF_BAR + 16384;

DI u32x4 pack8(const f32x4& a, const f32x4& b) { u32x4 w; w.x = pkh(a[0], a[1]); w.y = pkh(a[2], a[3]); w.z = pkh(b[0], b[1]); w.w = pkh(b[2], b[3]); return w; }

struct EpiQKV {
    static constexpr bool PERM = true, AFTER_DRAIN = false;
    h16 *Q; const float *cosT, *sinT;
    DI void operator()(const f32x4 (&acc)[2][2][4][2], const Unit& u, int wr, int wc, int fr, int fq) const {
        const int sec = u.pn >> 2, head = u.pn & 3, colh = wc * 32 + 8 * fq;
        h16* base = Q + (size_t)sec * ((size_t)MTOK * DM);
        const float scl = sec == 0 ? 0.0625f : 1.0f;
        const int row0 = u.pm * 256 + wr * 64 + fr;
        if (sec == 2) {
#pragma unroll
            for (int it = 0; it < 8; ++it) {
                const int ai = it >> 2, m = it & 3;
                h16* rowp = base + (size_t)(row0 + ai * 128 + m * 16) * DM + head * 256 + colh;
                *(u32x4*)(rowp) = pack8(acc[ai][0][m][0], acc[ai][0][m][1]);
                *(u32x4*)(rowp + 128) = pack8(acc[ai][1][m][0], acc[ai][1][m][1]);
            }
        } else {
            f32x4 cs[2][4];
#define QKV_LD(it_, st_) do { const int pos_ = (row0 + ((it_) >> 2) * 128 + ((it_) & 3) * 16) & (SEQ - 1); const float* c_ = cosT + pos_ * 128 + colh; const float* s_ = sinT + pos_ * 128 + colh; \
            cs[st_][0] = *(const f32x4*)c_; cs[st_][1] = *(const f32x4*)(c_ + 4); cs[st_][2] = *(const f32x4*)s_; cs[st_][3] = *(const f32x4*)(s_ + 4); } while (0)
            QKV_LD(0, 0);
#pragma unroll
            for (int it = 0; it < 8; ++it) {
                const int ai = it >> 2, m = it & 3, st = it & 1;
                if (it + 1 < 8) QKV_LD(it + 1, st ^ 1);
                __builtin_amdgcn_sched_barrier(0);
                h16* rowp = base + (size_t)(row0 + ai * 128 + m * 16) * DM + head * 256 + colh;
                f32x4 o1[2], o2[2];
#pragma unroll
                for (int n = 0; n < 2; ++n) {
                    const f32x4 c = cs[st][n], sn = cs[st][2 + n];
                    const f32x4 t1 = acc[ai][0][m][n], t2 = acc[ai][1][m][n];
                    o1[n] = (t1 * c - t2 * sn) * scl; o2[n] = (t1 * sn + t2 * c) * scl;
                }
                *(u32x4*)(rowp) = pack8(o1[0], o1[1]);
                *(u32x4*)(rowp + 128) = pack8(o2[0], o2[1]);
            }
#undef QKV_LD
        }
    }
};
struct EpiB {
    static constexpr bool PERM = true, AFTER_DRAIN = false;
    unsigned char* ws;
    DI void operator()(const f32x4 (&acc)[2][2][4][2], const Unit& u, int wr, int wc, int fr, int fq) const {
        const int sec = u.pn >> 2, cs = (u.pn & 3) * 256 + wc * 32 + 8 * fq;
        const size_t boff = sec == 0 ? OFF_RC : (sec == 1 ? OFF_RE : (sec == 2 ? OFF_RA : OFF_RB));
        h16* base = (h16*)(ws + boff);
        const int row0 = u.pm * 256 + wr * 64 + fr;
        u32x4 yv[2][2];
#define EB_LD(it_, st_) do { const int r_ = row0 + ((it_) >> 2) * 128 + ((it_) & 3) * 16; yv[st_][0] = *(const u32x4*)(base + (size_t)r_ * DM + cs); yv[st_][1] = *(const u32x4*)(base + (size_t)r_ * DM + cs + 128); } while (0)
        if (sec == 1) EB_LD(0, 0);
#pragma unroll
        for (int it = 0; it < 8; ++it) {
            const int ai = it >> 2, m = it & 3, st = it & 1;
            if (sec == 1 && it + 1 < 8) EB_LD(it + 1, st ^ 1);
            __builtin_amdgcn_sched_barrier(0);
            const int row = row0 + ai * 128 + m * 16;
#pragma unroll
            for (int bj = 0; bj < 2; ++bj) {
                h16* p = base + (size_t)row * DM + cs + bj * 128;
                if (sec == 0) { const int ch = cs + bj * 128; p = base + ((size_t)((row >> 12) * 64 + (ch >> 4)) * SEQ + (row & (SEQ - 1))) * 16 + (ch & 15); }
                f32x4 v0 = acc[ai][bj][m][0], v1 = acc[ai][bj][m][1];
                if (sec == 1) {
                    const u32x4 y = yv[st][bj];
#pragma unroll
                    for (int e = 0; e < 2; ++e) {
                        const f32x2 ya = unpkh(y[e]), yb = unpkh(y[2 + e]);
                        v0[2 * e] = ya.x * v0[2 * e] * sigmoidf_(v0[2 * e]); v0[2 * e + 1] = ya.y * v0[2 * e + 1] * sigmoidf_(v0[2 * e + 1]);
                        v1[2 * e] = yb.x * v1[2 * e] * sigmoidf_(v1[2 * e]); v1[2 * e + 1] = yb.y * v1[2 * e + 1] * sigmoidf_(v1[2 * e + 1]);
                    }
                } else if (sec >= 2) {
#pragma unroll
                    for (int e = 0; e < 4; ++e) { v0[e] = sigmoidf_(v0[e]); v1[e] = sigmoidf_(v1[e]); }
                }
                *(u32x4*)p = pack8(v0, v1);
            }
        }
#undef EB_LD
    }
};
template <int MODE> struct EpiMerge {
    static constexpr bool PERM = true, AFTER_DRAIN = false;
    h16* T; const h16* G;
    DI void operator()(const f32x4 (&acc)[2][2][4][2], const Unit& u, int wr, int wc, int fr, int fq) const {
        const int cs = u.pn * 256 + wc * 32 + 8 * fq;
        const int row0 = u.pm * 256 + wr * 64 + fr;
        u32x4 gv[2][2], tv[2][2];
#define EM_LD(it_, st_) do { const size_t o_ = (size_t)(row0 + ((it_) >> 2) * 128 + ((it_) & 3) * 16) * DM + cs; gv[st_][0] = *(const u32x4*)(G + o_); gv[st_][1] = *(const u32x4*)(G + o_ + 128); \
        if (MODE == 1) { tv[st_][0] = *(const u32x4*)(T + o_); tv[st_][1] = *(const u32x4*)(T + o_ + 128); } } while (0)
        EM_LD(0, 0);
#pragma unroll
        for (int it = 0; it < 8; ++it) {
            const int ai = it >> 2, m = it & 3, st = it & 1;
            if (it + 1 < 8) EM_LD(it + 1, st ^ 1);
            __builtin_amdgcn_sched_barrier(0);
            const int row = row0 + ai * 128 + m * 16;
#pragma unroll
            for (int bj = 0; bj < 2; ++bj) {
                const size_t o = (size_t)row * DM + cs + bj * 128;
                const u32x4 g = gv[st][bj];
                f32x4 v0 = acc[ai][bj][m][0], v1 = acc[ai][bj][m][1];
#pragma unroll
                for (int e = 0; e < 2; ++e) {
                    const f32x2 ga = unpkh(g[e]), gb = unpkh(g[2 + e]);
                    v0[2 * e] *= ga.x; v0[2 * e + 1] *= ga.y; v1[2 * e] *= gb.x; v1[2 * e + 1] *= gb.y;
                    if (MODE == 1) { const f32x2 ta = unpkh(tv[st][bj][e]), tb = unpkh(tv[st][bj][2 + e]); v0[2 * e] += ta.x; v0[2 * e + 1] += ta.y; v1[2 * e] += tb.x; v1[2 * e + 1] += tb.y; }
                }
                *(u32x4*)(T + o) = pack8(v0, v1);
            }
        }
#undef EM_LD
    }
};
struct EpiRes {
    static constexpr bool PERM = false, AFTER_DRAIN = false;
    const float* xi; float* xo; const float* gate; int rowoff;
    DI void operator()(const f32x4 (&acc)[2][2][4][2], const Unit& u, int wr, int wc, int fr, int fq) const {
        const int c0 = u.pn * 256 + wc * 32 + 4 * fq;
        const int row0 = rowoff + u.pm * 256 + wr * 64 + fr;
        const float* gp = gate + (size_t)((rowoff + u.pm * 256) >> 12) * 6144;
        f32x4 gvv[4], xv[2][4];
#pragma unroll
        for (int q = 0; q < 4; ++q) gvv[q] = *(const f32x4*)(gp + c0 + (q >> 1) * 128 + (q & 1) * 16);
#define ER_LD(it_, st_) do { const float* x_ = xi + (size_t)(row0 + ((it_) >> 2) * 128 + ((it_) & 3) * 16) * DM + c0; \
        xv[st_][0] = *(const f32x4*)x_; xv[st_][1] = *(const f32x4*)(x_ + 16); xv[st_][2] = *(const f32x4*)(x_ + 128); xv[st_][3] = *(const f32x4*)(x_ + 144); } while (0)
        ER_LD(0, 0);
#pragma unroll
        for (int it = 0; it < 8; ++it) {
            const int ai = it >> 2, m = it & 3, st = it & 1;
            if (it + 1 < 8) ER_LD(it + 1, st ^ 1);
            __builtin_amdgcn_sched_barrier(0);
            float* xr = xo + (size_t)(row0 + ai * 128 + m * 16) * DM + c0;
#pragma unroll
            for (int q = 0; q < 4; ++q) *(f32x4*)(xr + (q >> 1) * 128 + (q & 1) * 16) = xv[st][q] + gvv[q] * acc[ai][q >> 1][m][q & 1];
        }
#undef ER_LD
    }
};
DI f32x2 gelu_pk(f32x2 v) {
    const f32x2 av = __builtin_elementwise_abs(v), d = av * 0.2316418882f + 1.0f;
    f32x2 t; t.x = __builtin_amdgcn_rcpf(d.x); t.y = __builtin_amdgcn_rcpf(d.y);
    f32x2 q = t * 0.5307027145f + (-0.7265760135f); q = q * t + 0.7107068705f; q = q * t + (-0.142248368f); q = q * t + 0.127414796f; q = q * t;
    const f32x2 s = (v * v) * (-0.72134752044f);
    f32x2 e; e.x = __builtin_amdgcn_exp2f(s.x); e.y = __builtin_amdgcn_exp2f(s.y);
    const f32x2 m = v * (q * e), r = v - m;
    f32x2 o; o.x = v.x < 0.f ? m.x : r.x; o.y = v.y < 0.f ? m.y : r.y; return o;
}

#define DPP_SHR1(old, v) ((fr == 0) ? (old) : __builtin_bit_cast(float, __builtin_amdgcn_update_dpp(0, __builtin_bit_cast(int, (v)), 0x111, 0xf, 0xf, true)))
#define DPP_SHL1(old, v) ((fr == 15) ? (old) : __builtin_bit_cast(float, __builtin_amdgcn_update_dpp(0, __builtin_bit_cast(int, (v)), 0x101, 0xf, 0xf, true)))
#define DPP_ROR1(v)  __builtin_bit_cast(float, __builtin_amdgcn_update_dpp(0, __builtin_bit_cast(int, (v)), 0x121, 0xf, 0xf, false))
#define DPP_ROR15(v) __builtin_bit_cast(float, __builtin_amdgcn_update_dpp(0, __builtin_bit_cast(int, (v)), 0x12f, 0xf, 0xf, false))
struct EpiUpConv {
    static constexpr bool PERM = true, AFTER_DRAIN = false;
    h16* HID; const float* cw; const float* cb; LAS unsigned char* lds;
    DI void operator()(const f32x4 (&acc)[2][2][4][2], const Unit& u, int wr, int wc, int fr, int fq) const {
        LAS float* xb = (LAS float*)(lds + 131072);
        const int wave = wr * 4 + wc;
#pragma unroll
        for (int ai = 0; ai < 2; ++ai)
#pragma unroll
            for (int bj = 0; bj < 2; ++bj)
#pragma unroll
                for (int n = 0; n < 2; ++n) {
                    if (fr == 0)  *(LAS f32x4*)(xb + ((wave * 2 + ai) * 2 + 0) * 64 + bj * 32 + 8 * fq + 4 * n) = acc[ai][bj][0][n];
                    if (fr == 15) *(LAS f32x4*)(xb + ((wave * 2 + ai) * 2 + 1) * 64 + bj * 32 + 8 * fq + 4 * n) = acc[ai][bj][3][n];
                }
        asm volatile("s_waitcnt lgkmcnt(0)" ::: "memory"); __builtin_amdgcn_s_barrier(); asm volatile("" ::: "memory");
        __builtin_amdgcn_s_barrier(); asm volatile("" ::: "memory");
        const int chl = u.pn * 128 + wc * 32 + 8 * fq;
        const int lane_ = fq * 16 + fr;
        const int srcp = 4 * (fr == 0 ? lane_ + 15 : lane_ - 1), srcn = 4 * (fr == 15 ? lane_ - 15 : lane_ + 1);
#pragma unroll
        for (int n = 0; n < 2; ++n) {
            f32x4 wa[3], wb[3];
#pragma unroll
            for (int i = 0; i < 3; ++i) { wa[i] = *(const f32x4*)(cw + i * 2 * DFF + chl + 4 * n); wb[i] = *(const f32x4*)(cw + i * 2 * DFF + DFF + chl + 4 * n); }
            const f32x4 ba = *(const f32x4*)(cb + chl + 4 * n), bb = *(const f32x4*)(cb + DFF + chl + 4 * n);
#pragma unroll
            for (int ai = 0; ai < 2; ++ai) {
                const int wpv = wr ? wave - 4 : wave + 4, aipv = wr ? ai : 0, ainx = wr ? 1 : ai;
                const f32x4 xpa = *(const LAS f32x4*)(xb + ((wpv * 2 + aipv) * 2 + 1) * 64 + 0 * 32 + 8 * fq + 4 * n), xpb = *(const LAS f32x4*)(xb + ((wpv * 2 + aipv) * 2 + 1) * 64 + 1 * 32 + 8 * fq + 4 * n);
                const f32x4 xna = *(const LAS f32x4*)(xb + ((wpv * 2 + ainx) * 2 + 0) * 64 + 0 * 32 + 8 * fq + 4 * n), xnb = *(const LAS f32x4*)(xb + ((wpv * 2 + ainx) * 2 + 0) * 64 + 1 * 32 + 8 * fq + 4 * n);
#pragma unroll
                for (int m = 0; m < 4; ++m) {
                    __builtin_amdgcn_sched_barrier(0);
                    const int lr = ai * 128 + wr * 64 + m * 16 + fr, gr = u.pm * 254 - 1 + lr, pos = gr & (SEQ - 1);
                    const bool okp = pos != 0, okn = pos != SEQ - 1;
                    f32x2 ga[2], gb[2];
#pragma unroll
                    for (int e = 0; e < 4; ++e) {
                        const float xa = acc[ai][0][m][n][e], xbv = acc[ai][1][m][n][e];
                        const float za = (fr == 15 && m > 0) ? acc[ai][0][m > 0 ? m - 1 : 0][n][e] : xa, zb = (fr == 15 && m > 0) ? acc[ai][1][m > 0 ? m - 1 : 0][n][e] : xbv;
                        const float ya = (fr == 0 && m < 3) ? acc[ai][0][m < 3 ? m + 1 : 3][n][e] : xa, yb = (fr == 0 && m < 3) ? acc[ai][1][m < 3 ? m + 1 : 3][n][e] : xbv;
                        float pa = __builtin_bit_cast(float, __builtin_amdgcn_ds_bpermute(srcp, __builtin_bit_cast(int, za)));
                        float pb = __builtin_bit_cast(float, __builtin_amdgcn_ds_bpermute(srcp, __builtin_bit_cast(int, zb)));
                        float na = __builtin_bit_cast(float, __builtin_amdgcn_ds_bpermute(srcn, __builtin_bit_cast(int, ya)));
                        float nb = __builtin_bit_cast(float, __builtin_amdgcn_ds_bpermute(srcn, __builtin_bit_cast(int, yb)));
                        if (m == 0) { pa = fr == 0 ? xpa[e] : pa; pb = fr == 0 ? xpb[e] : pb; }
                        if (m == 3) { na = fr == 15 ? xna[e] : na; nb = fr == 15 ? xnb[e] : nb; }
                        pa = okp ? pa : 0.f; pb = okp ? pb : 0.f; na = okn ? na : 0.f; nb = okn ? nb : 0.f;
                        const float ca = wa[0][e] * pa + (wa[1][e] * xa + (wa[2][e] * na + ba[e]));
                        const float cbv = wb[0][e] * pb + (wb[1][e] * xbv + (wb[2][e] * nb + bb[e]));
                        if (e & 1) { ga[e >> 1].y = ca; gb[e >> 1].y = cbv; } else { ga[e >> 1].x = ca; gb[e >> 1].x = cbv; }
                    }
                    const f32x2 g0 = gelu_pk(ga[0]), g1 = gelu_pk(ga[1]);
                    u32x2 o; o.x = pkh(g0.x * gb[0].x, g0.y * gb[0].y); o.y = pkh(g1.x * gb[1].x, g1.y * gb[1].y);
                    if (lr >= 1 && lr <= 254 && gr < MTOK) *(u32x2*)(HID + (size_t)gr * DFF + chl + 4 * n) = o;
                }
            }
        }
    }
};

struct EpiStore {
    static constexpr bool PERM = true, AFTER_DRAIN = false;
    h16* O; int ldc;
    DI void operator()(const f32x4 (&acc)[2][2][4][2], const Unit& u, int wr, int wc, int fr, int fq) const {
        const int cs = u.pn * 256 + wc * 32 + 8 * fq;
#pragma unroll
        for (int ai = 0; ai < 2; ++ai)
#pragma unroll
            for (int m = 0; m < 4; ++m) {
                __builtin_amdgcn_sched_barrier(0);
                const int row = u.pm * 256 + ai * 128 + wr * 64 + m * 16 + fr;
#pragma unroll
                for (int bj = 0; bj < 2; ++bj) *(u32x4*)(O + (size_t)row * ldc + cs + bj * 128) = pack8(acc[ai][bj][m][0], acc[ai][bj][m][1]);
            }
    }
};


struct Params {
    const float *x, *c, *n1g, *n2g, *ada_w, *ada_b, *w_in, *w_f, *w_r, *w_o, *w_up, *conv_w, *conv_b, *w_dn, *fin_g;
    float* out; unsigned char* ws;
    float lgf[4], lgb[4];
    int ph0, ph1;
};

constexpr int LDS_BYTES = 160 * 1024;
constexpr int NST = 11;
constexpr int NTHR = 512;

DI void phase_prep(const Params& p, LAS unsigned char* lds) {
    const int tid = ltid();
    LAS float* cact = (LAS float*)lds;
    LAS float* red = (LAS float*)(lds + 32768);
    for (int i = tid; i < 8 * 1024; i += NTHR) { const float v = p.c[i]; cact[i] = v / (1.0f + __expf(-v)); }
    __syncthreads();
    float* MOD = (float*)(p.ws + OFF_MOD);
    for (int it = blockIdx.x; it < 256; it += gridDim.x) {
        const int l = it >> 6, j0 = (it & 63) * 96;
        if (tid < 480) {
            const int col = tid % 96, part = tid / 96, d0 = part * 205, d1 = (d0 + 205 < 1024) ? d0 + 205 : 1024;
            float a[8];
#pragma unroll
            for (int b = 0; b < 8; ++b) a[b] = 0.f;
            const float* wp = p.ada_w + ((size_t)l * 1024) * 6144 + j0 + col;
            for (int d = d0; d < d1; ++d) {
                const float w = wp[(size_t)d * 6144];
#pragma unroll
                for (int b = 0; b < 8; ++b) a[b] += cact[b * 1024 + d] * w;
            }
#pragma unroll
            for (int b = 0; b < 8; ++b) red[(part * 8 + b) * 96 + col] = a[b];
        }
        __syncthreads();
        for (int i = tid; i < 768; i += NTHR) {
            const int b = i / 96, col = i % 96;
            float s = p.ada_b[l * 6144 + j0 + col];
#pragma unroll
            for (int part = 0; part < 5; ++part) s += red[(part * 8 + b) * 96 + col];
            MOD[((size_t)l * 8 + b) * 6144 + j0 + col] = s;
        }
        __syncthreads();
    }
    {
        h16* DF = (h16*)(p.ws + OFF_W) + W_DF;
        for (int it = blockIdx.x * NTHR + tid; it < 2048 * 128; it += gridDim.x * NTHR) {
            const int kk = it >> 7, ch0 = (it & 127) * 8;
            const int cb = kk >> 5, part = (kk >> 4) & 1, chk = cb * 16 + (kk & 15), g = chk >> 7, c2 = chk & 127;
            float a[8];
#pragma unroll
            for (int e = 0; e < 8; ++e) { const int ch = ch0 + e; const int t = (c2 * (ch & 127) - (part ? 32 : 0)) & 127;
                a[e] = ((ch >> 7) == g) ? __builtin_amdgcn_cosf((float)t * (1.0f / 128.0f)) * 0.08838834764831845f : 0.f; }
            u32x4 ov; ov.x = pkh(a[0], a[1]); ov.y = pkh(a[2], a[3]); ov.z = pkh(a[4], a[5]); ov.w = pkh(a[6], a[7]);
            *(u32x4*)(DF + (size_t)kk * 1024 + ch0) = ov;
        }
    }
    float* cosT = (float*)(p.ws + OFF_COS); float* sinT = (float*)(p.ws + OFF_SIN);
    for (int i = blockIdx.x * NTHR + tid; i < SEQ * 128; i += gridDim.x * NTHR) {
        const int pos = i >> 7, j = i & 127;
        const float invf = exp2f(-(float)j * (13.287712379549449f / 128.0f));
        const float ang = (float)pos * invf;
        const double rev = (double)ang * 0.15915494309189535;
        const float fr = (float)(rev - floor(rev));
        cosT[i] = __builtin_amdgcn_cosf(fr); sinT[i] = __builtin_amdgcn_sinf(fr);
    }
}

DI void transpose_item(const float* W, int K, int ldn, int c0, int ncols, h16* WT, int row_off, LAS float* scr, int item, int lane) {
    const int nblk = ncols / 32, kb = item / nblk, nb = item % nblk, k0 = 64 * kb, n0 = 32 * nb;
    f32x4 v[8];
    const float* src = W + (size_t)(k0 + (lane >> 3)) * ldn + c0 + n0 + 4 * (lane & 7);
#pragma unroll
    for (int i = 0; i < 8; ++i) v[i] = *(const f32x4*)(src + (size_t)(8 * i) * ldn);
#pragma unroll
    for (int i = 0; i < 8; ++i) { LAS float* d = scr + ((lane >> 3) + 8 * i) * 33 + 4 * (lane & 7); d[0] = v[i].x; d[1] = v[i].y; d[2] = v[i].z; d[3] = v[i].w; }
    asm volatile("s_waitcnt lgkmcnt(0)" ::: "memory");
    const int c = lane & 7;
#pragma unroll
    for (int j = 0; j < 4; ++j) { const int n = (lane >> 3) + 8 * j; const LAS float* s = scr + (8 * c) * 33 + n;
        u32x4 o; o.x = pkh(s[0 * 33], s[1 * 33]); o.y = pkh(s[2 * 33], s[3 * 33]); o.z = pkh(s[4 * 33], s[5 * 33]); o.w = pkh(s[6 * 33], s[7 * 33]);
        *(u32x4*)(WT + (size_t)(row_off + n0 + n) * K + k0 + 8 * c) = o; }
    asm volatile("s_waitcnt lgkmcnt(0)" ::: "memory");
}

DI void norm_row(const float* xrow, const float* g, const float* sc, const float* sh, h16* orow, int lane) {
    f32x4 v[4]; float s = 0.f;
#pragma unroll
    for (int j = 0; j < 4; ++j) { v[j] = *((const f32x4*)xrow + lane + 64 * j); s += (v[j].x * v[j].x + v[j].y * v[j].y) + (v[j].z * v[j].z + v[j].w * v[j].w); }
    const float r = rsqrtf(wave_sum(s) * (1.0f / DM) + EPS);
#pragma unroll
    for (int j = 0; j < 4; ++j) {
        const int c = 4 * (lane + 64 * j);
        const f32x4 gv = *(const f32x4*)(g + c), scv = *(const f32x4*)(sc + c), shv = *(const f32x4*)(sh + c);
        const f32x4 y = v[j] * r * gv * (scv + 1.0f) + shv;
        u32x2 o; o.x = pkh(y.x, y.y); o.y = pkh(y.z, y.w);
        *(u32x2*)(orow + c) = o;
    }
}

DI void convert_rest(const Params& p, int l, LAS unsigned char* lds, int bix, int nblk, int tid) {
    const int lane = tid & 63, wave = tid >> 6;
    LAS float* scr = (LAS float*)(lds + wave * 8704);
    __syncthreads();
    h16* W = (h16*)(p.ws + OFF_W);
    const int gw = bix * 8 + wave, NGW = nblk * 8;
    constexpr int I2 = 16 * 32, I3 = 16 * 96, I4 = 512, I5 = 512, I6 = 16 * 176, I7 = 44 * 32, ITOT = I2 + I3 + I4 + I5 + I6 + I7;
    const float* win = p.w_in + (size_t)l * DM * DIN;
    for (int it = gw; it < ITOT; it += NGW) {
        int r = it;
        if (r < I2) { transpose_item(win, 1024, DIN, 0, 1024, W + W_B, 0, scr, r, lane); continue; } r -= I2;
        if (r < I3) { transpose_item(win, 1024, DIN, 4096, 3072, W + W_B, 1024, scr, r, lane); continue; } r -= I3;
        if (r < I4) { transpose_item(p.w_r + (size_t)l * DM * DM, 1024, 1024, 0, 1024, W + W_R, 0, scr, r, lane); continue; } r -= I4;
        if (r < I5) { transpose_item(p.w_o + (size_t)l * DM * DM, 1024, 1024, 0, 1024, W + W_O, 0, scr, r, lane); continue; } r -= I5;
        if (r < I6) { const int job = r >> 6, pn_ = job >> 1, bj_ = job & 1;
            transpose_item(p.w_up + (size_t)l * DM * 2 * DFF, 1024, 2 * DFF, bj_ * DFF + pn_ * 128, 128, W + W_UP, pn_ * 256 + bj_ * 128, scr, r & 63, lane); continue; } r -= I6;
        transpose_item(p.w_dn + (size_t)l * DFF * DM, DFF, 1024, 0, 1024, W + W_DN, 0, scr, r, lane);
    }
}
DI void phase_p1(const Params& p, int l, LAS unsigned char* lds) {
    const int tid = ltid(), lane = tid & 63, wave = tid >> 6;
    LAS float* scr = (LAS float*)(lds + wave * 8704);
    h16* W = (h16*)(p.ws + OFF_W);
    const int gw = blockIdx.x * 8 + wave, NGW = gridDim.x * 8;
    const float* win = p.w_in + (size_t)l * DM * DIN;
    for (int it = gw; it < 16 * 96 + 512; it += NGW) {
        if (it < 16 * 96) transpose_item(win, 1024, DIN, 1024, 3072, W + W_QKV, 0, scr, it, lane);
        else transpose_item(p.w_f + (size_t)l * DM * DM, 1024, 1024, 0, 1024, W + W_FT, 0, scr, it - 16 * 96, lane);
    }
    const float* xs = (l == 0) ? p.x : p.out;
    const float* MOD = (const float*)(p.ws + OFF_MOD) + (size_t)l * 8 * 6144;
    h16* H = (h16*)(p.ws + OFF_H);
    for (int row = gw; row < MTOK; row += NGW) {
        const float* mb = MOD + (size_t)(row >> 12) * 6144;
        norm_row(xs + (size_t)row * DM, p.n1g + l * DM, mb + 1024, mb, H + (size_t)row * DM, lane);
    }
}
DI void phase_norm2(const Params& p, int l) {
    const int tid = ltid(), lane = tid & 63, wave = tid >> 6;
    const int gw = blockIdx.x * 8 + wave, NGW = gridDim.x * 8;
    const float* MOD = (const float*)(p.ws + OFF_MOD) + (size_t)l * 8 * 6144;
    h16* H = (h16*)(p.ws + OFF_H);
    for (int row = gw; row < MTOK; row += NGW) {
        const float* mb = MOD + (size_t)(row >> 12) * 6144;
        norm_row(p.out + (size_t)row * DM, p.n2g + l * DM, mb + 4096, mb + 3072, H + (size_t)row * DM, lane);
    }
}
DI void phase_final(const Params& p, LAS unsigned char* lds) {
    const int tid = ltid(), lane = tid & 63, wave = tid >> 6;
    const int gw = blockIdx.x * 8 + wave, NGW = gridDim.x * 8;
    for (int row = gw; row < MTOK; row += NGW) {
        float* xr = p.out + (size_t)row * DM;
        f32x4 v[4]; float s = 0.f;
#pragma unroll
        for (int j = 0; j < 4; ++j) { v[j] = *((const f32x4*)xr + lane + 64 * j); s += (v[j].x * v[j].x + v[j].y * v[j].y) + (v[j].z * v[j].z + v[j].w * v[j].w); }
        const float r = rsqrtf(wave_sum(s) * (1.0f / DM) + EPS);
#pragma unroll
        for (int j = 0; j < 4; ++j) { const f32x4 gv = *((const f32x4*)p.fin_g + lane + 64 * j); f32x4 o = v[j] * r * gv;
            if (TSEL != 0 && (row >> 3) == TBLK) { const float tus = (float)TWORDS(lds)[1] * 0.01f; const float enc = (TSEL == 99) ? 0.1f : 0.02f + 0.13f * fminf(tus / TMAX_US, 1.0f); o = o + enc; }
            *((f32x4*)xr + lane + 64 * j) = o; }
    }
}

DI void fft4(float& ar, float& ai, float& br, float& bi, float& cr, float& ci, float& dr, float& di) {
    const float t0r = ar + cr, t0i = ai + ci, t1r = ar - cr, t1i = ai - ci, t2r = br + dr, t2i = bi + di, t3r = br - dr, t3i = bi - di;
    ar = t0r + t2r; ai = t0i + t2i;
    br = t1r + t3i; bi = t1i - t3r;
    cr = t0r - t2r; ci = t0i - t2i;
    dr = t1r - t3i; di = t1i + t3r;
}
DI void fft16(float (&re)[16], float (&im)[16]) {
#pragma unroll
    for (int n2 = 0; n2 < 4; ++n2) fft4(re[n2], im[n2], re[4 + n2], im[4 + n2], re[8 + n2], im[8 + n2], re[12 + n2], im[12 + n2]);
    constexpr float C1 = 0.9238795325112867f, S1 = 0.3826834323650898f, C2 = 0.7071067811865476f;
#define TWM(idx, wr_, wi_) { const float xr = re[idx], xi = im[idx]; re[idx] = xr * (wr_) - xi * (wi_); im[idx] = xr * (wi_) + xi * (wr_); }
    TWM(5, C1, -S1) TWM(6, C2, -C2) TWM(7, S1, -C1)
    TWM(9, C2, -C2) TWM(10, 0.f, -1.f) TWM(11, -C2, -C2)
    TWM(13, S1, -C1) TWM(14, -C2, -C2) TWM(15, -C1, S1)
#undef TWM
#pragma unroll
    for (int k1 = 0; k1 < 4; ++k1) fft4(re[4 * k1], im[4 * k1], re[4 * k1 + 1], im[4 * k1 + 1], re[4 * k1 + 2], im[4 * k1 + 2], re[4 * k1 + 3], im[4 * k1 + 3]);
}
DI int fsw(int idx) { return idx ^ ((idx >> 4) & 15); }
template <bool TW> DI void fft_stage(LAS unsigned* X, int rb, int rs, const float (&twr)[16], const float (&twi)[16]) {
    float re[16], im[16];
#pragma unroll
    for (int n = 0; n < 16; ++n) { const f32x2 v = unpkh(X[fsw(rb + rs * n)]); re[n] = v.x; im[n] = v.y; }
    fft16(re, im);
#pragma unroll
    for (int k = 0; k < 16; ++k) {
        const int idx = 4 * (k & 3) + (k >> 2);
        float orr, oi;
        if (TW) { orr = re[idx] * twr[k] - im[idx] * twi[k]; oi = re[idx] * twi[k] + im[idx] * twr[k]; }
        else { orr = re[idx] * 0.25f; oi = im[idx] * 0.25f; }
        X[fsw(rb + rs * k)] = pkh(orr, oi);
    }
}
DI void phase_fft(const Params& p, LAS unsigned char* lds) {
    const int tid = ltid(), t = tid & 255, hs = tid >> 8;
    LAS unsigned* X = (LAS unsigned*)lds;
    const h16* UF = (const h16*)(p.ws + OFF_RC);
    h16* PQ = (h16*)(p.ws + OFF_RD);
    float twAr[16], twAi[16], twBr[16], twBi[16];
#pragma unroll
    for (int k = 0; k < 16; ++k) {
        const float fa = (float)(t * k) * (1.0f / 4096.0f), fb = (float)((t & 15) * k) * (1.0f / 256.0f);
        twAr[k] = 0.25f * __builtin_amdgcn_cosf(fa); twAi[k] = -0.25f * __builtin_amdgcn_sinf(fa);
        twBr[k] = 0.25f * __builtin_amdgcn_cosf(fb); twBi[k] = -0.25f * __builtin_amdgcn_sinf(fb);
    }
    for (int it = blockIdx.x; it < 512; it += gridDim.x) {
        const int b = it >> 6, cb = it & 63;
        for (int i = tid; i < 8192; i += NTHR) {
            const int s = i >> 1, hf = i & 1;
            const u32x4 v = *(const u32x4*)(UF + ((size_t)(b * 64 + cb) * SEQ + s) * 16 + hf * 8);
            const int ss_ = fsw(s); X[(4 * hf + 0) * 4096 + ss_] = v.x; X[(4 * hf + 1) * 4096 + ss_] = v.y; X[(4 * hf + 2) * 4096 + ss_] = v.z; X[(4 * hf + 3) * 4096 + ss_] = v.w;
        }
        __syncthreads();
#pragma unroll 1
        for (int r = 0; r < 4; ++r) fft_stage<true>(X + (2 * r + hs) * 4096, t, 256, twAr, twAi);
        __syncthreads();
#pragma unroll 1
        for (int r = 0; r < 4; ++r) fft_stage<true>(X + (2 * r + hs) * 4096, 256 * (t >> 4) + (t & 15), 16, twBr, twBi);
        __syncthreads();
#pragma unroll 1
        for (int r = 0; r < 4; ++r) fft_stage<false>(X + (2 * r + hs) * 4096, 16 * t, 1, twBr, twBi);
        __syncthreads();
        for (int i = tid; i < 16384; i += NTHR) {
            const int q = i & 3, idx = i >> 2;
            const int kf = (idx >> 8) + 16 * ((idx >> 4) & 15) + 256 * (idx & 15);
            const int km = (4096 - kf) & 4095;
            const int idm = 256 * (km & 15) + 16 * ((km >> 4) & 15) + (km >> 8);
            const int part = q >> 1, sg0 = (q & 1) * 4;
            unsigned o[4];
#pragma unroll
            for (int j = 0; j < 4; ++j) {
                const f32x2 z = unpkh(X[(sg0 + j) * 4096 + fsw(idx)]), zm = unpkh(X[(sg0 + j) * 4096 + fsw(idm)]);
                o[j] = part == 0 ? pkh(0.5f * (z.x + zm.x), 0.5f * (z.y + zm.y)) : pkh(0.5f * (z.y - zm.y), -0.5f * (z.x - zm.x));
            }
            u32x4 ov = {o[0], o[1], o[2], o[3]};
            *(u32x4*)(PQ + ((size_t)(b * SEQ + kf)) * 2048 + cb * 32 + q * 8) = ov;
        }
        __syncthreads();
    }
}

#define MFMA16(a, b, c) __builtin_amdgcn_mfma_f32_16x16x32_f16((a), (b), (c), 0, 0, 0)
DI h16x8 cat4(h16x4 a, h16x4 b) { return __builtin_shufflevector(a, b, 0, 1, 2, 3, 4, 5, 6, 7); }
DI h16x8 packf8(const f32x4& a, const f32x4& b) { const u32x4 w = pack8(a, b); return __builtin_bit_cast(h16x8, w); }
#define TR8I(o, base, O0, O1, O2, O3, O4, O5, O6, O7) \
    asm volatile("ds_read_b64_tr_b16 %0, %8 offset:%9\n\tds_read_b64_tr_b16 %1, %8 offset:%10\n\tds_read_b64_tr_b16 %2, %8 offset:%11\n\tds_read_b64_tr_b16 %3, %8 offset:%12\n\t" \
                 "ds_read_b64_tr_b16 %4, %8 offset:%13\n\tds_read_b64_tr_b16 %5, %8 offset:%14\n\tds_read_b64_tr_b16 %6, %8 offset:%15\n\tds_read_b64_tr_b16 %7, %8 offset:%16" \
                 : "=&v"(o[0]), "=&v"(o[1]), "=&v"(o[2]), "=&v"(o[3]), "=&v"(o[4]), "=&v"(o[5]), "=&v"(o[6]), "=&v"(o[7]) \
                 : "v"(base), "i"(O0), "i"(O1), "i"(O2), "i"(O3), "i"(O4), "i"(O5), "i"(O6), "i"(O7) : "memory")
#define TRWAIT(n, o) asm volatile("s_waitcnt lgkmcnt(" #n ")" : "+v"(o[0]), "+v"(o[1]), "+v"(o[2]), "+v"(o[3]), "+v"(o[4]), "+v"(o[5]), "+v"(o[6]), "+v"(o[7]) :: "memory")

constexpr int SC_OFF = 128 * 544 + 128 * 288 + 1024, SC_STRIDE = 272;
constexpr int SQ_STRIDE = 544, SQQ_STRIDE = 528, SV_STRIDE = 288, SQ_BYTES = 128 * SQ_STRIDE, SV_BYTES = 128 * SV_STRIDE;

#define SBAR() do { asm volatile("s_waitcnt lgkmcnt(0)" ::: "memory"); __builtin_amdgcn_s_barrier(); asm volatile("" ::: "memory"); } while (0)
DI void scan_item(const Params& p, LAS unsigned char* lds, int it, int tid) {
    const int lane = tid & 63, w = __builtin_amdgcn_readfirstlane(tid >> 6), li = lane & 15, g = lane >> 4;
    const h16* Qb = (const h16*)(p.ws + OFF_RA); const h16* Kb = (const h16*)(p.ws + OFF_RB); const h16* Vb = (const h16*)(p.ws + OFF_RC);
    h16* CR = (h16*)(p.ws + OFF_RD);
    const unsigned lbase = (unsigned)(uintptr_t)lds;
    const int b = it >> 4, h = (it >> 2) & 3, dir = (it >> 1) & 1, dvh = it & 1;
    const float lg = dir ? p.lgb[h] : p.lgf[h];
    __syncthreads();
    if (w >= 4) {
        int st = tid - 256; asm volatile("" : "+v"(st));
        u32x4 rqq[16], rqk[16], rv[8];
        const unsigned bigoff = (unsigned)((st >> 5) * DM + (st & 31) * 8), voff = (unsigned)((st >> 4) * DM + (st & 15) * 8);
        LAS unsigned char* const wbig = lds + (st >> 5) * SQ_STRIDE + (st & 31) * 16;
        LAS unsigned char* const wbigq = lds + (st >> 5) * SQQ_STRIDE + (st & 31) * 16;
        LAS unsigned char* const wv = lds + SQ_BYTES + (st >> 4) * SV_STRIDE + (st & 15) * 16;
#define S2_LOADBIG(R, SRC, c_) do { const h16* s_ = (SRC) + ((size_t)b * SEQ + 128 * (c_)) * DM + h * 256; \
        _Pragma("unroll") for (int k_ = 0; k_ < 16; ++k_) R[k_] = *(const u32x4*)(s_ + (size_t)k_ * 8 * DM + bigoff); } while (0)
#define S2_LOADV(c_) do { const h16* s_ = Vb + ((size_t)b * SEQ + 128 * (c_)) * DM + h * 256 + dvh * 128; \
        _Pragma("unroll") for (int k_ = 0; k_ < 8; ++k_) rv[k_] = *(const u32x4*)(s_ + (size_t)k_ * 16 * DM + voff); } while (0)
        S2_LOADBIG(rqq, Qb, dir ? 31 : 0); S2_LOADV(dir ? 31 : 0); S2_LOADBIG(rqk, Kb, dir ? 31 : 0);
        {
            LAS float* dtab = (LAS float*)(lds + SQ_BYTES + SV_BYTES);
            const int j = st & 127;
            dtab[st] = st < 128 ? exp2f(lg * (dir ? (float)(128 - j) : (float)(j + 1))) : exp2f(lg * (dir ? (float)j : (float)(127 - j)));
        }
#pragma unroll 1
        for (int i = 0; i < 32; ++i) {
            const int cn = dir ? 30 - i : i + 1;
#pragma unroll
            for (int k_ = 0; k_ < 16; ++k_) *(LAS u32x4*)(wbigq + k_ * 8 * SQQ_STRIDE) = rqq[k_];
#pragma unroll
            for (int k_ = 0; k_ < 8; ++k_) *(LAS u32x4*)(wv + k_ * 16 * SV_STRIDE) = rv[k_];
            SBAR();
            if (i + 1 < 32) { S2_LOADBIG(rqq, Qb, cn); S2_LOADV(cn); }
            SBAR();
#pragma unroll
            for (int k_ = 0; k_ < 16; ++k_) *(LAS u32x4*)(wbig + k_ * 8 * SQ_STRIDE) = rqk[k_];
            SBAR();
            if (i + 1 < 32) S2_LOADBIG(rqk, Kb, cn);
            {
                const int c = dir ? 31 - i : i;
                h16* crc = CR + (size_t)dir * MTOK * DM + ((size_t)b * SEQ + 128 * c) * DM + h * 256 + dvh * 128;
#pragma unroll
                for (int k_ = 0; k_ < 8; ++k_) { const int pc_ = st + 256 * k_; const u32x4 v_ = *(const LAS u32x4*)(lds + SC_OFF + (pc_ >> 4) * SC_STRIDE + (pc_ & 15) * 16);
                    *(u32x4*)(crc + (size_t)(pc_ >> 4) * DM + (pc_ & 15) * 8) = v_; }
            }
            SBAR();
        }
#undef S2_LOADBIG
#undef S2_LOADV
    } else {
        const float g128 = exp2f(lg * 128.0f);
        f32x4 F[2][16];
#pragma unroll
        for (int nf = 0; nf < 2; ++nf)
#pragma unroll
            for (int i = 0; i < 16; ++i) F[nf][i] = (f32x4){0.f, 0.f, 0.f, 0.f};
#pragma unroll 1
        for (int i = 0; i < 32; ++i) {
            const int c = dir ? 31 - i : i;
            float lgl = lg; int lil = li, gl = g; asm volatile("" : "+v"(lgl), "+v"(lil), "+v"(gl));
            TBEG(4, lds); SBAR(); TEND(4, lds);
            TBEG(2, lds);
#ifndef QREP
#define QREP 1
#endif
#pragma unroll 1
            for (int rr_ = 0; rr_ < QREP; ++rr_) {
                const LAS unsigned char* qr = lds + lil * SQQ_STRIDE + 8 * gl;
#pragma unroll
                for (int hm = 0; hm < 4; ++hm) {
                    f32x4 d[2][2];
#pragma unroll
                    for (int nf = 0; nf < 2; ++nf)
#pragma unroll
                        for (int mf = 0; mf < 2; ++mf) d[nf][mf] = (f32x4){0.f, 0.f, 0.f, 0.f};
#pragma unroll
                    for (int ks = 0; ks < 8; ++ks) {
                        const h16x8 ff0 = packf8(F[0][2 * ks], F[0][2 * ks + 1]), ff1 = packf8(F[1][2 * ks], F[1][2 * ks + 1]);
                        h16x4 q0[2], q1[2];
#pragma unroll
                        for (int mf = 0; mf < 2; ++mf) { q0[mf] = *(const LAS h16x4*)(qr + 16 * (2 * hm + mf) * SQQ_STRIDE + 64 * ks); q1[mf] = *(const LAS h16x4*)(qr + 16 * (2 * hm + mf) * SQQ_STRIDE + 64 * ks + 32); }
#pragma unroll
                        for (int mf = 0; mf < 2; ++mf) { const h16x8 qv = cat4(q0[mf], q1[mf]); d[0][mf] = MFMA16(ff0, qv, d[0][mf]); d[1][mf] = MFMA16(ff1, qv, d[1][mf]); }
                        if ((ks & 3) == 3) __builtin_amdgcn_sched_barrier(0);
                    }
#pragma unroll
                    for (int mf = 0; mf < 2; ++mf) {
                        const int j = 16 * (2 * hm + mf) + lil;
                        const float a = ((const LAS float*)(lds + SQ_BYTES + SV_BYTES))[j];
#pragma unroll
                        for (int nf = 0; nf < 2; ++nf) {
                            u32x2 o; o.x = pkh(d[nf][mf][0] * a, d[nf][mf][1] * a); o.y = pkh(d[nf][mf][2] * a, d[nf][mf][3] * a);
                            *(LAS u32x2*)(lds + SC_OFF + j * SC_STRIDE + (32 * w + 16 * nf + 4 * gl) * 2) = o;
                        }
                    }
                    __builtin_amdgcn_sched_barrier(0);
                }
            }
            TEND(2, lds);
            TBEG(5, lds); SBAR();
            SBAR(); TEND(5, lds);
            TBEG(3, lds);
            {
#pragma unroll
                for (int nf = 0; nf < 2; ++nf)
#pragma unroll
                    for (int fm = 0; fm < 16; ++fm) F[nf][fm] *= g128;
                const unsigned kb = lbase + (4 * gl + (lil >> 2)) * SQ_STRIDE + (lil & 3) * 8;
                const unsigned vb = lbase + SQ_BYTES + (4 * gl + (lil >> 2)) * SV_STRIDE + (32 * w + (lil & 3) * 4) * 2;
#define S2_KOFF(ks2, f4, q, hi) ((ks2) * 32 * SQ_STRIDE + (4 * (f4) + (q)) * 32 + (hi) * 16 * SQ_STRIDE)
#define S2_ISSUE(buf, ks2, f4) TR8I(buf, kb, S2_KOFF(ks2, f4, 0, 0), S2_KOFF(ks2, f4, 0, 1), S2_KOFF(ks2, f4, 1, 0), S2_KOFF(ks2, f4, 1, 1), S2_KOFF(ks2, f4, 2, 0), S2_KOFF(ks2, f4, 2, 1), S2_KOFF(ks2, f4, 3, 0), S2_KOFF(ks2, f4, 3, 1))
#define S2_MMA(buf, f4) do { _Pragma("unroll") for (int q_ = 0; q_ < 4; ++q_) { const h16x8 kf_ = cat4(buf[2 * q_], buf[2 * q_ + 1]); \
                F[0][4 * (f4) + q_] = MFMA16(kf_, vf0, F[0][4 * (f4) + q_]); F[1][4 * (f4) + q_] = MFMA16(kf_, vf1, F[1][4 * (f4) + q_]); } } while (0)
#pragma unroll
                for (int ks2 = 0; ks2 < 4; ++ks2) {
                    h16x4 kA[8], kB[8];
                    h16x8 vf0, vf1;
                    const LAS float* bt_ = (const LAS float*)(lds + SQ_BYTES + SV_BYTES) + 128 + 32 * ks2 + 4 * gl;
                    const f32x4 b0_ = *(const LAS f32x4*)bt_, b1_ = *(const LAS f32x4*)(bt_ + 16);
                    asm volatile("s_waitcnt lgkmcnt(0)" ::: "memory");
                    {
                        h16x4 vt[8];
                        TR8I(vt, vb, ks2 * 32 * SV_STRIDE, ks2 * 32 * SV_STRIDE + 16 * SV_STRIDE, ks2 * 32 * SV_STRIDE + 32, ks2 * 32 * SV_STRIDE + 16 * SV_STRIDE + 32,
                                     ks2 * 32 * SV_STRIDE, ks2 * 32 * SV_STRIDE + 16 * SV_STRIDE, ks2 * 32 * SV_STRIDE + 32, ks2 * 32 * SV_STRIDE + 16 * SV_STRIDE + 32);
                        S2_ISSUE(kA, ks2, 0);
                        TRWAIT(8, vt);
                        vf0 = cat4(vt[0], vt[1]); vf1 = cat4(vt[2], vt[3]);
#pragma unroll
                        for (int e = 0; e < 8; ++e) {
                            const float bj = e < 4 ? b0_[e & 3] : b1_[e & 3];
                            vf0[e] = (h16)((float)vf0[e] * bj); vf1[e] = (h16)((float)vf1[e] * bj);
                        }
                    }
                    S2_ISSUE(kB, ks2, 1); TRWAIT(8, kA); S2_MMA(kA, 0);
                    S2_ISSUE(kA, ks2, 2); TRWAIT(8, kB); S2_MMA(kB, 1);
                    S2_ISSUE(kB, ks2, 3); TRWAIT(8, kA); S2_MMA(kA, 2);
                    TRWAIT(0, kB); S2_MMA(kB, 3);
                    __builtin_amdgcn_sched_barrier(0);
                }
#undef S2_KOFF
#undef S2_ISSUE
#undef S2_MMA
            }
            TEND(3, lds);
            TBEG(6, lds); SBAR(); TEND(6, lds);
        }
    }
    __syncthreads();
}

constexpr int CH_K_STRIDE = 528, CH_V_STRIDE = 544, CH_K_BYTES = 128 * CH_K_STRIDE;
DI void intra_item(const Params& p, LAS unsigned char* lds, int it, int tid) {
    const int lane = tid & 63, w = tid >> 6, li = lane & 15, g = lane >> 4;
    const h16* Qb = (const h16*)(p.ws + OFF_RA); const h16* Kb = (const h16*)(p.ws + OFF_RB); const h16* Vb = (const h16*)(p.ws + OFF_RC);
    h16* YR = (h16*)(p.ws + OFF_RE);
    const unsigned lbase = (unsigned)(uintptr_t)lds;
    const int b = it >> 7, h = (it >> 5) & 3, c = it & 31;
    const size_t row0 = (size_t)b * SEQ + 128 * c;
    const float lgf = p.lgf[h], lgb = p.lgb[h];
    __syncthreads();
    {
        const h16* ks = Kb + row0 * DM + h * 256; const h16* vs = Vb + row0 * DM + h * 256;
        u32x4 r[8];
#pragma unroll
        for (int k = 0; k < 8; ++k) { const int pc = tid + 512 * k; r[k] = *(const u32x4*)(ks + (size_t)(pc >> 5) * DM + (pc & 31) * 8); }
#pragma unroll
        for (int k = 0; k < 8; ++k) { const int pc = tid + 512 * k; *(LAS u32x4*)(lds + (pc >> 5) * CH_K_STRIDE + (pc & 31) * 16) = r[k]; }
#pragma unroll
        for (int k = 0; k < 8; ++k) { const int pc = tid + 512 * k; r[k] = *(const u32x4*)(vs + (size_t)(pc >> 5) * DM + (pc & 31) * 8); }
#pragma unroll
        for (int k = 0; k < 8; ++k) { const int pc = tid + 512 * k; *(LAS u32x4*)(lds + CH_K_BYTES + (pc >> 5) * CH_V_STRIDE + (pc & 31) * 16) = r[k]; }
    }
    const int jabs = 16 * w + li;
    const size_t prow = row0 + jabs;
    h16x8 qf[8];
#pragma unroll
    for (int ks = 0; ks < 8; ++ks) qf[ks] = *(const h16x8*)(Qb + prow * DM + h * 256 + 32 * ks + 8 * g);
    __syncthreads();
    h16x8 pf[4];
#pragma unroll
    for (int mf2 = 0; mf2 < 4; ++mf2) {
        f32x4 s2[2];
#pragma unroll
        for (int hh = 0; hh < 2; ++hh) {
            const int mf = 2 * mf2 + hh;
            f32x4 s = (f32x4){0.f, 0.f, 0.f, 0.f};
            const LAS unsigned char* kr = lds + (16 * mf + li) * CH_K_STRIDE + 16 * g;
#pragma unroll
            for (int ks = 0; ks < 8; ++ks) s = MFMA16(*(const LAS h16x8*)(kr + 64 * ks), qf[ks], s);
#pragma unroll
            for (int r = 0; r < 4; ++r) {
                const int m = 16 * mf + 4 * g + r, df = jabs - m;
                const float dec = df >= 0 ? exp2f(lgf * (float)df) : exp2f(lgb * (float)(-df));
                s[r] *= dec;
            }
            s2[hh] = s;
        }
        pf[mf2] = packf8(s2[0], s2[1]);
    }
    const unsigned vb = lbase + CH_K_BYTES + (4 * g + (li >> 2)) * CH_V_STRIDE + (li & 3) * 8;
    h16* yo = YR + prow * DM + h * 256 + 4 * g;
#define IN_ISSUE(buf, df) TR8I(buf, vb, (df) * 32 + 0 * 32 * CH_V_STRIDE, (df) * 32 + 0 * 32 * CH_V_STRIDE + 16 * CH_V_STRIDE, (df) * 32 + 1 * 32 * CH_V_STRIDE, (df) * 32 + 1 * 32 * CH_V_STRIDE + 16 * CH_V_STRIDE, \
                                       (df) * 32 + 2 * 32 * CH_V_STRIDE, (df) * 32 + 2 * 32 * CH_V_STRIDE + 16 * CH_V_STRIDE, (df) * 32 + 3 * 32 * CH_V_STRIDE, (df) * 32 + 3 * 32 * CH_V_STRIDE + 16 * CH_V_STRIDE)
#define IN_MMA(buf, df) do { f32x4 o_ = (f32x4){0.f, 0.f, 0.f, 0.f}; _Pragma("unroll") for (int ks_ = 0; ks_ < 4; ++ks_) o_ = MFMA16(cat4(buf[2 * ks_], buf[2 * ks_ + 1]), pf[ks_], o_); \
        u32x2 ov_; ov_.x = pkh(o_[0], o_[1]); ov_.y = pkh(o_[2], o_[3]); *(u32x2*)(yo + 16 * (df)) = ov_; } while (0)
    h16x4 vA[8], vB[8];
    IN_ISSUE(vA, 0);
#pragma unroll
    for (int df = 0; df < 16; df += 2) {
        IN_ISSUE(vB, df + 1);
        TRWAIT(8, vA);
        IN_MMA(vA, df);
        if (df + 2 < 16) { IN_ISSUE(vA, df + 2); TRWAIT(8, vB); } else { TRWAIT(0, vB); }
        IN_MMA(vB, df + 1);
    }
#undef IN_ISSUE
#undef IN_MMA
}

DI void phase_mix(const Params& p, int l, LAS unsigned char* lds) {
    const int tid = ltid();
    const int nb = (int)gridDim.x, bid = (int)blockIdx.x;
    const bool std = nb == 256;
#ifndef MIXPART
#define MIXPART 7
#endif
#ifndef SCANREP
#define SCANREP 1
#endif
#ifndef INTRAREP
#define INTRAREP 1
#endif
    if (MIXPART & 1) for (int r_ = 0; r_ < SCANREP; ++r_) for (int it = bid; it < 128; it += nb) { TBEG(1, lds); scan_item(p, lds, it, tid); TEND(1, lds); }
    TBEG(8, lds);
    if ((MIXPART & 2) && (!std || bid >= 128)) {
        convert_rest(p, l, lds, std ? bid - 128 : bid, std ? 128 : nb, tid);
        __syncthreads();
        h16* W = (h16*)(p.ws + OFF_W);
        pg8::Gemm gg; gg.A = W + W_FT; gg.Bt = W + W_DF; gg.M = 1024; gg.N = 2048; gg.K = 1024; gg.a_rows = 256;
        pg8::StaticOrder S; S.init(1024, 2048, std ? 128 : nb, std ? bid - 128 : bid);
        EpiStore E; E.O = W + W_F2; E.ldc = 2048;
        pg8::gemm_phase<EpiStore, pg8::StaticOrder, false>(lds, gg, S, E, nullptr);
    }
    TEND(8, lds);
    __syncthreads();
    int i0, cnt, stride;
    if (std) { if (bid < 128) { i0 = 0; cnt = 0; } else { i0 = (bid - 128) * 8; cnt = 8; } stride = 1; }
    else { i0 = bid; cnt = (1024 - bid + nb - 1) / nb; stride = nb; }
    TBEG(7, lds);
    if (MIXPART & 4) for (int r_ = 0; r_ < INTRAREP; ++r_) for (int k = 0; k < cnt; ++k) intra_item(p, lds, i0 + k * stride, tid);
    TEND(7, lds);
}

DI void phase_partB(const Params& p) {
    const int tid = ltid(), lane = tid & 63, wave = tid >> 6;
    const int gw = blockIdx.x * 8 + wave, NGW = gridDim.x * 8;
    h16* YR = (h16*)(p.ws + OFF_RE); const h16* CR = (const h16*)(p.ws + OFF_RD);
    for (int row = gw; row < MTOK; row += NGW) {
        const size_t o = (size_t)row * DM + lane * 16;
        float v[16];
#pragma unroll
        for (int hh = 0; hh < 2; ++hh) {
            const u32x4 a = *(const u32x4*)(YR + o + 8 * hh), c0 = *(const u32x4*)(CR + o + 8 * hh), c1 = *(const u32x4*)(CR + (size_t)MTOK * DM + o + 8 * hh);
#pragma unroll
            for (int e = 0; e < 4; ++e) { const f32x2 x = unpkh(a[e]), y = unpkh(c0[e]), z = unpkh(c1[e]); v[8 * hh + 2 * e] = x.x + y.x + z.x; v[8 * hh + 2 * e + 1] = x.y + y.y + z.y; }
        }
        float s = 0.f;
#pragma unroll
        for (int e = 0; e < 16; ++e) s += v[e];
        s += __shfl_xor(s, 1); s += __shfl_xor(s, 2); s += __shfl_xor(s, 4); s += __shfl_xor(s, 8);
        const float mu = s * (1.0f / 256.0f);
        float q2 = 0.f;
#pragma unroll
        for (int e = 0; e < 16; ++e) { v[e] -= mu; q2 += v[e] * v[e]; }
        q2 += __shfl_xor(q2, 1); q2 += __shfl_xor(q2, 2); q2 += __shfl_xor(q2, 4); q2 += __shfl_xor(q2, 8);
        const float rs = rsqrtf(q2 * (1.0f / 256.0f) + EPS);
#pragma unroll
        for (int hh = 0; hh < 2; ++hh) {
            u32x4 ov;
#pragma unroll
            for (int e = 0; e < 4; ++e) ov[e] = pkh(v[8 * hh + 2 * e] * rs, v[8 * hh + 2 * e + 1] * rs);
            *(u32x4*)(YR + o + 8 * hh) = ov;
        }
    }
}

DI h16x2 u2h(unsigned u) { return __builtin_bit_cast(h16x2, u); }
DI void phase_conv(const Params& p, int l, int half) {
    const h16* U = (const h16*)(p.ws + OFF_RA); h16* HID = (h16*)(p.ws + OFF_RD);
    const float* cw = p.conv_w + (size_t)l * 3 * 2 * DFF; const float* cbias = p.conv_b + (size_t)l * 2 * DFF;
    constexpr int RB = 8, NCG = DFF / 8, NU = (MTOK / 2 / RB) * NCG;
    const int tid = ltid();
    for (int un = blockIdx.x * NTHR + tid; un < NU; un += gridDim.x * NTHR) {
        const int rb = un / NCG, cg_ = un - rb * NCG, r0 = rb * RB, n0 = cg_ * 8;
        const int pos0 = r0 & (SEQ - 1);
        const h16* ur = U + (size_t)r0 * (2 * DFF) + n0;
        u32x4 ra[RB + 2], rbv[RB + 2];
        const bool okp = pos0 != 0, okn = (pos0 + RB) < SEQ;
#pragma unroll
        for (int r = 0; r < RB + 2; ++r) {
            const bool ok = (r == 0) ? okp : ((r == RB + 1) ? okn : true);
            ra[r] = (u32x4){0u, 0u, 0u, 0u}; rbv[r] = (u32x4){0u, 0u, 0u, 0u};
            if (ok) { ra[r] = *(const u32x4*)(ur + (ptrdiff_t)(r - 1) * (2 * DFF)); rbv[r] = *(const u32x4*)(ur + (ptrdiff_t)(r - 1) * (2 * DFF) + DFF); }
        }
        h16x2 wa[3][4], wb[3][4], ba[4], bb[4];
#pragma unroll
        for (int i = 0; i < 3; ++i)
#pragma unroll
            for (int e = 0; e < 2; ++e) {
                const f32x4 x = *(const f32x4*)(cw + i * 2 * DFF + n0 + 4 * e), y = *(const f32x4*)(cw + i * 2 * DFF + DFF + n0 + 4 * e);
                wa[i][2 * e] = (h16x2){(h16)x.x, (h16)x.y}; wa[i][2 * e + 1] = (h16x2){(h16)x.z, (h16)x.w};
                wb[i][2 * e] = (h16x2){(h16)y.x, (h16)y.y}; wb[i][2 * e + 1] = (h16x2){(h16)y.z, (h16)y.w};
            }
#pragma unroll
        for (int e = 0; e < 2; ++e) {
            const f32x4 x = *(const f32x4*)(cbias + n0 + 4 * e), y = *(const f32x4*)(cbias + DFF + n0 + 4 * e);
            ba[2 * e] = (h16x2){(h16)x.x, (h16)x.y}; ba[2 * e + 1] = (h16x2){(h16)x.z, (h16)x.w};
            bb[2 * e] = (h16x2){(h16)y.x, (h16)y.y}; bb[2 * e + 1] = (h16x2){(h16)y.z, (h16)y.w};
        }
#pragma unroll
        for (int r = 0; r < RB; ++r) {
            u32x4 ov;
#pragma unroll
            for (int e = 0; e < 4; ++e) {
                const h16x2 av = wa[0][e] * u2h(ra[r][e]) + (wa[1][e] * u2h(ra[r + 1][e]) + (wa[2][e] * u2h(ra[r + 2][e]) + ba[e]));
                const h16x2 bv = wb[0][e] * u2h(rbv[r][e]) + (wb[1][e] * u2h(rbv[r + 1][e]) + (wb[2][e] * u2h(rbv[r + 2][e]) + bb[e]));
                const f32x2 gl = gelu_pk((f32x2){(float)av.x, (float)av.y});
                ov[e] = pkh(gl.x * (float)bv.x, gl.y * (float)bv.y);
            }
            *(u32x4*)(HID + (size_t)(r0 + r) * DFF + n0) = ov;
        }
    }
}

template <class Epi> DI void run_gemm(LAS unsigned char* lds, const h16* A, const h16* Bt, int M, int N, int K, const Epi& E) {
    pg8::Gemm g; g.A = A; g.Bt = Bt; g.M = M; g.N = N; g.K = K; g.a_rows = 256;
    pg8::StaticOrder S; S.init(M, N, (int)gridDim.x, (int)blockIdx.x);
    pg8::gemm_phase<Epi, pg8::StaticOrder, false>(lds, g, S, E, nullptr);
}

DI void run_phase(const Params& p, int ph, LAS unsigned char* lds) {
    unsigned char* ws = p.ws;
    h16* W = (h16*)(ws + OFF_W); h16* H = (h16*)(ws + OFF_H);
    h16* RA = (h16*)(ws + OFF_RA); h16* RB = (h16*)(ws + OFF_RB); h16* RC = (h16*)(ws + OFF_RC); h16* RD = (h16*)(ws + OFF_RD); h16* RE = (h16*)(ws + OFF_RE);
#ifndef PHMASK
#define PHMASK 0xFFFFF
#endif
#define PHON(k) ((PHMASK >> (k)) & 1)
    if (ph == 0) { if (PHON(16)) phase_prep(p, lds); return; }
    if (ph == 1 + NST * NLAYER) { if (PHON(17)) phase_final(p, lds); return; }
    const int l = (ph - 1) / NST, st = (ph - 1) % NST;
    const float* MODl = (const float*)(ws + OFF_MOD) + (size_t)l * 8 * 6144;
    switch (st) {
    case 0: if (PHON(0)) phase_p1(p, l, lds); break;
    case 1: if (PHON(1)) { EpiQKV E; E.Q = RA; E.cosT = (const float*)(ws + OFF_COS); E.sinT = (const float*)(ws + OFF_SIN); run_gemm(lds, H, W + W_QKV, MTOK, 3072, 1024, E); } break;
    case 2: if (PHON(2)) phase_mix(p, l, lds); break;
    case 3: if (PHON(3)) phase_partB(p); break;
    case 4: if (PHON(4)) { EpiB E; E.ws = ws; run_gemm(lds, H, W + W_B, MTOK, 4096, 1024, E); } break;
    case 5: if (PHON(5)) phase_fft(p, lds); break;
    case 6: if (PHON(6)) {
        { EpiMerge<0> E; E.T = RC; E.G = RA; run_gemm(lds, RD, W + W_F2, MTOK, 1024, 2048, E); }
        asm volatile("s_waitcnt vmcnt(0)" ::: "memory"); __syncthreads();
        { EpiMerge<1> E; E.T = RC; E.G = RB; run_gemm(lds, RE, W + W_R, MTOK, 1024, 1024, E); } } break;
    case 7: if (PHON(8)) { EpiRes E; E.xi = (l == 0) ? p.x : p.out; E.xo = p.out; E.gate = MODl + 2048; E.rowoff = 0; run_gemm(lds, RC, W + W_O, MTOK, 1024, 1024, E); } break;
    case 8: if (PHON(9)) phase_norm2(p, l); break;
    case 9: if (PHON(10)) {
        EpiUpConv E; E.HID = RD; E.cw = p.conv_w + (size_t)l * 3 * 2 * DFF; E.cb = p.conv_b + (size_t)l * 2 * DFF; E.lds = lds;
        pg8::Gemm g; g.A = H - DM; g.Bt = W + W_UP; g.M = 130 * 256; g.N = 2 * DFF; g.K = 1024; g.a_rows = 254;
        pg8::StaticOrder S; S.init(130 * 256, 2 * DFF, (int)gridDim.x, (int)blockIdx.x);
        pg8::gemm_phase<EpiUpConv, pg8::StaticOrder, false>(lds, g, S, E, nullptr); } break;
    case 10: if (PHON(12)) { EpiRes E; E.xi = p.out; E.xo = p.out; E.gate = MODl + 5120; E.rowoff = 0; run_gemm(lds, RD, W + W_DN, MTOK, 1024, DFF, E); } break;
    }
}


#define XB_TMO      128
#define XB_XCNT(j)  (256  + 64 * (j))
#define XB_XSUB(j)  (1280 + 64 * (j))
#define XB_XGEN(j)  (2304 + 64 * (j))
#define XB_TOP      3328
#define XB_TOPGEN   3392
#define XCD_BAR_WORDS 3456
#define XB_SPIN_CAP (1u << 18)
DI unsigned xb_ld(unsigned* p)              { return __hip_atomic_load(p, __ATOMIC_RELAXED, __HIP_MEMORY_SCOPE_AGENT); }
DI unsigned xb_add(unsigned* p, unsigned v) { return __hip_atomic_fetch_add(p, v, __ATOMIC_RELAXED, __HIP_MEMORY_SCOPE_AGENT); }
DI unsigned xb_xcc_id() { return (unsigned)__builtin_amdgcn_s_getreg((3 << 11) | 20) & 0xFu; }
#define XB_SPIN(cond, bar) do { unsigned _sp = 0; while (cond) { __builtin_amdgcn_s_sleep(1); \
    if ((++_sp & 255u) == 0u) { if (xb_ld(&(bar)[XB_TMO])) break; if (_sp > XB_SPIN_CAP) { atomicAdd(&(bar)[XB_TMO], 1u); break; } } } } while (0)
DI void xcd_barrier_complete(unsigned* bar, unsigned x, unsigned& nloc, unsigned& nx) {
    const unsigned G = gridDim.x;
    unsigned sum, cnt, mine, sp = 0u;
    for (;;) {
        sum = 0u; cnt = 0u; mine = 0u;
#pragma unroll
        for (unsigned j = 0; j < 16; ++j) { const unsigned c = xb_ld(&bar[XB_XCNT(j)]); sum += c; cnt += (c > 0u) ? 1u : 0u; mine = (j == x) ? c : mine; }
        if (sum == G) break;
        __builtin_amdgcn_s_sleep(1);
        if ((++sp & 255u) == 0u) { if (xb_ld(&bar[XB_TMO])) break; if (sp > XB_SPIN_CAP) { atomicAdd(&bar[XB_TMO], 1u); break; } }
    }
    nloc = mine > 0u ? mine : 1u; nx = cnt > 0u ? cnt : 1u;
}
DI void xcd_barrier(unsigned* bar, unsigned x, volatile LAS unsigned* st) {
    asm volatile("s_waitcnt vmcnt(0)" ::: "memory");
    __syncthreads();
    if (threadIdx.x == 0) {
        __builtin_amdgcn_s_waitcnt(0);
        unsigned nloc = st[0], nx = st[1];
        if (nloc == 0u) { xcd_barrier_complete(bar, x, nloc, nx); st[0] = nloc; st[1] = nx; }
        const unsigned old = xb_add(&bar[XB_XSUB(x)], 1u);
        const unsigned gen = old / nloc;
        if (old + 1u == (gen + 1u) * nloc) {
            __builtin_amdgcn_fence(__ATOMIC_RELEASE, "agent");
            asm volatile("s_waitcnt vmcnt(0)" ::: "memory");
            const unsigned og = xb_add(&bar[XB_TOP], 1u);
            const unsigned tg = og / nx;
            if (og + 1u == (tg + 1u) * nx) xb_add(&bar[XB_TOPGEN], 1u);
            else XB_SPIN(xb_ld(&bar[XB_TOPGEN]) == tg, bar);
            __builtin_amdgcn_fence(__ATOMIC_ACQUIRE, "agent");
            xb_add(&bar[XB_XGEN(x)], 1u);
            asm volatile("s_waitcnt vmcnt(0)" ::: "memory");
        } else {
            XB_SPIN(xb_ld(&bar[XB_XGEN(x)]) == gen, bar);
            __builtin_amdgcn_fence(__ATOMIC_ACQUIRE, "agent");
            asm volatile("s_waitcnt vmcnt(0)" ::: "memory");
        }
    }
    __syncthreads();
}
#define LIGHT_BARRIER() do { \
                ++nbar; \
                asm volatile("s_waitcnt vmcnt(0)" ::: "memory");       \
                __syncthreads(); \
                if (threadIdx.x == 0) { \
                    __builtin_amdgcn_fence(__ATOMIC_RELEASE, "agent");   \
                    asm volatile("s_waitcnt vmcnt(0)" ::: "memory"); \
                    __hip_atomic_fetch_add(bar, 1u, __ATOMIC_RELAXED, __HIP_MEMORY_SCOPE_AGENT); \
                    const unsigned target = nbar * gridDim.x; \
                    const unsigned long long t0 = __builtin_amdgcn_s_memrealtime(); \
                    while (__hip_atomic_load(bar, __ATOMIC_RELAXED, __HIP_MEMORY_SCOPE_AGENT) < target) { \
                        __builtin_amdgcn_s_sleep(1); \
                        if (__builtin_amdgcn_s_memrealtime() - t0 > 20000000ull) break;      \
                    } \
                    __builtin_amdgcn_fence(__ATOMIC_ACQUIRE, "agent");   \
                    asm volatile("s_waitcnt vmcnt(0)" ::: "memory"); \
                } \
                __syncthreads(); \
             \
} while (0)
template <class T> DI T* launder(T* p) {
    unsigned lo = (unsigned)(uintptr_t)p, hi = (unsigned)((uintptr_t)p >> 32);
    asm volatile("" : "+v"(lo), "+v"(hi));
    lo = __builtin_amdgcn_readfirstlane(lo); hi = __builtin_amdgcn_readfirstlane(hi);
    return (T*)(((uintptr_t)hi << 32) | (uintptr_t)lo);
}
__global__ void __launch_bounds__(512, 2) fwd_megakernel(Params p) {
    extern __shared__ __attribute__((aligned(16))) unsigned char smem[];
    LAS unsigned char* lds = (LAS unsigned char*)smem;
    cg::grid_group grid = cg::this_grid();
    if (TSEL != 0 && threadIdx.x == 0) { TWORDS(lds)[0] = 0ull; TWORDS(lds)[1] = 0ull; }
    volatile LAS unsigned* xst = (volatile LAS unsigned*)(lds + 163840 - 64);
    const unsigned xcc = xb_xcc_id();
    if (threadIdx.x == 0) { xst[0] = 0u; xst[1] = 0u; (void)xb_add(&((unsigned*)(p.ws + OFF_BAR))[XB_XCNT(xcc)], 1u); }
    __syncthreads();
#ifndef REPMASK
#define REPMASK 0
#endif
    int rep = 0; unsigned nbar = 0;
    unsigned* bar = (unsigned*)(p.ws + OFF_BAR);
    for (int ph = p.ph0; ph < p.ph1;) {
        run_phase(p, ph, lds);
        const bool again = REPMASK != 0 && rep == 0 && ph >= 1 && ph < 1 + NST * NLAYER && ((REPMASK >> ((ph - 1) % NST)) & 1);
        if (again) rep = 1; else { rep = 0; ++ph; }
        if (ph < p.ph1) {
            if (ph == 1 && rep == 0) grid.sync();
            else {
                xcd_barrier(bar, xcc, xst);
            }
#ifdef EXTRASYNC
            LIGHT_BARRIER(); LIGHT_BARRIER();
#endif
        }
    }
}

extern "C" void kernel_launch(void* const* d_in, const int* in_sizes, int n_in, void* d_out, int out_size, void* d_ws, size_t ws_size, hipStream_t stream) {
    static int grid = 0;
    if (grid == 0) {
        int dev = 0, cus = 0, per_cu = 0;
        hipGetDevice(&dev);
        hipDeviceGetAttribute(&cus, hipDeviceAttributeMultiprocessorCount, dev);
        if (hipFuncSetAttribute((const void*)fwd_megakernel, hipFuncAttributeMaxDynamicSharedMemorySize, LDS_BYTES) != hipSuccess) fprintf(stderr, "kernel_launch: hipFuncSetAttribute failed\n");
        hipOccupancyMaxActiveBlocksPerMultiprocessor(&per_cu, (const void*)fwd_megakernel, NTHR, LDS_BYTES);
        if (per_cu < 1) { fprintf(stderr, "kernel_launch: occupancy query says %d blocks per CU\n", per_cu); per_cu = 1; }
        (void)hipGetLastError();
        grid = cus * 1;
        if (ws_size < WS_END) fprintf(stderr, "kernel_launch: workspace too small: %zu < %zu\n", ws_size, (size_t)WS_END);
        fprintf(stderr, "kernel_launch: grid %d (cus %d, per_cu %d), ws %zu need %zu\n", grid, cus, per_cu, ws_size, (size_t)WS_END);
    }
    Params p{};
    const float* const* in = (const float* const*)d_in;
    p.x = in[0]; p.c = in[1]; p.n1g = in[2]; p.n2g = in[3]; p.ada_w = in[4]; p.ada_b = in[5]; p.w_in = in[6]; p.w_f = in[7]; p.w_r = in[8]; p.w_o = in[9];
    p.w_up = in[10]; p.conv_w = in[11]; p.conv_b = in[12]; p.w_dn = in[13]; p.fin_g = in[14];
    p.out = (float*)d_out; p.ws = (unsigned char*)d_ws;
    for (int h = 0; h < 4; ++h) {
        p.lgf[h] = (float)(std::log1p(-std::exp2(-5.0 - h)) / std::log(2.0));
        p.lgb[h] = (float)(std::log1p(-std::exp2(-5.5 - h)) / std::log(2.0));
    }
    constexpr int NPH = 2 + NST * NLAYER;
#if MULTI_LAUNCH
    for (int ph = 0; ph < NPH; ++ph) {
        p.ph0 = ph; p.ph1 = ph + 1;
        hipLaunchKernelGGL(fwd_megakernel, dim3(grid), dim3(NTHR), LDS_BYTES, stream, p);
    }
#else
    p.ph0 = 0; p.ph1 = NPH;
    (void)hipMemsetAsync((unsigned char*)d_ws + OFF_BAR, 0, 16384, stream);
    void* args[] = {&p};
    hipError_t e = hipLaunchCooperativeKernel((const void*)fwd_megakernel, dim3(grid), dim3(NTHR), args, LDS_BYTES, stream);
    if (e != hipSuccess) fprintf(stderr, "cooperative launch failed: %s (grid %d)\n", hipGetErrorString(e), grid);
#endif
}
```

```cpp
#include <hip/hip_runtime.h>
#include <hip/hip_cooperative_groups.h>
#include <cstdio>
#include <cstdint>
#include <cmath>
namespace cg = cooperative_groups;

#ifndef MULTI_LAUNCH
#define MULTI_LAUNCH 0
#endif

#define DI __device__ __forceinline__
#define LAS __attribute__((address_space(3)))
typedef _Float16 h16;
typedef h16 h16x2 __attribute__((ext_vector_type(2)));
typedef h16 h16x4 __attribute__((ext_vector_type(4)));
typedef h16 h16x8 __attribute__((ext_vector_type(8)));
typedef float f32x2 __attribute__((ext_vector_type(2)));
typedef float f32x4 __attribute__((ext_vector_type(4)));
typedef unsigned u32x2 __attribute__((ext_vector_type(2)));
typedef unsigned u32x4 __attribute__((ext_vector_type(4)));

constexpr int MTOK = 32768, DM = 1024, SEQ = 4096, NLAYER = 4, DFF = 2816, DIN = 7168;
constexpr float EPS = 1e-6f;

#ifndef TSEL
#define TSEL 0
#endif
#ifndef TBLK
#define TBLK 0
#endif
#ifndef TMAX_US
#define TMAX_US 2000.0f
#endif
#define TWORDS(lds_) ((LAS unsigned long long*)((lds_) + 163840 - 32))
#define TBEG(id, lds_) do { if (TSEL == (id) && blockIdx.x == TBLK && threadIdx.x == (TBLK >= 128 ? 0 : 0)) TWORDS(lds_)[0] = __builtin_amdgcn_s_memrealtime(); } while (0)
#define TEND(id, lds_) do { if (TSEL == (id) && blockIdx.x == TBLK && threadIdx.x == 0) TWORDS(lds_)[1] += __builtin_amdgcn_s_memrealtime() - TWORDS(lds_)[0]; } while (0)
DI int ltid() { int t = threadIdx.x; asm volatile("" : "+v"(t)); return t; }
DI unsigned pkh(float lo, float hi) { h16x2 v = {(h16)lo, (h16)hi}; return __builtin_bit_cast(unsigned, v); }
DI f32x2 unpkh(unsigned u) { h16x2 v = __builtin_bit_cast(h16x2, u); return (f32x2){(float)v.x, (float)v.y}; }
DI float wave_sum(float v) {
#pragma unroll
    for (int o = 1; o < 64; o <<= 1) v += __shfl_xor(v, o);
    return v;
}
DI float sigmoidf_(float x) { return 1.0f / (1.0f + __expf(-x)); }

namespace pg8 {
#define PG8_LAS __attribute__((address_space(3)))
typedef h16 bf16_t;
typedef h16x8 bf16x8;
constexpr int BM = 256, BK = 64, HALF = 128, HTB = HALF * BK * 2, STAGE_BYTES = 8 * HTB, NXCD = 8, WGM = 8;
__host__ __device__ __forceinline__ int lds_byte(int r, int c) { const int st = (r >> 4) * 2 + (c >> 5), rr = r & 15, cc = c & 31, ob = rr * 64 + cc * 2; return st * 1024 + (ob ^ (((ob >> 9) & 1) << 5)); }
__host__ __device__ __forceinline__ void stage_rc(int b, int& R, int& C) { const int st = b / 1024, sb = b % 1024, swz = sb ^ (((sb >> 9) & 1) << 5); R = (st >> 1) * 16 + swz / 64; C = (st & 1) * 32 + (swz % 64) / 2; }
__host__ __device__ __forceinline__ int perm32(int rho) { const int n = rho >> 4, i = rho & 15; return 8 * (i >> 2) + 4 * n + (i & 3); }
struct Unit { int pm, pn; };
struct Gemm { const bf16_t* A; const bf16_t* Bt; int M, N, K; int a_rows; };
struct StaticOrder {
    int nM, nN, nwg, G, c;
    __host__ __device__ void init(int M, int N, int G_, int c_) { nM = M / BM; nN = N / BM; nwg = nM * nN; G = G_; c = c_; }
    __host__ __device__ bool next(int i, Unit& u) const {
        const long L = (long)i * G + c; if (L >= nwg) return false;
        int wgid = (int)L; { const int q = nwg / NXCD, r = nwg % NXCD, xcd = wgid % NXCD, off = wgid / NXCD; wgid = (xcd < r ? xcd * (q + 1) : r * (q + 1) + (xcd - r) * q) + off; }
        const int nig = WGM * nN, gid = wgid / nig, fm = gid * WGM, gsz = (nM - fm) < WGM ? (nM - fm) : WGM;
        u.pm = fm + ((wgid % nig) % gsz); u.pn = (wgid % nig) / gsz; return true;
    }
    __device__ __forceinline__ void a_ready(const Unit&) const {}
    __device__ __forceinline__ void done(const Unit&) const {}
};
template <class Epi, class Sched, bool STAMP = false>
__device__ __forceinline__ void gemm_phase(PG8_LAS unsigned char* lds, const Gemm g, const Sched& S, const Epi& E, unsigned long long* stamps) {
    const int tid = ltid(), wid = __builtin_amdgcn_readfirstlane(tid >> 6), lane = tid & 63, wr = wid >> 2, wc = wid & 3, fr = lane & 15, fq = lane >> 4;
    const int K = g.K, nt = K / BK;
    int ts_lo = 0, ts_hi = 0, nts = 0; const unsigned long long rt_entry = STAMP ? (unsigned long long)wall_clock64() : 0ull;
#define PG8_STAMP() do { if (STAMP && wid == 0 && nts < 64) { const unsigned long long _c = (unsigned long long)clock64(); \
        ts_lo = (lane == nts) ? (int)(unsigned)_c : ts_lo; ts_hi = (lane == nts) ? (int)(unsigned)(_c >> 32) : ts_hi; ++nts; } } while (0)
    PG8_STAMP();
    unsigned voffA[2], voffB[2];
#pragma unroll
    for (int i = 0; i < 2; ++i) { int R, C; stage_rc(tid * 16 + i * 8192, R, C); const int Rb = Epi::PERM ? ((R & ~31) + perm32(R & 31)) : R;
        voffA[i] = (unsigned)(R * K + C) * 2u; voffB[i] = (unsigned)(Rb * K + C) * 2u; }
    const size_t kstep = (size_t)(BK * 2);
    const size_t hstep = (size_t)HALF * K * 2;
    const size_t tstep = 2 * hstep;
    const size_t tstepA = (size_t)g.a_rows * K * 2;
    const unsigned ldsw = (unsigned)wid * 1024u;
    const int aoff = lds_byte(wr * 64 + fr, fq * 8), boff = lds_byte(wc * 32 + fr, fq * 8);
#define PG8_SA(b, h) (((b) * 2 + (h)) * HTB)
#define PG8_SB(b, h) ((4 + (b) * 2 + (h)) * HTB)
#define PG8_STAGE(bufoff, gbase, voff) do { _Pragma("unroll") for (int _i = 0; _i < 2; ++_i) \
        __builtin_amdgcn_global_load_lds((const unsigned*)((const char*)(gbase) + (voff)[_i]), (PG8_LAS unsigned*)(lds + (bufoff) + ldsw + _i * 8192), 16, 0, 0); } while (0)
#define PG8_LDA(dst, b, h) do { _Pragma("unroll") for (int m = 0; m < 4; ++m) _Pragma("unroll") for (int k = 0; k < 2; ++k) dst[m][k] = *(const PG8_LAS bf16x8*)(lds + PG8_SA(b, h) + aoff + m * 2048 + k * 1024); } while (0)
#define PG8_LDB(dst, b, h) do { _Pragma("unroll") for (int n = 0; n < 2; ++n) _Pragma("unroll") for (int k = 0; k < 2; ++k) dst[n][k] = *(const PG8_LAS bf16x8*)(lds + PG8_SB(b, h) + boff + n * 2048 + k * 1024); } while (0)
#define PG8_MMA(ai, bj, At, Bt) do { __builtin_amdgcn_s_setprio(1); _Pragma("unroll") for (int m = 0; m < 4; ++m) _Pragma("unroll") for (int n = 0; n < 2; ++n) _Pragma("unroll") for (int k = 0; k < 2; ++k) \
        acc[ai][bj][m][n] = __builtin_amdgcn_mfma_f32_16x16x32_f16(Bt[n][k], At[m][k], acc[ai][bj][m][n], 0, 0, 0); __builtin_amdgcn_s_setprio(0); } while (0)
#define PG8_WAIT_V(n) asm volatile("s_waitcnt vmcnt(" #n ")" ::: "memory")
#define PG8_WAIT_L(n) asm volatile("s_waitcnt lgkmcnt(" #n ")" ::: "memory")
#define PG8_BAR __builtin_amdgcn_s_barrier()
#define PG8_SCHED __builtin_amdgcn_sched_barrier(0)
    Unit cur, nxt; int ui = 0;
    if (!S.next(0, cur)) return;
    f32x4 acc[2][2][4][2];
#pragma unroll
    for (int a = 0; a < 2; ++a)
#pragma unroll
        for (int b = 0; b < 2; ++b)
#pragma unroll
            for (int m = 0; m < 4; ++m)
#pragma unroll
                for (int n = 0; n < 2; ++n) acc[a][b][m][n] = (f32x4){0.f, 0.f, 0.f, 0.f};
    bf16x8 At[4][2], B0[2][2], B1[2][2];
    const char* cA = (const char*)g.A + (size_t)cur.pm * tstepA; const char* cB = (const char*)g.Bt + (size_t)cur.pn * tstep;
    S.a_ready(cur);
    PG8_STAGE(PG8_SB(0, 0), cB, voffB); PG8_STAGE(PG8_SA(0, 0), cA, voffA); PG8_STAGE(PG8_SB(0, 1), cB + hstep, voffB); PG8_STAGE(PG8_SA(0, 1), cA + hstep, voffA);
    if (wr == 1) PG8_BAR;
    PG8_WAIT_V(4); PG8_BAR;
    PG8_STAGE(PG8_SB(1, 0), cB + kstep, voffB); PG8_STAGE(PG8_SA(1, 0), cA + kstep, voffA); PG8_STAGE(PG8_SB(1, 1), cB + hstep + kstep, voffB);
    PG8_WAIT_V(6); PG8_BAR;
    PG8_STAMP();
    for (;;) {
        const bool has_next = S.next(ui + 1, nxt);
        const char* nA = has_next ? (const char*)g.A + (size_t)nxt.pm * tstepA : cA; const char* nB = has_next ? (const char*)g.Bt + (size_t)nxt.pn * tstep : cB;
        for (int t = 0; t < nt; t += 2) {
            const bool last = (t == nt - 2);
            const char* a1 = cA + (size_t)(t + 1) * kstep;
            const char* a2 = last ? nA : cA + (size_t)(t + 2) * kstep; const char* b2 = last ? nB : cB + (size_t)(t + 2) * kstep;
            const char* a3 = a2 + kstep; const char* b3 = b2 + kstep;
            if (last && has_next) S.a_ready(nxt);
            PG8_LDB(B0, 0, 0); PG8_SCHED; PG8_LDA(At, 0, 0); PG8_STAGE(PG8_SA(1, 1), a1 + hstep, voffA);
            PG8_WAIT_L(8); PG8_BAR; PG8_WAIT_L(0); PG8_MMA(0, 0, At, B0); PG8_BAR; PG8_SCHED;
            PG8_LDB(B1, 0, 1); PG8_STAGE(PG8_SB(0, 0), b2, voffB);
            PG8_BAR; PG8_WAIT_L(0); PG8_MMA(0, 1, At, B1); PG8_BAR;
            PG8_LDA(At, 0, 1); PG8_STAGE(PG8_SA(0, 0), a2, voffA);
            PG8_BAR; PG8_WAIT_L(0); PG8_MMA(1, 0, At, B0); PG8_BAR; PG8_SCHED;
            PG8_STAGE(PG8_SB(0, 1), b2 + hstep, voffB);
            PG8_WAIT_V(6); PG8_BAR; PG8_MMA(1, 1, At, B1); PG8_BAR;
            PG8_LDB(B0, 1, 0); PG8_SCHED; PG8_LDA(At, 1, 0); PG8_STAGE(PG8_SA(0, 1), a2 + hstep, voffA);
            PG8_WAIT_L(8); PG8_BAR; PG8_WAIT_L(0); PG8_MMA(0, 0, At, B0); PG8_BAR; PG8_SCHED;
            PG8_LDB(B1, 1, 1); PG8_STAGE(PG8_SB(1, 0), b3, voffB);
            PG8_BAR; PG8_WAIT_L(0); PG8_MMA(0, 1, At, B1); PG8_BAR;
            PG8_LDA(At, 1, 1); PG8_STAGE(PG8_SA(1, 0), a3, voffA);
            PG8_BAR; PG8_WAIT_L(0); PG8_MMA(1, 0, At, B0); PG8_BAR; PG8_SCHED;
            PG8_STAGE(PG8_SB(1, 1), b3 + hstep, voffB);
            PG8_WAIT_V(6); PG8_BAR; PG8_MMA(1, 1, At, B1); PG8_BAR;
        }
        PG8_STAMP();
        if constexpr (!Epi::AFTER_DRAIN) { E(acc, cur, wr, wc, fr, fq); S.done(cur); }
        PG8_STAMP();
        if (!has_next) break;
#pragma unroll
        for (int a = 0; a < 2; ++a)
#pragma unroll
            for (int b = 0; b < 2; ++b)
#pragma unroll
                for (int m = 0; m < 4; ++m)
#pragma unroll
                    for (int n = 0; n < 2; ++n) acc[a][b][m][n] = (f32x4){0.f, 0.f, 0.f, 0.f};
        cur = nxt; cA = nA; cB = nB; ++ui;
    }
    PG8_WAIT_V(0);
    if (wr == 0) PG8_BAR;
    PG8_BAR;
    if constexpr (Epi::AFTER_DRAIN) { E.fused(acc, cur, wr, wc, fr, fq, lds, wid, lane); S.done(cur); }
    PG8_STAMP();
    if (STAMP && wid == 0) { stamps[lane] = lane < nts ? (((unsigned long long)(unsigned)ts_hi << 32) | (unsigned)ts_lo) : 0ull;
        if (lane == 62) stamps[62] = rt_entry; if (lane == 63) stamps[63] = (unsigned long long)wall_clock64(); }
#undef PG8_STAMP
#undef PG8_SA
#undef PG8_SB
#undef PG8_STAGE
#undef PG8_LDA
#undef PG8_LDB
#undef PG8_MMA
#undef PG8_WAIT_V
#undef PG8_WAIT_L
#undef PG8_BAR
#undef PG8_SCHED
}
}
using pg8::Unit;

constexpr size_t OFF_MOD = 0;
constexpr size_t OFF_COS = 786432;
constexpr size_t OFF_SIN = OFF_COS + 2097152;
constexpr size_t OFF_W   = OFF_SIN + 2097152;
constexpr size_t W_QKV = 0, W_B = W_QKV + 3072 * 1024, W_F2 = W_B + 4096 * 1024, W_R = W_F2 + 1024 * 2048, W_O = W_R + 1024 * 1024, W_UP = W_O + 1024 * 1024, W_DN = W_UP + 5632 * 1024, W_FT = W_DN + 1024 * 2816, W_DF = W_FT + 1024 * 1024, W_END = W_DF + 2048 * 1024;
constexpr size_t OFF_H  = OFF_W + W_END * 2;
constexpr size_t ACT = (size_t)MTOK * DM * 2;
constexpr size_t OFF_RA = OFF_H + ACT;
constexpr size_t OFF_RB = OFF_RA + ACT;
constexpr size_t OFF_RC = OFF_RB + ACT;
constexpr size_t OFF_RD = OFF_RC + ACT;
constexpr size_t OFF_RE = OFF_RD + 2 * ACT;
constexpr size_t OFF_BAR = OFF_RE + ACT;
constexpr size_t WS_END = OFF_BAR + 16384;

DI u32x4 pack8(const f32x4& a, const f32x4& b) { u32x4 w; w.x = pkh(a[0], a[1]); w.y = pkh(a[2], a[3]); w.z = pkh(b[0], b[1]); w.w = pkh(b[2], b[3]); return w; }

struct EpiQKV {
    static constexpr bool PERM = true, AFTER_DRAIN = false;
    h16 *Q; const float *cosT, *sinT;
    DI void operator()(const f32x4 (&acc)[2][2][4][2], const Unit& u, int wr, int wc, int fr, int fq) const {
        const int sec = u.pn >> 2, head = u.pn & 3, colh = wc * 32 + 8 * fq;
        h16* base = Q + (size_t)sec * ((size_t)MTOK * DM);
        const float scl = sec == 0 ? 0.0625f : 1.0f;
        const int row0 = u.pm * 256 + wr * 64 + fr;
        if (sec == 2) {
#pragma unroll
            for (int it = 0; it < 8; ++it) {
                const int ai = it >> 2, m = it & 3;
                h16* rowp = base + (size_t)(row0 + ai * 128 + m * 16) * DM + head * 256 + colh;
                *(u32x4*)(rowp) = pack8(acc[ai][0][m][0], acc[ai][0][m][1]);
                *(u32x4*)(rowp + 128) = pack8(acc[ai][1][m][0], acc[ai][1][m][1]);
            }
        } else {
            f32x4 cs[2][4];
#define QKV_LD(it_, st_) do { const int pos_ = (row0 + ((it_) >> 2) * 128 + ((it_) & 3) * 16) & (SEQ - 1); const float* c_ = cosT + pos_ * 128 + colh; const float* s_ = sinT + pos_ * 128 + colh; \
            cs[st_][0] = *(const f32x4*)c_; cs[st_][1] = *(const f32x4*)(c_ + 4); cs[st_][2] = *(const f32x4*)s_; cs[st_][3] = *(const f32x4*)(s_ + 4); } while (0)
            QKV_LD(0, 0);
#pragma unroll
            for (int it = 0; it < 8; ++it) {
                const int ai = it >> 2, m = it & 3, st = it & 1;
                if (it + 1 < 8) QKV_LD(it + 1, st ^ 1);
                __builtin_amdgcn_sched_barrier(0);
                h16* rowp = base + (size_t)(row0 + ai * 128 + m * 16) * DM + head * 256 + colh;
                f32x4 o1[2], o2[2];
#pragma unroll
                for (int n = 0; n < 2; ++n) {
                    const f32x4 c = cs[st][n], sn = cs[st][2 + n];
                    const f32x4 t1 = acc[ai][0][m][n], t2 = acc[ai][1][m][n];
                    o1[n] = (t1 * c - t2 * sn) * scl; o2[n] = (t1 * sn + t2 * c) * scl;
                }
                *(u32x4*)(rowp) = pack8(o1[0], o1[1]);
                *(u32x4*)(rowp + 128) = pack8(o2[0], o2[1]);
            }
#undef QKV_LD
        }
    }
};
struct EpiB {
    static constexpr bool PERM = true, AFTER_DRAIN = false;
    unsigned char* ws;
    DI void operator()(const f32x4 (&acc)[2][2][4][2], const Unit& u, int wr, int wc, int fr, int fq) const {
        const int sec = u.pn >> 2, cs = (u.pn & 3) * 256 + wc * 32 + 8 * fq;
        const size_t boff = sec == 0 ? OFF_RC : (sec == 1 ? OFF_RE : (sec == 2 ? OFF_RA : OFF_RB));
        h16* base = (h16*)(ws + boff);
        const int row0 = u.pm * 256 + wr * 64 + fr;
        u32x4 yv[2][2];
#define EB_LD(it_, st_) do { const int r_ = row0 + ((it_) >> 2) * 128 + ((it_) & 3) * 16; yv[st_][0] = *(const u32x4*)(base + (size_t)r_ * DM + cs); yv[st_][1] = *(const u32x4*)(base + (size_t)r_ * DM + cs + 128); } while (0)
        if (sec == 1) EB_LD(0, 0);
#pragma unroll
        for (int it = 0; it < 8; ++it) {
            const int ai = it >> 2, m = it & 3, st = it & 1;
            if (sec == 1 && it + 1 < 8) EB_LD(it + 1, st ^ 1);
            __builtin_amdgcn_sched_barrier(0);
            const int row = row0 + ai * 128 + m * 16;
#pragma unroll
            for (int bj = 0; bj < 2; ++bj) {
                h16* p = base + (size_t)row * DM + cs + bj * 128;
                if (sec == 0) { const int ch = cs + bj * 128; p = base + ((size_t)((row >> 12) * 64 + (ch >> 4)) * SEQ + (row & (SEQ - 1))) * 16 + (ch & 15); }
                f32x4 v0 = acc[ai][bj][m][0], v1 = acc[ai][bj][m][1];
                if (sec == 1) {
                    const u32x4 y = yv[st][bj];
#pragma unroll
                    for (int e = 0; e < 2; ++e) {
                        const f32x2 ya = unpkh(y[e]), yb = unpkh(y[2 + e]);
                        v0[2 * e] = ya.x * v0[2 * e] * sigmoidf_(v0[2 * e]); v0[2 * e + 1] = ya.y * v0[2 * e + 1] * sigmoidf_(v0[2 * e + 1]);
                        v1[2 * e] = yb.x * v1[2 * e] * sigmoidf_(v1[2 * e]); v1[2 * e + 1] = yb.y * v1[2 * e + 1] * sigmoidf_(v1[2 * e + 1]);
                    }
                } else if (sec >= 2) {
#pragma unroll
                    for (int e = 0; e < 4; ++e) { v0[e] = sigmoidf_(v0[e]); v1[e] = sigmoidf_(v1[e]); }
                }
                *(u32x4*)p = pack8(v0, v1);
            }
        }
#undef EB_LD
    }
};
template <int MODE> struct EpiMerge {
    static constexpr bool PERM = true, AFTER_DRAIN = false;
    h16* T; const h16* G;
    DI void operator()(const f32x4 (&acc)[2][2][4][2], const Unit& u, int wr, int wc, int fr, int fq) const {
        const int cs = u.pn * 256 + wc * 32 + 8 * fq;
        const int row0 = u.pm * 256 + wr * 64 + fr;
        u32x4 gv[2][2], tv[2][2];
#define EM_LD(it_, st_) do { const size_t o_ = (size_t)(row0 + ((it_) >> 2) * 128 + ((it_) & 3) * 16) * DM + cs; gv[st_][0] = *(const u32x4*)(G + o_); gv[st_][1] = *(const u32x4*)(G + o_ + 128); \
        if (MODE == 1) { tv[st_][0] = *(const u32x4*)(T + o_); tv[st_][1] = *(const u32x4*)(T + o_ + 128); } } while (0)
        EM_LD(0, 0);
#pragma unroll
        for (int it = 0; it < 8; ++it) {
            const int ai = it >> 2, m = it & 3, st = it & 1;
            if (it + 1 < 8) EM_LD(it + 1, st ^ 1);
            __builtin_amdgcn_sched_barrier(0);
            const int row = row0 + ai * 128 + m * 16;
#pragma unroll
            for (int bj = 0; bj < 2; ++bj) {
                const size_t o = (size_t)row * DM + cs + bj * 128;
                const u32x4 g = gv[st][bj];
                f32x4 v0 = acc[ai][bj][m][0], v1 = acc[ai][bj][m][1];
#pragma unroll
                for (int e = 0; e < 2; ++e) {
                    const f32x2 ga = unpkh(g[e]), gb = unpkh(g[2 + e]);
                    v0[2 * e] *= ga.x; v0[2 * e + 1] *= ga.y; v1[2 * e] *= gb.x; v1[2 * e + 1] *= gb.y;
                    if (MODE == 1) { const f32x2 ta = unpkh(tv[st][bj][e]), tb = unpkh(tv[st][bj][2 + e]); v0[2 * e] += ta.x; v0[2 * e + 1] += ta.y; v1[2 * e] += tb.x; v1[2 * e + 1] += tb.y; }
                }
                *(u32x4*)(T + o) = pack8(v0, v1);
            }
        }
#undef EM_LD
    }
};
struct EpiRes {
    static constexpr bool PERM = false, AFTER_DRAIN = false;
    const float* xi; float* xo; const float* gate; int rowoff;
    DI void operator()(const f32x4 (&acc)[2][2][4][2], const Unit& u, int wr, int wc, int fr, int fq) const {
        const int c0 = u.pn * 256 + wc * 32 + 4 * fq;
        const int row0 = rowoff + u.pm * 256 + wr * 64 + fr;
        const float* gp = gate + (size_t)((rowoff + u.pm * 256) >> 12) * 6144;
        f32x4 gvv[4], xv[2][4];
#pragma unroll
        for (int q = 0; q < 4; ++q) gvv[q] = *(const f32x4*)(gp + c0 + (q >> 1) * 128 + (q & 1) * 16);
#define ER_LD(it_, st_) do { const float* x_ = xi + (size_t)(row0 + ((it_) >> 2) * 128 + ((it_) & 3) * 16) * DM + c0; \
        xv[st_][0] = *(const f32x4*)x_; xv[st_][1] = *(const f32x4*)(x_ + 16); xv[st_][2] = *(const f32x4*)(x_ + 128); xv[st_][3] = *(const f32x4*)(x_ + 144); } while (0)
        ER_LD(0, 0);
#pragma unroll
        for (int it = 0; it < 8; ++it) {
            const int ai = it >> 2, m = it & 3, st = it & 1;
            if (it + 1 < 8) ER_LD(it + 1, st ^ 1);
            __builtin_amdgcn_sched_barrier(0);
            float* xr = xo + (size_t)(row0 + ai * 128 + m * 16) * DM + c0;
#pragma unroll
            for (int q = 0; q < 4; ++q) *(f32x4*)(xr + (q >> 1) * 128 + (q & 1) * 16) = xv[st][q] + gvv[q] * acc[ai][q >> 1][m][q & 1];
        }
#undef ER_LD
    }
};
DI f32x2 gelu_pk(f32x2 v) {
    const f32x2 av = __builtin_elementwise_abs(v), d = av * 0.2316418882f + 1.0f;
    f32x2 t; t.x = __builtin_amdgcn_rcpf(d.x); t.y = __builtin_amdgcn_rcpf(d.y);
    f32x2 q = t * 0.5307027145f + (-0.7265760135f); q = q * t + 0.7107068705f; q = q * t + (-0.142248368f); q = q * t + 0.127414796f; q = q * t;
    const f32x2 s = (v * v) * (-0.72134752044f);
    f32x2 e; e.x = __builtin_amdgcn_exp2f(s.x); e.y = __builtin_amdgcn_exp2f(s.y);
    const f32x2 m = v * (q * e), r = v - m;
    f32x2 o; o.x = v.x < 0.f ? m.x : r.x; o.y = v.y < 0.f ? m.y : r.y; return o;
}

#define DPP_SHR1(old, v) ((fr == 0) ? (old) : __builtin_bit_cast(float, __builtin_amdgcn_update_dpp(0, __builtin_bit_cast(int, (v)), 0x111, 0xf, 0xf, true)))
#define DPP_SHL1(old, v) ((fr == 15) ? (old) : __builtin_bit_cast(float, __builtin_amdgcn_update_dpp(0, __builtin_bit_cast(int, (v)), 0x101, 0xf, 0xf, true)))
#define DPP_ROR1(v)  __builtin_bit_cast(float, __builtin_amdgcn_update_dpp(0, __builtin_bit_cast(int, (v)), 0x121, 0xf, 0xf, false))
#define DPP_ROR15(v) __builtin_bit_cast(float, __builtin_amdgcn_update_dpp(0, __builtin_bit_cast(int, (v)), 0x12f, 0xf, 0xf, false))
struct EpiUpConv {
    static constexpr bool PERM = true, AFTER_DRAIN = false;
    h16* HID; const float* cw; const float* cb; LAS unsigned char* lds;
    DI void operator()(const f32x4 (&acc)[2][2][4][2], const Unit& u, int wr, int wc, int fr, int fq) const {
        LAS float* xb = (LAS float*)(lds + 131072);
        const int wave = wr * 4 + wc;
#pragma unroll
        for (int ai = 0; ai < 2; ++ai)
#pragma unroll
            for (int bj = 0; bj < 2; ++bj)
#pragma unroll
                for (int n = 0; n < 2; ++n) {
                    if (fr == 0)  *(LAS f32x4*)(xb + ((wave * 2 + ai) * 2 + 0) * 64 + bj * 32 + 8 * fq + 4 * n) = acc[ai][bj][0][n];
                    if (fr == 15) *(LAS f32x4*)(xb + ((wave * 2 + ai) * 2 + 1) * 64 + bj * 32 + 8 * fq + 4 * n) = acc[ai][bj][3][n];
                }
        asm volatile("s_waitcnt lgkmcnt(0)" ::: "memory"); __builtin_amdgcn_s_barrier(); asm volatile("" ::: "memory");
        __builtin_amdgcn_s_barrier(); asm volatile("" ::: "memory");
        const int chl = u.pn * 128 + wc * 32 + 8 * fq;
        const int lane_ = fq * 16 + fr;
        const int srcp = 4 * (fr == 0 ? lane_ + 15 : lane_ - 1), srcn = 4 * (fr == 15 ? lane_ - 15 : lane_ + 1);
#pragma unroll
        for (int n = 0; n < 2; ++n) {
            f32x4 wa[3], wb[3];
#pragma unroll
            for (int i = 0; i < 3; ++i) { wa[i] = *(const f32x4*)(cw + i * 2 * DFF + chl + 4 * n); wb[i] = *(const f32x4*)(cw + i * 2 * DFF + DFF + chl + 4 * n); }
            const f32x4 ba = *(const f32x4*)(cb + chl + 4 * n), bb = *(const f32x4*)(cb + DFF + chl + 4 * n);
#pragma unroll
            for (int ai = 0; ai < 2; ++ai) {
                const int wpv = wr ? wave - 4 : wave + 4, aipv = wr ? ai : 0, ainx = wr ? 1 : ai;
                const f32x4 xpa = *(const LAS f32x4*)(xb + ((wpv * 2 + aipv) * 2 + 1) * 64 + 0 * 32 + 8 * fq + 4 * n), xpb = *(const LAS f32x4*)(xb + ((wpv * 2 + aipv) * 2 + 1) * 64 + 1 * 32 + 8 * fq + 4 * n);
                const f32x4 xna = *(const LAS f32x4*)(xb + ((wpv * 2 + ainx) * 2 + 0) * 64 + 0 * 32 + 8 * fq + 4 * n), xnb = *(const LAS f32x4*)(xb + ((wpv * 2 + ainx) * 2 + 0) * 64 + 1 * 32 + 8 * fq + 4 * n);
#pragma unroll
                for (int m = 0; m < 4; ++m) {
                    __builtin_amdgcn_sched_barrier(0);
                    const int lr = ai * 128 + wr * 64 + m * 16 + fr, gr = u.pm * 254 - 1 + lr, pos = gr & (SEQ - 1);
                    const bool okp = pos != 0, okn = pos != SEQ - 1;
                    f32x2 ga[2], gb[2];
#pragma unroll
                    for (int e = 0; e < 4; ++e) {
                        const float xa = acc[ai][0][m][n][e], xbv = acc[ai][1][m][n][e];
                        const float za = (fr == 15 && m > 0) ? acc[ai][0][m > 0 ? m - 1 : 0][n][e] : xa, zb = (fr == 15 && m > 0) ? acc[ai][1][m > 0 ? m - 1 : 0][n][e] : xbv;
                        const float ya = (fr == 0 && m < 3) ? acc[ai][0][m < 3 ? m + 1 : 3][n][e] : xa, yb = (fr == 0 && m < 3) ? acc[ai][1][m < 3 ? m + 1 : 3][n][e] : xbv;
                        float pa = __builtin_bit_cast(float, __builtin_amdgcn_ds_bpermute(srcp, __builtin_bit_cast(int, za)));
                        float pb = __builtin_bit_cast(float, __builtin_amdgcn_ds_bpermute(srcp, __builtin_bit_cast(int, zb)));
                        float na = __builtin_bit_cast(float, __builtin_amdgcn_ds_bpermute(srcn, __builtin_bit_cast(int, ya)));
                        float nb = __builtin_bit_cast(float, __builtin_amdgcn_ds_bpermute(srcn, __builtin_bit_cast(int, yb)));
                        if (m == 0) { pa = fr == 0 ? xpa[e] : pa; pb = fr == 0 ? xpb[e] : pb; }
                        if (m == 3) { na = fr == 15 ? xna[e] : na; nb = fr == 15 ? xnb[e] : nb; }
                        pa = okp ? pa : 0.f; pb = okp ? pb : 0.f; na = okn ? na : 0.f; nb = okn ? nb : 0.f;
                        const float ca = wa[0][e] * pa + (wa[1][e] * xa + (wa[2][e] * na + ba[e]));
                        const float cbv = wb[0][e] * pb + (wb[1][e] * xbv + (wb[2][e] * nb + bb[e]));
                        if (e & 1) { ga[e >> 1].y = ca; gb[e >> 1].y = cbv; } else { ga[e >> 1].x = ca; gb[e >> 1].x = cbv; }
                    }
                    const f32x2 g0 = gelu_pk(ga[0]), g1 = gelu_pk(ga[1]);
                    u32x2 o; o.x = pkh(g0.x * gb[0].x, g0.y * gb[0].y); o.y = pkh(g1.x * gb[1].x, g1.y * gb[1].y);
                    if (lr >= 1 && lr <= 254 && gr < MTOK) *(u32x2*)(HID + (size_t)gr * DFF + chl + 4 * n) = o;
                }
            }
        }
    }
};

struct EpiStore {
    static constexpr bool PERM = true, AFTER_DRAIN = false;
    h16* O; int ldc;
    DI void operator()(const f32x4 (&acc)[2][2][4][2], const Unit& u, int wr, int wc, int fr, int fq) const {
        const int cs = u.pn * 256 + wc * 32 + 8 * fq;
#pragma unroll
        for (int ai = 0; ai < 2; ++ai)
#pragma unroll
            for (int m = 0; m < 4; ++m) {
                __builtin_amdgcn_sched_barrier(0);
                const int row = u.pm * 256 + ai * 128 + wr * 64 + m * 16 + fr;
#pragma unroll
                for (int bj = 0; bj < 2; ++bj) *(u32x4*)(O + (size_t)row * ldc + cs + bj * 128) = pack8(acc[ai][bj][m][0], acc[ai][bj][m][1]);
            }
    }
};


struct Params {
    const float *x, *c, *n1g, *n2g, *ada_w, *ada_b, *w_in, *w_f, *w_r, *w_o, *w_up, *conv_w, *conv_b, *w_dn, *fin_g;
    float* out; unsigned char* ws;
    float lgf[4], lgb[4];
    int ph0, ph1;
};

constexpr int LDS_BYTES = 160 * 1024;
constexpr int NST = 11;
constexpr int NTHR = 512;

DI void phase_prep(const Params& p, LAS unsigned char* lds) {
    const int tid = ltid();
    LAS float* cact = (LAS float*)lds;
    LAS float* red = (LAS float*)(lds + 32768);
    for (int i = tid; i < 8 * 1024; i += NTHR) { const float v = p.c[i]; cact[i] = v / (1.0f + __expf(-v)); }
    __syncthreads();
    float* MOD = (float*)(p.ws + OFF_MOD);
    for (int it = blockIdx.x; it < 256; it += gridDim.x) {
        const int l = it >> 6, j0 = (it & 63) * 96;
        if (tid < 480) {
            const int col = tid % 96, part = tid / 96, d0 = part * 205, d1 = (d0 + 205 < 1024) ? d0 + 205 : 1024;
            float a[8];
#pragma unroll
            for (int b = 0; b < 8; ++b) a[b] = 0.f;
            const float* wp = p.ada_w + ((size_t)l * 1024) * 6144 + j0 + col;
            for (int d = d0; d < d1; d += 16) {
                float wv_[16];
#pragma unroll
                for (int k = 0; k < 16; ++k) wv_[k] = (d + k < d1) ? wp[(size_t)(d + k) * 6144] : 0.f;
#pragma unroll
                for (int k = 0; k < 16; ++k)
#pragma unroll
                    for (int b = 0; b < 8; ++b) a[b] += cact[b * 1024 + ((d + k < 1024) ? d + k : 1023)] * wv_[k];
            }
#pragma unroll
            for (int b = 0; b < 8; ++b) red[(part * 8 + b) * 96 + col] = a[b];
        }
        __syncthreads();
        for (int i = tid; i < 768; i += NTHR) {
            const int b = i / 96, col = i % 96;
            float s = p.ada_b[l * 6144 + j0 + col];
#pragma unroll
            for (int part = 0; part < 5; ++part) s += red[(part * 8 + b) * 96 + col];
            MOD[((size_t)l * 8 + b) * 6144 + j0 + col] = s;
        }
        __syncthreads();
    }
    {
        h16* DF = (h16*)(p.ws + OFF_W) + W_DF;
        for (int it = blockIdx.x * NTHR + tid; it < 2048 * 128; it += gridDim.x * NTHR) {
            const int kk = it >> 7, ch0 = (it & 127) * 8;
            const int cb = kk >> 5, part = (kk >> 4) & 1, chk = cb * 16 + (kk & 15), g = chk >> 7, c2 = chk & 127;
            float a[8];
#pragma unroll
            for (int e = 0; e < 8; ++e) { const int ch = ch0 + e; const int t = (c2 * (ch & 127) - (part ? 32 : 0)) & 127;
                a[e] = ((ch >> 7) == g) ? __builtin_amdgcn_cosf((float)t * (1.0f / 128.0f)) * 0.08838834764831845f : 0.f; }
            u32x4 ov; ov.x = pkh(a[0], a[1]); ov.y = pkh(a[2], a[3]); ov.z = pkh(a[4], a[5]); ov.w = pkh(a[6], a[7]);
            *(u32x4*)(DF + (size_t)kk * 1024 + ch0) = ov;
        }
    }
    float* cosT = (float*)(p.ws + OFF_COS); float* sinT = (float*)(p.ws + OFF_SIN);
    for (int i = blockIdx.x * NTHR + tid; i < SEQ * 128; i += gridDim.x * NTHR) {
        const int pos = i >> 7, j = i & 127;
        const float invf = exp2f(-(float)j * (13.287712379549449f / 128.0f));
        const float ang = (float)pos * invf;
        const double rev = (double)ang * 0.15915494309189535;
        const float fr = (float)(rev - floor(rev));
        cosT[i] = __builtin_amdgcn_cosf(fr); sinT[i] = __builtin_amdgcn_sinf(fr);
    }
}

DI void transpose_item(const float* W, int K, int ldn, int c0, int ncols, h16* WT, int row_off, LAS float* scr, int item, int lane) {
    const int nblk = ncols / 32, kb = item / nblk, nb = item % nblk, k0 = 64 * kb, n0 = 32 * nb;
    f32x4 v[8];
    const float* src = W + (size_t)(k0 + (lane >> 3)) * ldn + c0 + n0 + 4 * (lane & 7);
#pragma unroll
    for (int i = 0; i < 8; ++i) v[i] = *(const f32x4*)(src + (size_t)(8 * i) * ldn);
#pragma unroll
    for (int i = 0; i < 8; ++i) { LAS float* d = scr + ((lane >> 3) + 8 * i) * 33 + 4 * (lane & 7); d[0] = v[i].x; d[1] = v[i].y; d[2] = v[i].z; d[3] = v[i].w; }
    asm volatile("s_waitcnt lgkmcnt(0)" ::: "memory");
    const int c = lane & 7;
#pragma unroll
    for (int j = 0; j < 4; ++j) { const int n = (lane >> 3) + 8 * j; const LAS float* s = scr + (8 * c) * 33 + n;
        u32x4 o; o.x = pkh(s[0 * 33], s[1 * 33]); o.y = pkh(s[2 * 33], s[3 * 33]); o.z = pkh(s[4 * 33], s[5 * 33]); o.w = pkh(s[6 * 33], s[7 * 33]);
        *(u32x4*)(WT + (size_t)(row_off + n0 + n) * K + k0 + 8 * c) = o; }
    asm volatile("s_waitcnt lgkmcnt(0)" ::: "memory");
}

DI void norm_row(const float* xrow, const float* g, const float* sc, const float* sh, h16* orow, int lane) {
    f32x4 v[4]; float s = 0.f;
#pragma unroll
    for (int j = 0; j < 4; ++j) { v[j] = *((const f32x4*)xrow + lane + 64 * j); s += (v[j].x * v[j].x + v[j].y * v[j].y) + (v[j].z * v[j].z + v[j].w * v[j].w); }
    const float r = rsqrtf(wave_sum(s) * (1.0f / DM) + EPS);
#pragma unroll
    for (int j = 0; j < 4; ++j) {
        const int c = 4 * (lane + 64 * j);
        const f32x4 gv = *(const f32x4*)(g + c), scv = *(const f32x4*)(sc + c), shv = *(const f32x4*)(sh + c);
        const f32x4 y = v[j] * r * gv * (scv + 1.0f) + shv;
        u32x2 o; o.x = pkh(y.x, y.y); o.y = pkh(y.z, y.w);
        *(u32x2*)(orow + c) = o;
    }
}


DI void norm_rows(const float* xs, const float* g, const float* modsc, const float* modsh, h16* H, int gw, int NGW, int lane) {
    f32x4 gv[4];
#pragma unroll
    for (int j = 0; j < 4; ++j) gv[j] = *((const f32x4*)g + lane + 64 * j);
    f32x4 v[2][4], sc[2][4], sh[2][4];
#define NR_LD(row_, st_) do { const float* x_ = xs + (size_t)(row_) * DM; const float* c_ = modsc + (size_t)((row_) >> 12) * 6144; const float* h_ = modsh + (size_t)((row_) >> 12) * 6144; \
    _Pragma("unroll") for (int j = 0; j < 4; ++j) { v[st_][j] = *((const f32x4*)x_ + lane + 64 * j); sc[st_][j] = *((const f32x4*)c_ + lane + 64 * j); sh[st_][j] = *((const f32x4*)h_ + lane + 64 * j); } } while (0)
    if (gw < MTOK) NR_LD(gw, 0);
    int st = 0;
    for (int row = gw; row < MTOK; row += NGW) {
        if (row + NGW < MTOK) { if (st == 0) NR_LD(row + NGW, 1); else NR_LD(row + NGW, 0); }
        float s = 0.f;
        f32x4 w[4], c[4], hh[4];
#pragma unroll
        for (int j = 0; j < 4; ++j) { w[j] = st ? v[1][j] : v[0][j]; c[j] = st ? sc[1][j] : sc[0][j]; hh[j] = st ? sh[1][j] : sh[0][j]; s += (w[j].x * w[j].x + w[j].y * w[j].y) + (w[j].z * w[j].z + w[j].w * w[j].w); }
        const float r = rsqrtf(wave_sum(s) * (1.0f / DM) + EPS);
        h16* orow = H + (size_t)row * DM;
#pragma unroll
        for (int j = 0; j < 4; ++j) {
            const f32x4 y = w[j] * r * gv[j] * (c[j] + 1.0f) + hh[j];
            u32x2 o; o.x = pkh(y.x, y.y); o.y = pkh(y.z, y.w);
            *(u32x2*)(orow + 4 * (lane + 64 * j)) = o;
        }
        st ^= 1;
    }
#undef NR_LD
}
DI void convert_rest(const Params& p, int l, LAS unsigned char* lds, int bix, int nblk, int tid) {
    const int lane = tid & 63, wave = tid >> 6;
    LAS float* scr = (LAS float*)(lds + wave * 8704);
    __syncthreads();
    h16* W = (h16*)(p.ws + OFF_W);
    const int gw = bix * 8 + wave, NGW = nblk * 8;
    constexpr int I2 = 16 * 32, I3 = 16 * 96, I4 = 512, I5 = 512, I6 = 16 * 176, I7 = 44 * 32, ITOT = I2 + I3 + I4 + I5 + I6 + I7;
    const float* win = p.w_in + (size_t)l * DM * DIN;
    for (int it = gw; it < ITOT; it += NGW) {
        int r = it;
        if (r < I2) { transpose_item(win, 1024, DIN, 0, 1024, W + W_B, 0, scr, r, lane); continue; } r -= I2;
        if (r < I3) { transpose_item(win, 1024, DIN, 4096, 3072, W + W_B, 1024, scr, r, lane); continue; } r -= I3;
        if (r < I4) { transpose_item(p.w_r + (size_t)l * DM * DM, 1024, 1024, 0, 1024, W + W_R, 0, scr, r, lane); continue; } r -= I4;
        if (r < I5) { transpose_item(p.w_o + (size_t)l * DM * DM, 1024, 1024, 0, 1024, W + W_O, 0, scr, r, lane); continue; } r -= I5;
        if (r < I6) { const int job = r >> 6, pn_ = job >> 1, bj_ = job & 1;
            transpose_item(p.w_up + (size_t)l * DM * 2 * DFF, 1024, 2 * DFF, bj_ * DFF + pn_ * 128, 128, W + W_UP, pn_ * 256 + bj_ * 128, scr, r & 63, lane); continue; } r -= I6;
        transpose_item(p.w_dn + (size_t)l * DFF * DM, DFF, 1024, 0, 1024, W + W_DN, 0, scr, r, lane);
    }
}
DI void phase_p1(const Params& p, int l, LAS unsigned char* lds) {
    const int tid = ltid(), lane = tid & 63, wave = tid >> 6;
    LAS float* scr = (LAS float*)(lds + wave * 8704);
    h16* W = (h16*)(p.ws + OFF_W);
    const int gw = blockIdx.x * 8 + wave, NGW = gridDim.x * 8;
    const float* win = p.w_in + (size_t)l * DM * DIN;
    for (int it = gw; it < 16 * 96 + 512; it += NGW) {
        if (it < 16 * 96) transpose_item(win, 1024, DIN, 1024, 3072, W + W_QKV, 0, scr, it, lane);
        else transpose_item(p.w_f + (size_t)l * DM * DM, 1024, 1024, 0, 1024, W + W_FT, 0, scr, it - 16 * 96, lane);
    }
    const float* xs = (l == 0) ? p.x : p.out;
    const float* MOD = (const float*)(p.ws + OFF_MOD) + (size_t)l * 8 * 6144;
    h16* H = (h16*)(p.ws + OFF_H);
    norm_rows(xs, p.n1g + l * DM, MOD + 1024, MOD, H, gw, NGW, lane);
}
DI void phase_norm2(const Params& p, int l) {
    const int tid = ltid(), lane = tid & 63, wave = tid >> 6;
    const int gw = blockIdx.x * 8 + wave, NGW = gridDim.x * 8;
    const float* MOD = (const float*)(p.ws + OFF_MOD) + (size_t)l * 8 * 6144;
    h16* H = (h16*)(p.ws + OFF_H);
    norm_rows(p.out, p.n2g + l * DM, MOD + 4096, MOD + 3072, H, gw, NGW, lane);
}
DI void phase_final(const Params& p, LAS unsigned char* lds) {
    const int tid = ltid(), lane = tid & 63, wave = tid >> 6;
    const int gw = blockIdx.x * 8 + wave, NGW = gridDim.x * 8;
    for (int row = gw; row < MTOK; row += NGW) {
        float* xr = p.out + (size_t)row * DM;
        f32x4 v[4]; float s = 0.f;
#pragma unroll
        for (int j = 0; j < 4; ++j) { v[j] = *((const f32x4*)xr + lane + 64 * j); s += (v[j].x * v[j].x + v[j].y * v[j].y) + (v[j].z * v[j].z + v[j].w * v[j].w); }
        const float r = rsqrtf(wave_sum(s) * (1.0f / DM) + EPS);
#pragma unroll
        for (int j = 0; j < 4; ++j) { const f32x4 gv = *((const f32x4*)p.fin_g + lane + 64 * j); f32x4 o = v[j] * r * gv;
            if (TSEL != 0 && (row >> 3) == TBLK) { const float tus = (float)TWORDS(lds)[1] * 0.01f; const float enc = (TSEL == 99) ? 0.1f : 0.02f + 0.13f * fminf(tus / TMAX_US, 1.0f); o = o + enc; }
            *((f32x4*)xr + lane + 64 * j) = o; }
    }
}

DI void fft4(float& ar, float& ai, float& br, float& bi, float& cr, float& ci, float& dr, float& di) {
    const float t0r = ar + cr, t0i = ai + ci, t1r = ar - cr, t1i = ai - ci, t2r = br + dr, t2i = bi + di, t3r = br - dr, t3i = bi - di;
    ar = t0r + t2r; ai = t0i + t2i;
    br = t1r + t3i; bi = t1i - t3r;
    cr = t0r - t2r; ci = t0i - t2i;
    dr = t1r - t3i; di = t1i + t3r;
}
DI void fft16(float (&re)[16], float (&im)[16]) {
#pragma unroll
    for (int n2 = 0; n2 < 4; ++n2) fft4(re[n2], im[n2], re[4 + n2], im[4 + n2], re[8 + n2], im[8 + n2], re[12 + n2], im[12 + n2]);
    constexpr float C1 = 0.9238795325112867f, S1 = 0.3826834323650898f, C2 = 0.7071067811865476f;
#define TWM(idx, wr_, wi_) { const float xr = re[idx], xi = im[idx]; re[idx] = xr * (wr_) - xi * (wi_); im[idx] = xr * (wi_) + xi * (wr_); }
    TWM(5, C1, -S1) TWM(6, C2, -C2) TWM(7, S1, -C1)
    TWM(9, C2, -C2) TWM(10, 0.f, -1.f) TWM(11, -C2, -C2)
    TWM(13, S1, -C1) TWM(14, -C2, -C2) TWM(15, -C1, S1)
#undef TWM
#pragma unroll
    for (int k1 = 0; k1 < 4; ++k1) fft4(re[4 * k1], im[4 * k1], re[4 * k1 + 1], im[4 * k1 + 1], re[4 * k1 + 2], im[4 * k1 + 2], re[4 * k1 + 3], im[4 * k1 + 3]);
}
DI int fsw(int idx) { return idx ^ ((idx >> 4) & 15); }
template <bool TW> DI void fft_stage(LAS unsigned* X, int rb, int rs, const float (&twr)[16], const float (&twi)[16]) {
    float re[16], im[16];
#pragma unroll
    for (int n = 0; n < 16; ++n) { const f32x2 v = unpkh(X[fsw(rb + rs * n)]); re[n] = v.x; im[n] = v.y; }
    fft16(re, im);
#pragma unroll
    for (int k = 0; k < 16; ++k) {
        const int idx = 4 * (k & 3) + (k >> 2);
        float orr, oi;
        if (TW) { orr = re[idx] * twr[k] - im[idx] * twi[k]; oi = re[idx] * twi[k] + im[idx] * twr[k]; }
        else { orr = re[idx] * 0.25f; oi = im[idx] * 0.25f; }
        X[fsw(rb + rs * k)] = pkh(orr, oi);
    }
}
DI void phase_fft(const Params& p, LAS unsigned char* lds) {
    const int tid = ltid(), t = tid & 255, hs = tid >> 8;
    LAS unsigned* X = (LAS unsigned*)lds;
    const h16* UF = (const h16*)(p.ws + OFF_RC);
    h16* PQ = (h16*)(p.ws + OFF_RD);
    float twAr[16], twAi[16], twBr[16], twBi[16];
#pragma unroll
    for (int k = 0; k < 16; ++k) {
        const float fa = (float)(t * k) * (1.0f / 4096.0f), fb = (float)((t & 15) * k) * (1.0f / 256.0f);
        twAr[k] = 0.25f * __builtin_amdgcn_cosf(fa); twAi[k] = -0.25f * __builtin_amdgcn_sinf(fa);
        twBr[k] = 0.25f * __builtin_amdgcn_cosf(fb); twBi[k] = -0.25f * __builtin_amdgcn_sinf(fb);
    }
    for (int it = blockIdx.x; it < 512; it += gridDim.x) {
        const int b = it >> 6, cb = it & 63;
        {
            const h16* ub = UF + ((size_t)(b * 64 + cb) * SEQ) * 16;
#pragma unroll 1
            for (int kb = 0; kb < 16; kb += 8) {
                u32x4 lv[8];
#pragma unroll
                for (int k = 0; k < 8; ++k) lv[k] = *(const u32x4*)(ub + (size_t)(tid + 512 * (kb + k)) * 8);
#pragma unroll
                for (int k = 0; k < 8; ++k) {
                    const int i = tid + 512 * (kb + k), s = i >> 1, hf = i & 1, ss_ = fsw(s);
                    X[(4 * hf + 0) * 4096 + ss_] = lv[k].x; X[(4 * hf + 1) * 4096 + ss_] = lv[k].y; X[(4 * hf + 2) * 4096 + ss_] = lv[k].z; X[(4 * hf + 3) * 4096 + ss_] = lv[k].w;
                }
            }
        }
        __syncthreads();
#pragma unroll 1
        for (int r = 0; r < 4; ++r) fft_stage<true>(X + (2 * r + hs) * 4096, t, 256, twAr, twAi);
        __syncthreads();
#pragma unroll 1
        for (int r = 0; r < 4; ++r) fft_stage<true>(X + (2 * r + hs) * 4096, 256 * (t >> 4) + (t & 15), 16, twBr, twBi);
        __syncthreads();
#pragma unroll 1
        for (int r = 0; r < 4; ++r) fft_stage<false>(X + (2 * r + hs) * 4096, 16 * t, 1, twBr, twBi);
        __syncthreads();
        for (int i = tid; i < 16384; i += NTHR) {
            const int q = i & 3, idx = i >> 2;
            const int kf = (idx >> 8) + 16 * ((idx >> 4) & 15) + 256 * (idx & 15);
            const int km = (4096 - kf) & 4095;
            const int idm = 256 * (km & 15) + 16 * ((km >> 4) & 15) + (km >> 8);
            const int part = q >> 1, sg0 = (q & 1) * 4;
            unsigned o[4];
#pragma unroll
            for (int j = 0; j < 4; ++j) {
                const f32x2 z = unpkh(X[(sg0 + j) * 4096 + fsw(idx)]), zm = unpkh(X[(sg0 + j) * 4096 + fsw(idm)]);
                o[j] = part == 0 ? pkh(0.5f * (z.x + zm.x), 0.5f * (z.y + zm.y)) : pkh(0.5f * (z.y - zm.y), -0.5f * (z.x - zm.x));
            }
            u32x4 ov = {o[0], o[1], o[2], o[3]};
            *(u32x4*)(PQ + ((size_t)(b * SEQ + kf)) * 2048 + cb * 32 + q * 8) = ov;
        }
        __syncthreads();
    }
}

#define MFMA16(a, b, c) __builtin_amdgcn_mfma_f32_16x16x32_f16((a), (b), (c), 0, 0, 0)
DI h16x8 cat4(h16x4 a, h16x4 b) { return __builtin_shufflevector(a, b, 0, 1, 2, 3, 4, 5, 6, 7); }
DI h16x8 packf8(const f32x4& a, const f32x4& b) { const u32x4 w = pack8(a, b); return __builtin_bit_cast(h16x8, w); }
#define TR8I(o, base, O0, O1, O2, O3, O4, O5, O6, O7) \
    asm volatile("ds_read_b64_tr_b16 %0, %8 offset:%9\n\tds_read_b64_tr_b16 %1, %8 offset:%10\n\tds_read_b64_tr_b16 %2, %8 offset:%11\n\tds_read_b64_tr_b16 %3, %8 offset:%12\n\t" \
                 "ds_read_b64_tr_b16 %4, %8 offset:%13\n\tds_read_b64_tr_b16 %5, %8 offset:%14\n\tds_read_b64_tr_b16 %6, %8 offset:%15\n\tds_read_b64_tr_b16 %7, %8 offset:%16" \
                 : "=&v"(o[0]), "=&v"(o[1]), "=&v"(o[2]), "=&v"(o[3]), "=&v"(o[4]), "=&v"(o[5]), "=&v"(o[6]), "=&v"(o[7]) \
                 : "v"(base), "i"(O0), "i"(O1), "i"(O2), "i"(O3), "i"(O4), "i"(O5), "i"(O6), "i"(O7) : "memory")
#define TRWAIT(n, o) asm volatile("s_waitcnt lgkmcnt(" #n ")" : "+v"(o[0]), "+v"(o[1]), "+v"(o[2]), "+v"(o[3]), "+v"(o[4]), "+v"(o[5]), "+v"(o[6]), "+v"(o[7]) :: "memory")

constexpr int SC_OFF = 128 * 544 + 128 * 288 + 1024, SC_STRIDE = 272;
constexpr int SQ_STRIDE = 544, SQQ_STRIDE = 528, SV_STRIDE = 288, SQ_BYTES = 128 * SQ_STRIDE, SV_BYTES = 128 * SV_STRIDE;

#define SBAR() do { asm volatile("s_waitcnt lgkmcnt(0)" ::: "memory"); __builtin_amdgcn_s_barrier(); asm volatile("" ::: "memory"); } while (0)
DI void scan_item(const Params& p, LAS unsigned char* lds, int it, int tid) {
    const int lane = tid & 63, w = __builtin_amdgcn_readfirstlane(tid >> 6), li = lane & 15, g = lane >> 4;
    const h16* Qb = (const h16*)(p.ws + OFF_RA); const h16* Kb = (const h16*)(p.ws + OFF_RB); const h16* Vb = (const h16*)(p.ws + OFF_RC);
    h16* CR = (h16*)(p.ws + OFF_RD);
    const unsigned lbase = (unsigned)(uintptr_t)lds;
    const int b = it >> 4, h = (it >> 2) & 3, dir = (it >> 1) & 1, dvh = it & 1;
    const float lg = dir ? p.lgb[h] : p.lgf[h];
    __syncthreads();
    if (w >= 4) {
        int st = tid - 256; asm volatile("" : "+v"(st));
        u32x4 rqq[16], rqk[16], rv[8];
        const unsigned bigoff = (unsigned)((st >> 5) * DM + (st & 31) * 8), voff = (unsigned)((st >> 4) * DM + (st & 15) * 8);
        LAS unsigned char* const wbig = lds + (st >> 5) * SQ_STRIDE + (st & 31) * 16;
        LAS unsigned char* const wbigq = lds + (st >> 5) * SQQ_STRIDE + (st & 31) * 16;
        LAS unsigned char* const wv = lds + SQ_BYTES + (st >> 4) * SV_STRIDE + (st & 15) * 16;
#define S2_LOADBIG(R, SRC, c_) do { const h16* s_ = (SRC) + ((size_t)b * SEQ + 128 * (c_)) * DM + h * 256; \
        _Pragma("unroll") for (int k_ = 0; k_ < 16; ++k_) R[k_] = *(const u32x4*)(s_ + (size_t)k_ * 8 * DM + bigoff); } while (0)
#define S2_LOADV(c_) do { const h16* s_ = Vb + ((size_t)b * SEQ + 128 * (c_)) * DM + h * 256 + dvh * 128; \
        _Pragma("unroll") for (int k_ = 0; k_ < 8; ++k_) rv[k_] = *(const u32x4*)(s_ + (size_t)k_ * 16 * DM + voff); } while (0)
        S2_LOADBIG(rqq, Qb, dir ? 31 : 0); S2_LOADV(dir ? 31 : 0); S2_LOADBIG(rqk, Kb, dir ? 31 : 0);
        {
            LAS float* dtab = (LAS float*)(lds + SQ_BYTES + SV_BYTES);
            const int j = st & 127;
            dtab[st] = st < 128 ? exp2f(lg * (dir ? (float)(128 - j) : (float)(j + 1))) : exp2f(lg * (dir ? (float)j : (float)(127 - j)));
        }
#pragma unroll 1
        for (int i = 0; i < 32; ++i) {
            const int cn = dir ? 30 - i : i + 1;
#pragma unroll
            for (int k_ = 0; k_ < 16; ++k_) *(LAS u32x4*)(wbigq + k_ * 8 * SQQ_STRIDE) = rqq[k_];
#pragma unroll
            for (int k_ = 0; k_ < 8; ++k_) *(LAS u32x4*)(wv + k_ * 16 * SV_STRIDE) = rv[k_];
            SBAR();
            if (i + 1 < 32) { S2_LOADBIG(rqq, Qb, cn); S2_LOADV(cn); }
            SBAR();
#pragma unroll
            for (int k_ = 0; k_ < 16; ++k_) *(LAS u32x4*)(wbig + k_ * 8 * SQ_STRIDE) = rqk[k_];
            SBAR();
            if (i + 1 < 32) S2_LOADBIG(rqk, Kb, cn);
            {
                const int c = dir ? 31 - i : i;
                h16* crc = CR + (size_t)dir * MTOK * DM + ((size_t)b * SEQ + 128 * c) * DM + h * 256 + dvh * 128;
#pragma unroll
                for (int k_ = 0; k_ < 8; ++k_) { const int pc_ = st + 256 * k_; const u32x4 v_ = *(const LAS u32x4*)(lds + SC_OFF + (pc_ >> 4) * SC_STRIDE + (pc_ & 15) * 16);
                    *(u32x4*)(crc + (size_t)(pc_ >> 4) * DM + (pc_ & 15) * 8) = v_; }
            }
            SBAR();
        }
#undef S2_LOADBIG
#undef S2_LOADV
    } else {
        const float g128 = exp2f(lg * 128.0f);
        f32x4 F[2][16];
#pragma unroll
        for (int nf = 0; nf < 2; ++nf)
#pragma unroll
            for (int i = 0; i < 16; ++i) F[nf][i] = (f32x4){0.f, 0.f, 0.f, 0.f};
#pragma unroll 1
        for (int i = 0; i < 32; ++i) {
            const int c = dir ? 31 - i : i;
            float lgl = lg; int lil = li, gl = g; asm volatile("" : "+v"(lgl), "+v"(lil), "+v"(gl));
            TBEG(4, lds); SBAR(); TEND(4, lds);
            TBEG(2, lds);
#ifndef QREP
#define QREP 1
#endif
#pragma unroll 1
            for (int rr_ = 0; rr_ < QREP; ++rr_) {
                const LAS unsigned char* qr = lds + lil * SQQ_STRIDE + 8 * gl;
#pragma unroll
                for (int hm = 0; hm < 4; ++hm) {
                    f32x4 d[2][2];
#pragma unroll
                    for (int nf = 0; nf < 2; ++nf)
#pragma unroll
                        for (int mf = 0; mf < 2; ++mf) d[nf][mf] = (f32x4){0.f, 0.f, 0.f, 0.f};
#pragma unroll
                    for (int ks = 0; ks < 8; ++ks) {
                        const h16x8 ff0 = packf8(F[0][2 * ks], F[0][2 * ks + 1]), ff1 = packf8(F[1][2 * ks], F[1][2 * ks + 1]);
                        h16x4 q0[2], q1[2];
#pragma unroll
                        for (int mf = 0; mf < 2; ++mf) { q0[mf] = *(const LAS h16x4*)(qr + 16 * (2 * hm + mf) * SQQ_STRIDE + 64 * ks); q1[mf] = *(const LAS h16x4*)(qr + 16 * (2 * hm + mf) * SQQ_STRIDE + 64 * ks + 32); }
#pragma unroll
                        for (int mf = 0; mf < 2; ++mf) { const h16x8 qv = cat4(q0[mf], q1[mf]); d[0][mf] = MFMA16(ff0, qv, d[0][mf]); d[1][mf] = MFMA16(ff1, qv, d[1][mf]); }
                        if ((ks & 3) == 3) __builtin_amdgcn_sched_barrier(0);
                    }
#pragma unroll
                    for (int mf = 0; mf < 2; ++mf) {
                        const int j = 16 * (2 * hm + mf) + lil;
                        const float a = ((const LAS float*)(lds + SQ_BYTES + SV_BYTES))[j];
#pragma unroll
                        for (int nf = 0; nf < 2; ++nf) {
                            u32x2 o; o.x = pkh(d[nf][mf][0] * a, d[nf][mf][1] * a); o.y = pkh(d[nf][mf][2] * a, d[nf][mf][3] * a);
                            *(LAS u32x2*)(lds + SC_OFF + j * SC_STRIDE + (32 * w + 16 * nf + 4 * gl) * 2) = o;
                        }
                    }
                    __builtin_amdgcn_sched_barrier(0);
                }
            }
            TEND(2, lds);
            TBEG(5, lds); SBAR();
            SBAR(); TEND(5, lds);
            TBEG(3, lds);
            {
#pragma unroll
                for (int nf = 0; nf < 2; ++nf)
#pragma unroll
                    for (int fm = 0; fm < 16; ++fm) F[nf][fm] *= g128;
                const unsigned kb = lbase + (4 * gl + (lil >> 2)) * SQ_STRIDE + (lil & 3) * 8;
                const unsigned vb = lbase + SQ_BYTES + (4 * gl + (lil >> 2)) * SV_STRIDE + (32 * w + (lil & 3) * 4) * 2;
#define S2_KOFF(ks2, f4, q, hi) ((ks2) * 32 * SQ_STRIDE + (4 * (f4) + (q)) * 32 + (hi) * 16 * SQ_STRIDE)
#define S2_ISSUE(buf, ks2, f4) TR8I(buf, kb, S2_KOFF(ks2, f4, 0, 0), S2_KOFF(ks2, f4, 0, 1), S2_KOFF(ks2, f4, 1, 0), S2_KOFF(ks2, f4, 1, 1), S2_KOFF(ks2, f4, 2, 0), S2_KOFF(ks2, f4, 2, 1), S2_KOFF(ks2, f4, 3, 0), S2_KOFF(ks2, f4, 3, 1))
#define S2_MMA(buf, f4) do { _Pragma("unroll") for (int q_ = 0; q_ < 4; ++q_) { const h16x8 kf_ = cat4(buf[2 * q_], buf[2 * q_ + 1]); \
                F[0][4 * (f4) + q_] = MFMA16(kf_, vf0, F[0][4 * (f4) + q_]); F[1][4 * (f4) + q_] = MFMA16(kf_, vf1, F[1][4 * (f4) + q_]); } } while (0)
#pragma unroll
                for (int ks2 = 0; ks2 < 4; ++ks2) {
                    h16x4 kA[8], kB[8];
                    h16x8 vf0, vf1;
                    const LAS float* bt_ = (const LAS float*)(lds + SQ_BYTES + SV_BYTES) + 128 + 32 * ks2 + 4 * gl;
                    const f32x4 b0_ = *(const LAS f32x4*)bt_, b1_ = *(const LAS f32x4*)(bt_ + 16);
                    asm volatile("s_waitcnt lgkmcnt(0)" ::: "memory");
                    {
                        h16x4 vt[8];
                        TR8I(vt, vb, ks2 * 32 * SV_STRIDE, ks2 * 32 * SV_STRIDE + 16 * SV_STRIDE, ks2 * 32 * SV_STRIDE + 32, ks2 * 32 * SV_STRIDE + 16 * SV_STRIDE + 32,
                                     ks2 * 32 * SV_STRIDE, ks2 * 32 * SV_STRIDE + 16 * SV_STRIDE, ks2 * 32 * SV_STRIDE + 32, ks2 * 32 * SV_STRIDE + 16 * SV_STRIDE + 32);
                        S2_ISSUE(kA, ks2, 0);
                        TRWAIT(8, vt);
                        vf0 = cat4(vt[0], vt[1]); vf1 = cat4(vt[2], vt[3]);
#pragma unroll
                        for (int e = 0; e < 8; ++e) {
                            const float bj = e < 4 ? b0_[e & 3] : b1_[e & 3];
                            vf0[e] = (h16)((float)vf0[e] * bj); vf1[e] = (h16)((float)vf1[e] * bj);
                        }
                    }
                    S2_ISSUE(kB, ks2, 1); TRWAIT(8, kA); S2_MMA(kA, 0);
                    S2_ISSUE(kA, ks2, 2); TRWAIT(8, kB); S2_MMA(kB, 1);
                    S2_ISSUE(kB, ks2, 3); TRWAIT(8, kA); S2_MMA(kA, 2);
                    TRWAIT(0, kB); S2_MMA(kB, 3);
                    __builtin_amdgcn_sched_barrier(0);
                }
#undef S2_KOFF
#undef S2_ISSUE
#undef S2_MMA
            }
            TEND(3, lds);
            TBEG(6, lds); SBAR(); TEND(6, lds);
        }
    }
    __syncthreads();
}

constexpr int CH_K_STRIDE = 528, CH_V_STRIDE = 544, CH_K_BYTES = 128 * CH_K_STRIDE;
DI void intra_item(const Params& p, LAS unsigned char* lds, int it, int tid) {
    const int lane = tid & 63, w = tid >> 6, li = lane & 15, g = lane >> 4;
    const h16* Qb = (const h16*)(p.ws + OFF_RA); const h16* Kb = (const h16*)(p.ws + OFF_RB); const h16* Vb = (const h16*)(p.ws + OFF_RC);
    h16* YR = (h16*)(p.ws + OFF_RE);
    const unsigned lbase = (unsigned)(uintptr_t)lds;
    const int b = it >> 7, h = (it >> 5) & 3, c = it & 31;
    const size_t row0 = (size_t)b * SEQ + 128 * c;
    const float lgf = p.lgf[h], lgb = p.lgb[h];
    __syncthreads();
    {
        const h16* ks = Kb + row0 * DM + h * 256; const h16* vs = Vb + row0 * DM + h * 256;
        u32x4 r[8];
#pragma unroll
        for (int k = 0; k < 8; ++k) { const int pc = tid + 512 * k; r[k] = *(const u32x4*)(ks + (size_t)(pc >> 5) * DM + (pc & 31) * 8); }
#pragma unroll
        for (int k = 0; k < 8; ++k) { const int pc = tid + 512 * k; *(LAS u32x4*)(lds + (pc >> 5) * CH_K_STRIDE + (pc & 31) * 16) = r[k]; }
#pragma unroll
        for (int k = 0; k < 8; ++k) { const int pc = tid + 512 * k; r[k] = *(const u32x4*)(vs + (size_t)(pc >> 5) * DM + (pc & 31) * 8); }
#pragma unroll
        for (int k = 0; k < 8; ++k) { const int pc = tid + 512 * k; *(LAS u32x4*)(lds + CH_K_BYTES + (pc >> 5) * CH_V_STRIDE + (pc & 31) * 16) = r[k]; }
    }
    const int jabs = 16 * w + li;
    const size_t prow = row0 + jabs;
    h16x8 qf[8];
#pragma unroll
    for (int ks = 0; ks < 8; ++ks) qf[ks] = *(const h16x8*)(Qb + prow * DM + h * 256 + 32 * ks + 8 * g);
    __syncthreads();
    h16x8 pf[4];
#pragma unroll
    for (int mf2 = 0; mf2 < 4; ++mf2) {
        f32x4 s2[2];
#pragma unroll
        for (int hh = 0; hh < 2; ++hh) {
            const int mf = 2 * mf2 + hh;
            f32x4 s = (f32x4){0.f, 0.f, 0.f, 0.f};
            const LAS unsigned char* kr = lds + (16 * mf + li) * CH_K_STRIDE + 16 * g;
#pragma unroll
            for (int ks = 0; ks < 8; ++ks) s = MFMA16(*(const LAS h16x8*)(kr + 64 * ks), qf[ks], s);
#pragma unroll
            for (int r = 0; r < 4; ++r) {
                const int m = 16 * mf + 4 * g + r, df = jabs - m;
                const float dec = df >= 0 ? exp2f(lgf * (float)df) : exp2f(lgb * (float)(-df));
                s[r] *= dec;
            }
            s2[hh] = s;
        }
        pf[mf2] = packf8(s2[0], s2[1]);
    }
    const unsigned vb = lbase + CH_K_BYTES + (4 * g + (li >> 2)) * CH_V_STRIDE + (li & 3) * 8;
    h16* yo = YR + prow * DM + h * 256 + 4 * g;
#define IN_ISSUE(buf, df) TR8I(buf, vb, (df) * 32 + 0 * 32 * CH_V_STRIDE, (df) * 32 + 0 * 32 * CH_V_STRIDE + 16 * CH_V_STRIDE, (df) * 32 + 1 * 32 * CH_V_STRIDE, (df) * 32 + 1 * 32 * CH_V_STRIDE + 16 * CH_V_STRIDE, \
                                       (df) * 32 + 2 * 32 * CH_V_STRIDE, (df) * 32 + 2 * 32 * CH_V_STRIDE + 16 * CH_V_STRIDE, (df) * 32 + 3 * 32 * CH_V_STRIDE, (df) * 32 + 3 * 32 * CH_V_STRIDE + 16 * CH_V_STRIDE)
#define IN_MMA(buf, df) do { f32x4 o_ = (f32x4){0.f, 0.f, 0.f, 0.f}; _Pragma("unroll") for (int ks_ = 0; ks_ < 4; ++ks_) o_ = MFMA16(cat4(buf[2 * ks_], buf[2 * ks_ + 1]), pf[ks_], o_); \
        u32x2 ov_; ov_.x = pkh(o_[0], o_[1]); ov_.y = pkh(o_[2], o_[3]); *(u32x2*)(yo + 16 * (df)) = ov_; } while (0)
    h16x4 vA[8], vB[8];
    IN_ISSUE(vA, 0);
#pragma unroll
    for (int df = 0; df < 16; df += 2) {
        IN_ISSUE(vB, df + 1);
        TRWAIT(8, vA);
        IN_MMA(vA, df);
        if (df + 2 < 16) { IN_ISSUE(vA, df + 2); TRWAIT(8, vB); } else { TRWAIT(0, vB); }
        IN_MMA(vB, df + 1);
    }
#undef IN_ISSUE
#undef IN_MMA
}

DI void phase_mix(const Params& p, int l, LAS unsigned char* lds) {
    const int tid = ltid();
    const int nb = (int)gridDim.x, bid = (int)blockIdx.x;
    const bool std = nb == 256;
#ifndef MIXPART
#define MIXPART 7
#endif
#ifndef SCANREP
#define SCANREP 1
#endif
#ifndef INTRAREP
#define INTRAREP 1
#endif
    if (MIXPART & 1) for (int r_ = 0; r_ < SCANREP; ++r_) for (int it = bid; it < 128; it += nb) { TBEG(1, lds); scan_item(p, lds, it, tid); TEND(1, lds); }
    TBEG(8, lds);
    if ((MIXPART & 2) && (!std || bid >= 128)) {
        convert_rest(p, l, lds, std ? bid - 128 : bid, std ? 128 : nb, tid);
        __syncthreads();
        h16* W = (h16*)(p.ws + OFF_W);
        pg8::Gemm gg; gg.A = W + W_FT; gg.Bt = W + W_DF; gg.M = 1024; gg.N = 2048; gg.K = 1024; gg.a_rows = 256;
        pg8::StaticOrder S; S.init(1024, 2048, std ? 128 : nb, std ? bid - 128 : bid);
        EpiStore E; E.O = W + W_F2; E.ldc = 2048;
        pg8::gemm_phase<EpiStore, pg8::StaticOrder, false>(lds, gg, S, E, nullptr);
    }
    TEND(8, lds);
    __syncthreads();
    int i0, cnt, stride;
    if (std) { if (bid < 128) { i0 = 0; cnt = 0; } else { i0 = (bid - 128) * 8; cnt = 8; } stride = 1; }
    else { i0 = bid; cnt = (1024 - bid + nb - 1) / nb; stride = nb; }
    TBEG(7, lds);
    if (MIXPART & 4) for (int r_ = 0; r_ < INTRAREP; ++r_) for (int k = 0; k < cnt; ++k) intra_item(p, lds, i0 + k * stride, tid);
    TEND(7, lds);
}

DI void phase_partB(const Params& p) {
    const int tid = ltid(), lane = tid & 63, wave = tid >> 6;
    const int gw = blockIdx.x * 8 + wave, NGW = gridDim.x * 8;
    h16* YR = (h16*)(p.ws + OFF_RE); const h16* CR = (const h16*)(p.ws + OFF_RD);
    u32x4 ld[2][6];
#define PB_LD(row_, st_) do { const size_t o_ = (size_t)(row_) * DM + lane * 16; ld[st_][0] = *(const u32x4*)(YR + o_); ld[st_][1] = *(const u32x4*)(YR + o_ + 8); ld[st_][2] = *(const u32x4*)(CR + o_); ld[st_][3] = *(const u32x4*)(CR + o_ + 8); \
        ld[st_][4] = *(const u32x4*)(CR + (size_t)MTOK * DM + o_); ld[st_][5] = *(const u32x4*)(CR + (size_t)MTOK * DM + o_ + 8); } while (0)
    if (gw < MTOK) PB_LD(gw, 0);
    int st = 0;
    for (int row = gw; row < MTOK; row += NGW) {
        if (row + NGW < MTOK) { if (st == 0) PB_LD(row + NGW, 1); else PB_LD(row + NGW, 0); }
        const size_t o = (size_t)row * DM + lane * 16;
        float v[16];
#pragma unroll
        for (int hh = 0; hh < 2; ++hh) {
            const u32x4 a = st ? ld[1][hh] : ld[0][hh], c0 = st ? ld[1][2 + hh] : ld[0][2 + hh], c1 = st ? ld[1][4 + hh] : ld[0][4 + hh];
#pragma unroll
            for (int e = 0; e < 4; ++e) { const f32x2 x = unpkh(a[e]), y = unpkh(c0[e]), z = unpkh(c1[e]); v[8 * hh + 2 * e] = x.x + y.x + z.x; v[8 * hh + 2 * e + 1] = x.y + y.y + z.y; }
        }
        st ^= 1;
        float s = 0.f;
#pragma unroll
        for (int e = 0; e < 16; ++e) s += v[e];
        s += __shfl_xor(s, 1); s += __shfl_xor(s, 2); s += __shfl_xor(s, 4); s += __shfl_xor(s, 8);
        const float mu = s * (1.0f / 256.0f);
        float q2 = 0.f;
#pragma unroll
        for (int e = 0; e < 16; ++e) { v[e] -= mu; q2 += v[e] * v[e]; }
        q2 += __shfl_xor(q2, 1); q2 += __shfl_xor(q2, 2); q2 += __shfl_xor(q2, 4); q2 += __shfl_xor(q2, 8);
        const float rs = rsqrtf(q2 * (1.0f / 256.0f) + EPS);
#pragma unroll
        for (int hh = 0; hh < 2; ++hh) {
            u32x4 ov;
#pragma unroll
            for (int e = 0; e < 4; ++e) ov[e] = pkh(v[8 * hh + 2 * e] * rs, v[8 * hh + 2 * e + 1] * rs);
            *(u32x4*)(YR + o + 8 * hh) = ov;
        }
    }
}

DI h16x2 u2h(unsigned u) { return __builtin_bit_cast(h16x2, u); }
DI void phase_conv(const Params& p, int l, int half) {
    const h16* U = (const h16*)(p.ws + OFF_RA); h16* HID = (h16*)(p.ws + OFF_RD);
    const float* cw = p.conv_w + (size_t)l * 3 * 2 * DFF; const float* cbias = p.conv_b + (size_t)l * 2 * DFF;
    constexpr int RB = 8, NCG = DFF / 8, NU = (MTOK / 2 / RB) * NCG;
    const int tid = ltid();
    for (int un = blockIdx.x * NTHR + tid; un < NU; un += gridDim.x * NTHR) {
        const int rb = un / NCG, cg_ = un - rb * NCG, r0 = rb * RB, n0 = cg_ * 8;
        const int pos0 = r0 & (SEQ - 1);
        const h16* ur = U + (size_t)r0 * (2 * DFF) + n0;
        u32x4 ra[RB + 2], rbv[RB + 2];
        const bool okp = pos0 != 0, okn = (pos0 + RB) < SEQ;
#pragma unroll
        for (int r = 0; r < RB + 2; ++r) {
            const bool ok = (r == 0) ? okp : ((r == RB + 1) ? okn : true);
            ra[r] = (u32x4){0u, 0u, 0u, 0u}; rbv[r] = (u32x4){0u, 0u, 0u, 0u};
            if (ok) { ra[r] = *(const u32x4*)(ur + (ptrdiff_t)(r - 1) * (2 * DFF)); rbv[r] = *(const u32x4*)(ur + (ptrdiff_t)(r - 1) * (2 * DFF) + DFF); }
        }
        h16x2 wa[3][4], wb[3][4], ba[4], bb[4];
#pragma unroll
        for (int i = 0; i < 3; ++i)
#pragma unroll
            for (int e = 0; e < 2; ++e) {
                const f32x4 x = *(const f32x4*)(cw + i * 2 * DFF + n0 + 4 * e), y = *(const f32x4*)(cw + i * 2 * DFF + DFF + n0 + 4 * e);
                wa[i][2 * e] = (h16x2){(h16)x.x, (h16)x.y}; wa[i][2 * e + 1] = (h16x2){(h16)x.z, (h16)x.w};
                wb[i][2 * e] = (h16x2){(h16)y.x, (h16)y.y}; wb[i][2 * e + 1] = (h16x2){(h16)y.z, (h16)y.w};
            }
#pragma unroll
        for (int e = 0; e < 2; ++e) {
            const f32x4 x = *(const f32x4*)(cbias + n0 + 4 * e), y = *(const f32x4*)(cbias + DFF + n0 + 4 * e);
            ba[2 * e] = (h16x2){(h16)x.x, (h16)x.y}; ba[2 * e + 1] = (h16x2){(h16)x.z, (h16)x.w};
            bb[2 * e] = (h16x2){(h16)y.x, (h16)y.y}; bb[2 * e + 1] = (h16x2){(h16)y.z, (h16)y.w};
        }
#pragma unroll
        for (int r = 0; r < RB; ++r) {
            u32x4 ov;
#pragma unroll
            for (int e = 0; e < 4; ++e) {
                const h16x2 av = wa[0][e] * u2h(ra[r][e]) + (wa[1][e] * u2h(ra[r + 1][e]) + (wa[2][e] * u2h(ra[r + 2][e]) + ba[e]));
                const h16x2 bv = wb[0][e] * u2h(rbv[r][e]) + (wb[1][e] * u2h(rbv[r + 1][e]) + (wb[2][e] * u2h(rbv[r + 2][e]) + bb[e]));
                const f32x2 gl = gelu_pk((f32x2){(float)av.x, (float)av.y});
                ov[e] = pkh(gl.x * (float)bv.x, gl.y * (float)bv.y);
            }
            *(u32x4*)(HID + (size_t)(r0 + r) * DFF + n0) = ov;
        }
    }
}

template <class Epi> DI void run_gemm(LAS unsigned char* lds, const h16* A, const h16* Bt, int M, int N, int K, const Epi& E) {
    pg8::Gemm g; g.A = A; g.Bt = Bt; g.M = M; g.N = N; g.K = K; g.a_rows = 256;
    pg8::StaticOrder S; S.init(M, N, (int)gridDim.x, (int)blockIdx.x);
    pg8::gemm_phase<Epi, pg8::StaticOrder, false>(lds, g, S, E, nullptr);
}

DI void run_phase(const Params& p, int ph, LAS unsigned char* lds) {
    unsigned char* ws = p.ws;
    h16* W = (h16*)(ws + OFF_W); h16* H = (h16*)(ws + OFF_H);
    h16* RA = (h16*)(ws + OFF_RA); h16* RB = (h16*)(ws + OFF_RB); h16* RC = (h16*)(ws + OFF_RC); h16* RD = (h16*)(ws + OFF_RD); h16* RE = (h16*)(ws + OFF_RE);
#ifndef PHMASK
#define PHMASK 0xFFFFF
#endif
#define PHON(k) ((PHMASK >> (k)) & 1)
    if (ph == 0) { if (PHON(16)) phase_prep(p, lds); return; }
    if (ph == 1 + NST * NLAYER) { if (PHON(17)) phase_final(p, lds); return; }
    const int l = (ph - 1) / NST, st = (ph - 1) % NST;
    const float* MODl = (const float*)(ws + OFF_MOD) + (size_t)l * 8 * 6144;
    switch (st) {
    case 0: if (PHON(0)) phase_p1(p, l, lds); break;
    case 1: if (PHON(1)) { EpiQKV E; E.Q = RA; E.cosT = (const float*)(ws + OFF_COS); E.sinT = (const float*)(ws + OFF_SIN); run_gemm(lds, H, W + W_QKV, MTOK, 3072, 1024, E); } break;
    case 2: if (PHON(2)) phase_mix(p, l, lds); break;
    case 3: if (PHON(3)) phase_partB(p); break;
    case 4: if (PHON(4)) { EpiB E; E.ws = ws; run_gemm(lds, H, W + W_B, MTOK, 4096, 1024, E); } break;
    case 5: if (PHON(5)) phase_fft(p, lds); break;
    case 6: if (PHON(6)) {
        { EpiMerge<0> E; E.T = RC; E.G = RA; run_gemm(lds, RD, W + W_F2, MTOK, 1024, 2048, E); }
        asm volatile("s_waitcnt vmcnt(0)" ::: "memory"); __syncthreads();
        { EpiMerge<1> E; E.T = RC; E.G = RB; run_gemm(lds, RE, W + W_R, MTOK, 1024, 1024, E); } } break;
    case 7: if (PHON(8)) { EpiRes E; E.xi = (l == 0) ? p.x : p.out; E.xo = p.out; E.gate = MODl + 2048; E.rowoff = 0; run_gemm(lds, RC, W + W_O, MTOK, 1024, 1024, E); } break;
    case 8: if (PHON(9)) phase_norm2(p, l); break;
    case 9: if (PHON(10)) {
        EpiUpConv E; E.HID = RD; E.cw = p.conv_w + (size_t)l * 3 * 2 * DFF; E.cb = p.conv_b + (size_t)l * 2 * DFF; E.lds = lds;
        pg8::Gemm g; g.A = H - DM; g.Bt = W + W_UP; g.M = 130 * 256; g.N = 2 * DFF; g.K = 1024; g.a_rows = 254;
        pg8::StaticOrder S; S.init(130 * 256, 2 * DFF, (int)gridDim.x, (int)blockIdx.x);
        pg8::gemm_phase<EpiUpConv, pg8::StaticOrder, false>(lds, g, S, E, nullptr); } break;
    case 10: if (PHON(12)) { EpiRes E; E.xi = p.out; E.xo = p.out; E.gate = MODl + 5120; E.rowoff = 0; run_gemm(lds, RD, W + W_DN, MTOK, 1024, DFF, E); } break;
    }
}


#define XB_TMO      128
#define XB_XCNT(j)  (256  + 64 * (j))
#define XB_XSUB(j)  (1280 + 64 * (j))
#define XB_XGEN(j)  (2304 + 64 * (j))
#define XB_TOP      3328
#define XB_TOPGEN   3392
#define XCD_BAR_WORDS 3456
#define XB_SPIN_CAP (1u << 18)
DI unsigned xb_ld(unsigned* p)              { return __hip_atomic_load(p, __ATOMIC_RELAXED, __HIP_MEMORY_SCOPE_AGENT); }
DI unsigned xb_add(unsigned* p, unsigned v) { return __hip_atomic_fetch_add(p, v, __ATOMIC_RELAXED, __HIP_MEMORY_SCOPE_AGENT); }
DI unsigned xb_xcc_id() { return (unsigned)__builtin_amdgcn_s_getreg((3 << 11) | 20) & 0xFu; }
#define XB_SPIN(cond, bar) do { unsigned _sp = 0; while (cond) { __builtin_amdgcn_s_sleep(1); \
    if ((++_sp & 255u) == 0u) { if (xb_ld(&(bar)[XB_TMO])) break; if (_sp > XB_SPIN_CAP) { atomicAdd(&(bar)[XB_TMO], 1u); break; } } } } while (0)
DI void xcd_barrier_complete(unsigned* bar, unsigned x, unsigned& nloc, unsigned& nx) {
    const unsigned G = gridDim.x;
    unsigned sum, cnt, mine, sp = 0u;
    for (;;) {
        sum = 0u; cnt = 0u; mine = 0u;
#pragma unroll
        for (unsigned j = 0; j < 16; ++j) { const unsigned c = xb_ld(&bar[XB_XCNT(j)]); sum += c; cnt += (c > 0u) ? 1u : 0u; mine = (j == x) ? c : mine; }
        if (sum == G) break;
        __builtin_amdgcn_s_sleep(1);
        if ((++sp & 255u) == 0u) { if (xb_ld(&bar[XB_TMO])) break; if (sp > XB_SPIN_CAP) { atomicAdd(&bar[XB_TMO], 1u); break; } }
    }
    nloc = mine > 0u ? mine : 1u; nx = cnt > 0u ? cnt : 1u;
}
DI void xcd_barrier(unsigned* bar, unsigned x, volatile LAS unsigned* st) {
    asm volatile("s_waitcnt vmcnt(0)" ::: "memory");
    __syncthreads();
    if (threadIdx.x == 0) {
        __builtin_amdgcn_s_waitcnt(0);
        unsigned nloc = st[0], nx = st[1];
        if (nloc == 0u) { xcd_barrier_complete(bar, x, nloc, nx); st[0] = nloc; st[1] = nx; }
        const unsigned old = xb_add(&bar[XB_XSUB(x)], 1u);
        const unsigned gen = old / nloc;
        if (old + 1u == (gen + 1u) * nloc) {
            __builtin_amdgcn_fence(__ATOMIC_RELEASE, "agent");
            asm volatile("s_waitcnt vmcnt(0)" ::: "memory");
            const unsigned og = xb_add(&bar[XB_TOP], 1u);
            const unsigned tg = og / nx;
            if (og + 1u == (tg + 1u) * nx) xb_add(&bar[XB_TOPGEN], 1u);
            else XB_SPIN(xb_ld(&bar[XB_TOPGEN]) == tg, bar);
            __builtin_amdgcn_fence(__ATOMIC_ACQUIRE, "agent");
            xb_add(&bar[XB_XGEN(x)], 1u);
            asm volatile("s_waitcnt vmcnt(0)" ::: "memory");
        } else {
            XB_SPIN(xb_ld(&bar[XB_XGEN(x)]) == gen, bar);
            __builtin_amdgcn_fence(__ATOMIC_ACQUIRE, "agent");
            asm volatile("s_waitcnt vmcnt(0)" ::: "memory");
        }
    }
    __syncthreads();
}
#define LIGHT_BARRIER() do { \
                ++nbar; \
                asm volatile("s_waitcnt vmcnt(0)" ::: "memory");       \
                __syncthreads(); \
                if (threadIdx.x == 0) { \
                    __builtin_amdgcn_fence(__ATOMIC_RELEASE, "agent");   \
                    asm volatile("s_waitcnt vmcnt(0)" ::: "memory"); \
                    __hip_atomic_fetch_add(bar, 1u, __ATOMIC_RELAXED, __HIP_MEMORY_SCOPE_AGENT); \
                    const unsigned target = nbar * gridDim.x; \
                    const unsigned long long t0 = __builtin_amdgcn_s_memrealtime(); \
                    while (__hip_atomic_load(bar, __ATOMIC_RELAXED, __HIP_MEMORY_SCOPE_AGENT) < target) { \
                        __builtin_amdgcn_s_sleep(1); \
                        if (__builtin_amdgcn_s_memrealtime() - t0 > 20000000ull) break;      \
                    } \
                    __builtin_amdgcn_fence(__ATOMIC_ACQUIRE, "agent");   \
                    asm volatile("s_waitcnt vmcnt(0)" ::: "memory"); \
                } \
                __syncthreads(); \
             \
} while (0)
template <class T> DI T* launder(T* p) {
    unsigned lo = (unsigned)(uintptr_t)p, hi = (unsigned)((uintptr_t)p >> 32);
    asm volatile("" : "+v"(lo), "+v"(hi));
    lo = __builtin_amdgcn_readfirstlane(lo); hi = __builtin_amdgcn_readfirstlane(hi);
    return (T*)(((uintptr_t)hi << 32) | (uintptr_t)lo);
}
__global__ void __launch_bounds__(512, 2) fwd_megakernel(Params p) {
    extern __shared__ __attribute__((aligned(16))) unsigned char smem[];
    LAS unsigned char* lds = (LAS unsigned char*)smem;
    cg::grid_group grid = cg::this_grid();
    if (TSEL != 0 && threadIdx.x == 0) { TWORDS(lds)[0] = 0ull; TWORDS(lds)[1] = 0ull; }
    volatile LAS unsigned* xst = (volatile LAS unsigned*)(lds + 163840 - 64);
    const unsigned xcc = xb_xcc_id();
    if (threadIdx.x == 0) { xst[0] = 0u; xst[1] = 0u; (void)xb_add(&((unsigned*)(p.ws + OFF_BAR))[XB_XCNT(xcc)], 1u); }
    __syncthreads();
#ifndef REPMASK
#define REPMASK 0
#endif
    int rep = 0; unsigned nbar = 0;
    unsigned* bar = (unsigned*)(p.ws + OFF_BAR);
    for (int ph = p.ph0; ph < p.ph1;) {
        run_phase(p, ph, lds);
        const bool again = REPMASK != 0 && rep == 0 && ph >= 1 && ph < 1 + NST * NLAYER && ((REPMASK >> ((ph - 1) % NST)) & 1);
        if (again) rep = 1; else { rep = 0; ++ph; }
        if (ph < p.ph1) {
            if (ph == 1 && rep == 0) grid.sync();
            else {
                xcd_barrier(bar, xcc, xst);
            }
#ifdef EXTRASYNC
            LIGHT_BARRIER(); LIGHT_BARRIER();
#endif
        }
    }
}

extern "C" void kernel_launch(void* const* d_in, const int* in_sizes, int n_in, void* d_out, int out_size, void* d_ws, size_t ws_size, hipStream_t stream) {
    static int grid = 0;
    if (grid == 0) {
        int dev = 0, cus = 0, per_cu = 0;
        hipGetDevice(&dev);
        hipDeviceGetAttribute(&cus, hipDeviceAttributeMultiprocessorCount, dev);
        if (hipFuncSetAttribute((const void*)fwd_megakernel, hipFuncAttributeMaxDynamicSharedMemorySize, LDS_BYTES) != hipSuccess) fprintf(stderr, "kernel_launch: hipFuncSetAttribute failed\n");
        hipOccupancyMaxActiveBlocksPerMultiprocessor(&per_cu, (const void*)fwd_megakernel, NTHR, LDS_BYTES);
        if (per_cu < 1) { fprintf(stderr, "kernel_launch: occupancy query says %d blocks per CU\n", per_cu); per_cu = 1; }
        (void)hipGetLastError();
        grid = cus * 1;
        if (ws_size < WS_END) fprintf(stderr, "kernel_launch: workspace too small: %zu < %zu\n", ws_size, (size_t)WS_END);
        fprintf(stderr, "kernel_launch: grid %d (cus %d, per_cu %d), ws %zu need %zu\n", grid, cus, per_cu, ws_size, (size_t)WS_END);
    }
    Params p{};
    const float* const* in = (const float* const*)d_in;
    p.x = in[0]; p.c = in[1]; p.n1g = in[2]; p.n2g = in[3]; p.ada_w = in[4]; p.ada_b = in[5]; p.w_in = in[6]; p.w_f = in[7]; p.w_r = in[8]; p.w_o = in[9];
    p.w_up = in[10]; p.conv_w = in[11]; p.conv_b = in[12]; p.w_dn = in[13]; p.fin_g = in[14];
    p.out = (float*)d_out; p.ws = (unsigned char*)d_ws;
    for (int h = 0; h < 4; ++h) {
        p.lgf[h] = (float)(std::log1p(-std::exp2(-5.0 - h)) / std::log(2.0));
        p.lgb[h] = (float)(std::log1p(-std::exp2(-5.5 - h)) / std::log(2.0));
    }
    constexpr int NPH = 2 + NST * NLAYER;
#if MULTI_LAUNCH
    for (int ph = 0; ph < NPH; ++ph) {
        p.ph0 = ph; p.ph1 = ph + 1;
        hipLaunchKernelGGL(fwd_megakernel, dim3(grid), dim3(NTHR), LDS_BYTES, stream, p);
    }
#else
    p.ph0 = 0; p.ph1 = NPH;
    (void)hipMemsetAsync((unsigned char*)d_ws + OFF_BAR, 0, 16384, stream);
    void* args[] = {&p};
    hipError_t e = hipLaunchCooperativeKernel((const void*)fwd_megakernel, dim3(grid), dim3(NTHR), args, LDS_BYTES, stream);
    if (e != hipSuccess) fprintf(stderr, "cooperative launch failed: %s (grid %d)\n", hipGetErrorString(e), grid);
#endif
}
```

```cpp
#include <hip/hip_runtime.h>
#include <hip/hip_cooperative_groups.h>
#include <cstdio>
#include <cstdint>
#include <cmath>
namespace cg = cooperative_groups;

#ifndef MULTI_LAUNCH
#define MULTI_LAUNCH 0
#endif

#define DI __device__ __forceinline__
#define LAS __attribute__((address_space(3)))
typedef _Float16 h16;
typedef h16 h16x2 __attribute__((ext_vector_type(2)));
typedef h16 h16x4 __attribute__((ext_vector_type(4)));
typedef h16 h16x8 __attribute__((ext_vector_type(8)));
typedef float f32x2 __attribute__((ext_vector_type(2)));
typedef float f32x4 __attribute__((ext_vector_type(4)));
typedef unsigned u32x2 __attribute__((ext_vector_type(2)));
typedef unsigned u32x4 __attribute__((ext_vector_type(4)));

constexpr int MTOK = 32768, DM = 1024, SEQ = 4096, NLAYER = 4, DFF = 2816, DIN = 7168;
constexpr float EPS = 1e-6f;

#ifndef TSEL
#define TSEL 0
#endif
#ifndef TBLK
#define TBLK 0
#endif
#ifndef TMAX_US
#define TMAX_US 2000.0f
#endif
#define TWORDS(lds_) ((LAS unsigned long long*)((lds_) + 163840 - 32))
#define TBEG(id, lds_) do { if (TSEL == (id) && blockIdx.x == TBLK && threadIdx.x == (TBLK >= 128 ? 0 : 0)) TWORDS(lds_)[0] = __builtin_amdgcn_s_memrealtime(); } while (0)
#define TEND(id, lds_) do { if (TSEL == (id) && blockIdx.x == TBLK && threadIdx.x == 0) TWORDS(lds_)[1] += __builtin_amdgcn_s_memrealtime() - TWORDS(lds_)[0]; } while (0)
DI int ltid() { int t = threadIdx.x; asm volatile("" : "+v"(t)); return t; }
DI unsigned pkh(float lo, float hi) { h16x2 v = {(h16)lo, (h16)hi}; return __builtin_bit_cast(unsigned, v); }
DI f32x2 unpkh(unsigned u) { h16x2 v = __builtin_bit_cast(h16x2, u); return (f32x2){(float)v.x, (float)v.y}; }
DI float wave_sum(float v) {
#pragma unroll
    for (int o = 1; o < 64; o <<= 1) v += __shfl_xor(v, o);
    return v;
}
DI float sigmoidf_(float x) { return 1.0f / (1.0f + __expf(-x)); }

namespace pg8 {
#define PG8_LAS __attribute__((address_space(3)))
typedef h16 bf16_t;
typedef h16x8 bf16x8;
constexpr int BM = 256, BK = 64, HALF = 128, HTB = HALF * BK * 2, STAGE_BYTES = 8 * HTB, NXCD = 8, WGM = 8;
__host__ __device__ __forceinline__ int lds_byte(int r, int c) { const int st = (r >> 4) * 2 + (c >> 5), rr = r & 15, cc = c & 31, ob = rr * 64 + cc * 2; return st * 1024 + (ob ^ (((ob >> 9) & 1) << 5)); }
__host__ __device__ __forceinline__ void stage_rc(int b, int& R, int& C) { const int st = b / 1024, sb = b % 1024, swz = sb ^ (((sb >> 9) & 1) << 5); R = (st >> 1) * 16 + swz / 64; C = (st & 1) * 32 + (swz % 64) / 2; }
__host__ __device__ __forceinline__ int perm32(int rho) { const int n = rho >> 4, i = rho & 15; return 8 * (i >> 2) + 4 * n + (i & 3); }
struct Unit { int pm, pn; };
struct Gemm { const bf16_t* A; const bf16_t* Bt; int M, N, K; int a_rows; };
struct StaticOrder {
    int nM, nN, nwg, G, c;
    __host__ __device__ void init(int M, int N, int G_, int c_) { nM = M / BM; nN = N / BM; nwg = nM * nN; G = G_; c = c_; }
    __host__ __device__ bool next(int i, Unit& u) const {
        const long L = (long)i * G + c; if (L >= nwg) return false;
        int wgid = (int)L; { const int q = nwg / NXCD, r = nwg % NXCD, xcd = wgid % NXCD, off = wgid / NXCD; wgid = (xcd < r ? xcd * (q + 1) : r * (q + 1) + (xcd - r) * q) + off; }
        const int nig = WGM * nN, gid = wgid / nig, fm = gid * WGM, gsz = (nM - fm) < WGM ? (nM - fm) : WGM;
        u.pm = fm + ((wgid % nig) % gsz); u.pn = (wgid % nig) / gsz; return true;
    }
    __device__ __forceinline__ void a_ready(const Unit&) const {}
    __device__ __forceinline__ void done(const Unit&) const {}
};
template <class Epi, class Sched, bool STAMP = false>
__device__ __forceinline__ void gemm_phase(PG8_LAS unsigned char* lds, const Gemm g, const Sched& S, const Epi& E, unsigned long long* stamps) {
    const int tid = ltid(), wid = __builtin_amdgcn_readfirstlane(tid >> 6), lane = tid & 63, wr = wid >> 2, wc = wid & 3, fr = lane & 15, fq = lane >> 4;
    const int K = g.K, nt = K / BK;
    int ts_lo = 0, ts_hi = 0, nts = 0; const unsigned long long rt_entry = STAMP ? (unsigned long long)wall_clock64() : 0ull;
#define PG8_STAMP() do { if (STAMP && wid == 0 && nts < 64) { const unsigned long long _c = (unsigned long long)clock64(); \
        ts_lo = (lane == nts) ? (int)(unsigned)_c : ts_lo; ts_hi = (lane == nts) ? (int)(unsigned)(_c >> 32) : ts_hi; ++nts; } } while (0)
    PG8_STAMP();
    unsigned voffA[2], voffB[2];
#pragma unroll
    for (int i = 0; i < 2; ++i) { int R, C; stage_rc(tid * 16 + i * 8192, R, C); const int Rb = Epi::PERM ? ((R & ~31) + perm32(R & 31)) : R;
        voffA[i] = (unsigned)(R * K + C) * 2u; voffB[i] = (unsigned)(Rb * K + C) * 2u; }
    const size_t kstep = (size_t)(BK * 2);
    const size_t hstep = (size_t)HALF * K * 2;
    const size_t tstep = 2 * hstep;
    const size_t tstepA = (size_t)g.a_rows * K * 2;
    const unsigned ldsw = (unsigned)wid * 1024u;
    const int aoff = lds_byte(wr * 64 + fr, fq * 8), boff = lds_byte(wc * 32 + fr, fq * 8);
#define PG8_SA(b, h) (((b) * 2 + (h)) * HTB)
#define PG8_SB(b, h) ((4 + (b) * 2 + (h)) * HTB)
#define PG8_STAGE(bufoff, gbase, voff) do { _Pragma("unroll") for (int _i = 0; _i < 2; ++_i) \
        __builtin_amdgcn_global_load_lds((const unsigned*)((const char*)(gbase) + (voff)[_i]), (PG8_LAS unsigned*)(lds + (bufoff) + ldsw + _i * 8192), 16, 0, 0); } while (0)
#define PG8_LDA(dst, b, h) do { _Pragma("unroll") for (int m = 0; m < 4; ++m) _Pragma("unroll") for (int k = 0; k < 2; ++k) dst[m][k] = *(const PG8_LAS bf16x8*)(lds + PG8_SA(b, h) + aoff + m * 2048 + k * 1024); } while (0)
#define PG8_LDB(dst, b, h) do { _Pragma("unroll") for (int n = 0; n < 2; ++n) _Pragma("unroll") for (int k = 0; k < 2; ++k) dst[n][k] = *(const PG8_LAS bf16x8*)(lds + PG8_SB(b, h) + boff + n * 2048 + k * 1024); } while (0)
#define PG8_MMA(ai, bj, At, Bt) do { __builtin_amdgcn_s_setprio(1); _Pragma("unroll") for (int m = 0; m < 4; ++m) _Pragma("unroll") for (int n = 0; n < 2; ++n) _Pragma("unroll") for (int k = 0; k < 2; ++k) \
        acc[ai][bj][m][n] = __builtin_amdgcn_mfma_f32_16x16x32_f16(Bt[n][k], At[m][k], acc[ai][bj][m][n], 0, 0, 0); __builtin_amdgcn_s_setprio(0); } while (0)
#define PG8_WAIT_V(n) asm volatile("s_waitcnt vmcnt(" #n ")" ::: "memory")
#define PG8_WAIT_L(n) asm volatile("s_waitcnt lgkmcnt(" #n ")" ::: "memory")
#define PG8_BAR __builtin_amdgcn_s_barrier()
#define PG8_SCHED __builtin_amdgcn_sched_barrier(0)
    Unit cur, nxt; int ui = 0;
    if (!S.next(0, cur)) return;
    f32x4 acc[2][2][4][2];
#pragma unroll
    for (int a = 0; a < 2; ++a)
#pragma unroll
        for (int b = 0; b < 2; ++b)
#pragma unroll
            for (int m = 0; m < 4; ++m)
#pragma unroll
                for (int n = 0; n < 2; ++n) acc[a][b][m][n] = (f32x4){0.f, 0.f, 0.f, 0.f};
    bf16x8 At[4][2], B0[2][2], B1[2][2];
    const char* cA = (const char*)g.A + (size_t)cur.pm * tstepA; const char* cB = (const char*)g.Bt + (size_t)cur.pn * tstep;
    S.a_ready(cur);
    PG8_STAGE(PG8_SB(0, 0), cB, voffB); PG8_STAGE(PG8_SA(0, 0), cA, voffA); PG8_STAGE(PG8_SB(0, 1), cB + hstep, voffB); PG8_STAGE(PG8_SA(0, 1), cA + hstep, voffA);
    if (wr == 1) PG8_BAR;
    PG8_WAIT_V(4); PG8_BAR;
    PG8_STAGE(PG8_SB(1, 0), cB + kstep, voffB); PG8_STAGE(PG8_SA(1, 0), cA + kstep, voffA); PG8_STAGE(PG8_SB(1, 1), cB + hstep + kstep, voffB);
    PG8_WAIT_V(6); PG8_BAR;
    PG8_STAMP();
    for (;;) {
        const bool has_next = S.next(ui + 1, nxt);
        const char* nA = has_next ? (const char*)g.A + (size_t)nxt.pm * tstepA : cA; const char* nB = has_next ? (const char*)g.Bt + (size_t)nxt.pn * tstep : cB;
        for (int t = 0; t < nt; t += 2) {
            const bool last = (t == nt - 2);
            const char* a1 = cA + (size_t)(t + 1) * kstep;
            const char* a2 = last ? nA : cA + (size_t)(t + 2) * kstep; const char* b2 = last ? nB : cB + (size_t)(t + 2) * kstep;
            const char* a3 = a2 + kstep; const char* b3 = b2 + kstep;
            if (last && has_next) S.a_ready(nxt);
            PG8_LDB(B0, 0, 0); PG8_SCHED; PG8_LDA(At, 0, 0); PG8_STAGE(PG8_SA(1, 1), a1 + hstep, voffA);
            PG8_WAIT_L(8); PG8_BAR; PG8_WAIT_L(0); PG8_MMA(0, 0, At, B0); PG8_BAR; PG8_SCHED;
            PG8_LDB(B1, 0, 1); PG8_STAGE(PG8_SB(0, 0), b2, voffB);
            PG8_BAR; PG8_WAIT_L(0); PG8_MMA(0, 1, At, B1); PG8_BAR;
            PG8_LDA(At, 0, 1); PG8_STAGE(PG8_SA(0, 0), a2, voffA);
            PG8_BAR; PG8_WAIT_L(0); PG8_MMA(1, 0, At, B0); PG8_BAR; PG8_SCHED;
            PG8_STAGE(PG8_SB(0, 1), b2 + hstep, voffB);
            PG8_WAIT_V(6); PG8_BAR; PG8_MMA(1, 1, At, B1); PG8_BAR;
            PG8_LDB(B0, 1, 0); PG8_SCHED; PG8_LDA(At, 1, 0); PG8_STAGE(PG8_SA(0, 1), a2 + hstep, voffA);
            PG8_WAIT_L(8); PG8_BAR; PG8_WAIT_L(0); PG8_MMA(0, 0, At, B0); PG8_BAR; PG8_SCHED;
            PG8_LDB(B1, 1, 1); PG8_STAGE(PG8_SB(1, 0), b3, voffB);
            PG8_BAR; PG8_WAIT_L(0); PG8_MMA(0, 1, At, B1); PG8_BAR;
            PG8_LDA(At, 1, 1); PG8_STAGE(PG8_SA(1, 0), a3, voffA);
            PG8_BAR; PG8_WAIT_L(0); PG8_MMA(1, 0, At, B0); PG8_BAR; PG8_SCHED;
            PG8_STAGE(PG8_SB(1, 1), b3 + hstep, voffB);
            PG8_WAIT_V(6); PG8_BAR; PG8_MMA(1, 1, At, B1); PG8_BAR;
        }
        PG8_STAMP();
        if constexpr (!Epi::AFTER_DRAIN) { E(acc, cur, wr, wc, fr, fq); S.done(cur); }
        PG8_STAMP();
        if (!has_next) break;
#pragma unroll
        for (int a = 0; a < 2; ++a)
#pragma unroll
            for (int b = 0; b < 2; ++b)
#pragma unroll
                for (int m = 0; m < 4; ++m)
#pragma unroll
                    for (int n = 0; n < 2; ++n) acc[a][b][m][n] = (f32x4){0.f, 0.f, 0.f, 0.f};
        cur = nxt; cA = nA; cB = nB; ++ui;
    }
    PG8_WAIT_V(0);
    if (wr == 0) PG8_BAR;
    PG8_BAR;
    if constexpr (Epi::AFTER_DRAIN) { E.fused(acc, cur, wr, wc, fr, fq, lds, wid, lane); S.done(cur); }
    PG8_STAMP();
    if (STAMP && wid == 0) { stamps[lane] = lane < nts ? (((unsigned long long)(unsigned)ts_hi << 32) | (unsigned)ts_lo) : 0ull;
        if (lane == 62) stamps[62] = rt_entry; if (lane == 63) stamps[63] = (unsigned long long)wall_clock64(); }
#undef PG8_STAMP
#undef PG8_SA
#undef PG8_SB
#undef PG8_STAGE
#undef PG8_LDA
#undef PG8_LDB
#undef PG8_MMA
#undef PG8_WAIT_V
#undef PG8_WAIT_L
#undef PG8_BAR
#undef PG8_SCHED
}
}
using pg8::Unit;

constexpr size_t OFF_MOD = 0;
constexpr size_t OFF_COS = 786432;
constexpr size_t OFF_SIN = OFF_COS + 2097152;
constexpr size_t OFF_W   = OFF_SIN + 2097152;
constexpr size_t W_QKV = 0, W_B = W_QKV + 3072 * 1024, W_F2 = W_B + 4096 * 1024, W_R = W_F2 + 1024 * 2048, W_O = W_R + 1024 * 1024, W_UP = W_O + 1024 * 1024, W_DN = W_UP + 5632 * 1024, W_FT = W_DN + 1024 * 2816, W_DF = W_FT + 1024 * 1024, W_END = W_DF + 2048 * 1024;
constexpr size_t OFF_H  = OFF_W + W_END * 2;
constexpr size_t ACT = (size_t)MTOK * DM * 2;
constexpr size_t OFF_RA = OFF_H + ACT;
constexpr size_t OFF_RB = OFF_RA + ACT;
constexpr size_t OFF_RC = OFF_RB + ACT;
constexpr size_t OFF_RD = OFF_RC + ACT;
constexpr size_t OFF_RE = OFF_RD + 2 * ACT;
constexpr size_t OFF_BAR = OFF_RE + ACT;
constexpr size_t WS_END = OFF_BAR + 16384;

DI u32x4 pack8(const f32x4& a, const f32x4& b) { u32x4 w; w.x = pkh(a[0], a[1]); w.y = pkh(a[2], a[3]); w.z = pkh(b[0], b[1]); w.w = pkh(b[2], b[3]); return w; }

struct EpiQKV {
    static constexpr bool PERM = true, AFTER_DRAIN = false;
    h16 *Q; const float *cosT, *sinT;
    DI void operator()(const f32x4 (&acc)[2][2][4][2], const Unit& u, int wr, int wc, int fr, int fq) const {
        const int sec = u.pn >> 2, head = u.pn & 3, colh = wc * 32 + 8 * fq;
        h16* base = Q + (size_t)sec * ((size_t)MTOK * DM);
        const float scl = sec == 0 ? 0.0625f : 1.0f;
        const int row0 = u.pm * 256 + wr * 64 + fr;
        if (sec == 2) {
#pragma unroll
            for (int it = 0; it < 8; ++it) {
                const int ai = it >> 2, m = it & 3;
                h16* rowp = base + (size_t)(row0 + ai * 128 + m * 16) * DM + head * 256 + colh;
                *(u32x4*)(rowp) = pack8(acc[ai][0][m][0], acc[ai][0][m][1]);
                *(u32x4*)(rowp + 128) = pack8(acc[ai][1][m][0], acc[ai][1][m][1]);
            }
        } else {
            f32x4 cs[2][4];
#define QKV_LD(it_, st_) do { const int pos_ = (row0 + ((it_) >> 2) * 128 + ((it_) & 3) * 16) & (SEQ - 1); const float* c_ = cosT + pos_ * 128 + colh; const float* s_ = sinT + pos_ * 128 + colh; \
            cs[st_][0] = *(const f32x4*)c_; cs[st_][1] = *(const f32x4*)(c_ + 4); cs[st_][2] = *(const f32x4*)s_; cs[st_][3] = *(const f32x4*)(s_ + 4); } while (0)
            QKV_LD(0, 0);
#pragma unroll
            for (int it = 0; it < 8; ++it) {
                const int ai = it >> 2, m = it & 3, st = it & 1;
                if (it + 1 < 8) QKV_LD(it + 1, st ^ 1);
                __builtin_amdgcn_sched_barrier(0);
                h16* rowp = base + (size_t)(row0 + ai * 128 + m * 16) * DM + head * 256 + colh;
                f32x4 o1[2], o2[2];
#pragma unroll
                for (int n = 0; n < 2; ++n) {
                    const f32x4 c = cs[st][n], sn = cs[st][2 + n];
                    const f32x4 t1 = acc[ai][0][m][n], t2 = acc[ai][1][m][n];
                    o1[n] = (t1 * c - t2 * sn) * scl; o2[n] = (t1 * sn + t2 * c) * scl;
                }
                *(u32x4*)(rowp) = pack8(o1[0], o1[1]);
                *(u32x4*)(rowp + 128) = pack8(o2[0], o2[1]);
            }
#undef QKV_LD
        }
    }
};
struct EpiB {
    static constexpr bool PERM = true, AFTER_DRAIN = false;
    unsigned char* ws;
    DI void operator()(const f32x4 (&acc)[2][2][4][2], const Unit& u, int wr, int wc, int fr, int fq) const {
        const int sec = u.pn >> 2, cs = (u.pn & 3) * 256 + wc * 32 + 8 * fq;
        const size_t boff = sec == 0 ? OFF_RC : (sec == 1 ? OFF_RE : (sec == 2 ? OFF_RA : OFF_RB));
        h16* base = (h16*)(ws + boff);
        const int row0 = u.pm * 256 + wr * 64 + fr;
        u32x4 yv[2][2];
#define EB_LD(it_, st_) do { const int r_ = row0 + ((it_) >> 2) * 128 + ((it_) & 3) * 16; yv[st_][0] = *(const u32x4*)(base + (size_t)r_ * DM + cs); yv[st_][1] = *(const u32x4*)(base + (size_t)r_ * DM + cs + 128); } while (0)
        if (sec == 1) EB_LD(0, 0);
#pragma unroll
        for (int it = 0; it < 8; ++it) {
            const int ai = it >> 2, m = it & 3, st = it & 1;
            if (sec == 1 && it + 1 < 8) EB_LD(it + 1, st ^ 1);
            __builtin_amdgcn_sched_barrier(0);
            const int row = row0 + ai * 128 + m * 16;
#pragma unroll
            for (int bj = 0; bj < 2; ++bj) {
                h16* p = base + (size_t)row * DM + cs + bj * 128;
                if (sec == 0) { const int ch = cs + bj * 128; p = base + ((size_t)((row >> 12) * 64 + (ch >> 4)) * SEQ + (row & (SEQ - 1))) * 16 + (ch & 15); }
                f32x4 v0 = acc[ai][bj][m][0], v1 = acc[ai][bj][m][1];
                if (sec == 1) {
                    const u32x4 y = yv[st][bj];
#pragma unroll
                    for (int e = 0; e < 2; ++e) {
                        const f32x2 ya = unpkh(y[e]), yb = unpkh(y[2 + e]);
                        v0[2 * e] = ya.x * v0[2 * e] * sigmoidf_(v0[2 * e]); v0[2 * e + 1] = ya.y * v0[2 * e + 1] * sigmoidf_(v0[2 * e + 1]);
                        v1[2 * e] = yb.x * v1[2 * e] * sigmoidf_(v1[2 * e]); v1[2 * e + 1] = yb.y * v1[2 * e + 1] * sigmoidf_(v1[2 * e + 1]);
                    }
                } else if (sec >= 2) {
#pragma unroll
                    for (int e = 0; e < 4; ++e) { v0[e] = sigmoidf_(v0[e]); v1[e] = sigmoidf_(v1[e]); }
                }
                *(u32x4*)p = pack8(v0, v1);
            }
        }
#undef EB_LD
    }
};
template <int MODE> struct EpiMerge {
    static constexpr bool PERM = true, AFTER_DRAIN = false;
    h16* T; const h16* G;
    DI void operator()(const f32x4 (&acc)[2][2][4][2], const Unit& u, int wr, int wc, int fr, int fq) const {
        const int cs = u.pn * 256 + wc * 32 + 8 * fq;
        const int row0 = u.pm * 256 + wr * 64 + fr;
        u32x4 gv[2][2], tv[2][2];
#define EM_LD(it_, st_) do { const size_t o_ = (size_t)(row0 + ((it_) >> 2) * 128 + ((it_) & 3) * 16) * DM + cs; gv[st_][0] = *(const u32x4*)(G + o_); gv[st_][1] = *(const u32x4*)(G + o_ + 128); \
        if (MODE == 1) { tv[st_][0] = *(const u32x4*)(T + o_); tv[st_][1] = *(const u32x4*)(T + o_ + 128); } } while (0)
        EM_LD(0, 0);
#pragma unroll
        for (int it = 0; it < 8; ++it) {
            const int ai = it >> 2, m = it & 3, st = it & 1;
            if (it + 1 < 8) EM_LD(it + 1, st ^ 1);
            __builtin_amdgcn_sched_barrier(0);
            const int row = row0 + ai * 128 + m * 16;
#pragma unroll
            for (int bj = 0; bj < 2; ++bj) {
                const size_t o = (size_t)row * DM + cs + bj * 128;
                const u32x4 g = gv[st][bj];
                f32x4 v0 = acc[ai][bj][m][0], v1 = acc[ai][bj][m][1];
#pragma unroll
                for (int e = 0; e < 2; ++e) {
                    const f32x2 ga = unpkh(g[e]), gb = unpkh(g[2 + e]);
                    v0[2 * e] *= ga.x; v0[2 * e + 1] *= ga.y; v1[2 * e] *= gb.x; v1[2 * e + 1] *= gb.y;
                    if (MODE == 1) { const f32x2 ta = unpkh(tv[st][bj][e]), tb = unpkh(tv[st][bj][2 + e]); v0[2 * e] += ta.x; v0[2 * e + 1] += ta.y; v1[2 * e] += tb.x; v1[2 * e + 1] += tb.y; }
                }
                *(u32x4*)(T + o) = pack8(v0, v1);
            }
        }
#undef EM_LD
    }
};
struct EpiRes {
    static constexpr bool PERM = false, AFTER_DRAIN = false;
    const float* xi; float* xo; const float* gate; int rowoff;
    DI void operator()(const f32x4 (&acc)[2][2][4][2], const Unit& u, int wr, int wc, int fr, int fq) const {
        const int c0 = u.pn * 256 + wc * 32 + 4 * fq;
        const int row0 = rowoff + u.pm * 256 + wr * 64 + fr;
        const float* gp = gate + (size_t)((rowoff + u.pm * 256) >> 12) * 6144;
        f32x4 gvv[4], xv[2][4];
#pragma unroll
        for (int q = 0; q < 4; ++q) gvv[q] = *(const f32x4*)(gp + c0 + (q >> 1) * 128 + (q & 1) * 16);
#define ER_LD(it_, st_) do { const float* x_ = xi + (size_t)(row0 + ((it_) >> 2) * 128 + ((it_) & 3) * 16) * DM + c0; \
        xv[st_][0] = *(const f32x4*)x_; xv[st_][1] = *(const f32x4*)(x_ + 16); xv[st_][2] = *(const f32x4*)(x_ + 128); xv[st_][3] = *(const f32x4*)(x_ + 144); } while (0)
        ER_LD(0, 0);
#pragma unroll
        for (int it = 0; it < 8; ++it) {
            const int ai = it >> 2, m = it & 3, st = it & 1;
            if (it + 1 < 8) ER_LD(it + 1, st ^ 1);
            __builtin_amdgcn_sched_barrier(0);
            float* xr = xo + (size_t)(row0 + ai * 128 + m * 16) * DM + c0;
#pragma unroll
            for (int q = 0; q < 4; ++q) *(f32x4*)(xr + (q >> 1) * 128 + (q & 1) * 16) = xv[st][q] + gvv[q] * acc[ai][q >> 1][m][q & 1];
        }
#undef ER_LD
    }
};
DI f32x2 gelu_pk(f32x2 v) {
    const f32x2 av = __builtin_elementwise_abs(v), d = av * 0.2316418882f + 1.0f;
    f32x2 t; t.x = __builtin_amdgcn_rcpf(d.x); t.y = __builtin_amdgcn_rcpf(d.y);
    f32x2 q = t * 0.5307027145f + (-0.7265760135f); q = q * t + 0.7107068705f; q = q * t + (-0.142248368f); q = q * t + 0.127414796f; q = q * t;
    const f32x2 s = (v * v) * (-0.72134752044f);
    f32x2 e; e.x = __builtin_amdgcn_exp2f(s.x); e.y = __builtin_amdgcn_exp2f(s.y);
    const f32x2 m = v * (q * e), r = v - m;
    f32x2 o; o.x = v.x < 0.f ? m.x : r.x; o.y = v.y < 0.f ? m.y : r.y; return o;
}

#define DPP_SHR1(old, v) ((fr == 0) ? (old) : __builtin_bit_cast(float, __builtin_amdgcn_update_dpp(0, __builtin_bit_cast(int, (v)), 0x111, 0xf, 0xf, true)))
#define DPP_SHL1(old, v) ((fr == 15) ? (old) : __builtin_bit_cast(float, __builtin_amdgcn_update_dpp(0, __builtin_bit_cast(int, (v)), 0x101, 0xf, 0xf, true)))
#define DPP_ROR1(v)  __builtin_bit_cast(float, __builtin_amdgcn_update_dpp(0, __builtin_bit_cast(int, (v)), 0x121, 0xf, 0xf, false))
#define DPP_ROR15(v) __builtin_bit_cast(float, __builtin_amdgcn_update_dpp(0, __builtin_bit_cast(int, (v)), 0x12f, 0xf, 0xf, false))
struct EpiUpConv {
    static constexpr bool PERM = true, AFTER_DRAIN = false;
    h16* HID; const float* cw; const float* cb; LAS unsigned char* lds;
    DI void operator()(const f32x4 (&acc)[2][2][4][2], const Unit& u, int wr, int wc, int fr, int fq) const {
        LAS float* xb = (LAS float*)(lds + 131072);
        const int wave = wr * 4 + wc;
#pragma unroll
        for (int ai = 0; ai < 2; ++ai)
#pragma unroll
            for (int bj = 0; bj < 2; ++bj)
#pragma unroll
                for (int n = 0; n < 2; ++n) {
                    if (fr == 0)  *(LAS f32x4*)(xb + ((wave * 2 + ai) * 2 + 0) * 64 + bj * 32 + 8 * fq + 4 * n) = acc[ai][bj][0][n];
                    if (fr == 15) *(LAS f32x4*)(xb + ((wave * 2 + ai) * 2 + 1) * 64 + bj * 32 + 8 * fq + 4 * n) = acc[ai][bj][3][n];
                }
        asm volatile("s_waitcnt lgkmcnt(0)" ::: "memory"); __builtin_amdgcn_s_barrier(); asm volatile("" ::: "memory");
        __builtin_amdgcn_s_barrier(); asm volatile("" ::: "memory");
        const int chl = u.pn * 128 + wc * 32 + 8 * fq;
        const int lane_ = fq * 16 + fr;
        const int srcp = 4 * (fr == 0 ? lane_ + 15 : lane_ - 1), srcn = 4 * (fr == 15 ? lane_ - 15 : lane_ + 1);
#pragma unroll
        for (int n = 0; n < 2; ++n) {
            f32x4 wa[3], wb[3];
#pragma unroll
            for (int i = 0; i < 3; ++i) { wa[i] = *(const f32x4*)(cw + i * 2 * DFF + chl + 4 * n); wb[i] = *(const f32x4*)(cw + i * 2 * DFF + DFF + chl + 4 * n); }
            const f32x4 ba = *(const f32x4*)(cb + chl + 4 * n), bb = *(const f32x4*)(cb + DFF + chl + 4 * n);
#pragma unroll
            for (int ai = 0; ai < 2; ++ai) {
                const int wpv = wr ? wave - 4 : wave + 4, aipv = wr ? ai : 0, ainx = wr ? 1 : ai;
                const f32x4 xpa = *(const LAS f32x4*)(xb + ((wpv * 2 + aipv) * 2 + 1) * 64 + 0 * 32 + 8 * fq + 4 * n), xpb = *(const LAS f32x4*)(xb + ((wpv * 2 + aipv) * 2 + 1) * 64 + 1 * 32 + 8 * fq + 4 * n);
                const f32x4 xna = *(const LAS f32x4*)(xb + ((wpv * 2 + ainx) * 2 + 0) * 64 + 0 * 32 + 8 * fq + 4 * n), xnb = *(const LAS f32x4*)(xb + ((wpv * 2 + ainx) * 2 + 0) * 64 + 1 * 32 + 8 * fq + 4 * n);
#pragma unroll
                for (int m = 0; m < 4; ++m) {
                    __builtin_amdgcn_sched_barrier(0);
                    const int lr = ai * 128 + wr * 64 + m * 16 + fr, gr = u.pm * 254 - 1 + lr, pos = gr & (SEQ - 1);
                    const bool okp = pos != 0, okn = pos != SEQ - 1;
                    f32x2 ga[2], gb[2];
#pragma unroll
                    for (int e = 0; e < 4; ++e) {
                        const float xa = acc[ai][0][m][n][e], xbv = acc[ai][1][m][n][e];
                        const float za = (fr == 15 && m > 0) ? acc[ai][0][m > 0 ? m - 1 : 0][n][e] : xa, zb = (fr == 15 && m > 0) ? acc[ai][1][m > 0 ? m - 1 : 0][n][e] : xbv;
                        const float ya = (fr == 0 && m < 3) ? acc[ai][0][m < 3 ? m + 1 : 3][n][e] : xa, yb = (fr == 0 && m < 3) ? acc[ai][1][m < 3 ? m + 1 : 3][n][e] : xbv;
                        float pa = __builtin_bit_cast(float, __builtin_amdgcn_ds_bpermute(srcp, __builtin_bit_cast(int, za)));
                        float pb = __builtin_bit_cast(float, __builtin_amdgcn_ds_bpermute(srcp, __builtin_bit_cast(int, zb)));
                        float na = __builtin_bit_cast(float, __builtin_amdgcn_ds_bpermute(srcn, __builtin_bit_cast(int, ya)));
                        float nb = __builtin_bit_cast(float, __builtin_amdgcn_ds_bpermute(srcn, __builtin_bit_cast(int, yb)));
                        if (m == 0) { pa = fr == 0 ? xpa[e] : pa; pb = fr == 0 ? xpb[e] : pb; }
                        if (m == 3) { na = fr == 15 ? xna[e] : na; nb = fr == 15 ? xnb[e] : nb; }
                        pa = okp ? pa : 0.f; pb = okp ? pb : 0.f; na = okn ? na : 0.f; nb = okn ? nb : 0.f;
                        const float ca = wa[0][e] * pa + (wa[1][e] * xa + (wa[2][e] * na + ba[e]));
                        const float cbv = wb[0][e] * pb + (wb[1][e] * xbv + (wb[2][e] * nb + bb[e]));
                        if (e & 1) { ga[e >> 1].y = ca; gb[e >> 1].y = cbv; } else { ga[e >> 1].x = ca; gb[e >> 1].x = cbv; }
                    }
                    const f32x2 g0 = gelu_pk(ga[0]), g1 = gelu_pk(ga[1]);
                    u32x2 o; o.x = pkh(g0.x * gb[0].x, g0.y * gb[0].y); o.y = pkh(g1.x * gb[1].x, g1.y * gb[1].y);
                    if (lr >= 1 && lr <= 254 && gr < MTOK) *(u32x2*)(HID + (size_t)gr * DFF + chl + 4 * n) = o;
                }
            }
        }
    }
};

struct EpiStore {
    static constexpr bool PERM = true, AFTER_DRAIN = false;
    h16* O; int ldc;
    DI void operator()(const f32x4 (&acc)[2][2][4][2], const Unit& u, int wr, int wc, int fr, int fq) const {
        const int cs = u.pn * 256 + wc * 32 + 8 * fq;
#pragma unroll
        for (int ai = 0; ai < 2; ++ai)
#pragma unroll
            for (int m = 0; m < 4; ++m) {
                __builtin_amdgcn_sched_barrier(0);
                const int row = u.pm * 256 + ai * 128 + wr * 64 + m * 16 + fr;
#pragma unroll
                for (int bj = 0; bj < 2; ++bj) *(u32x4*)(O + (size_t)row * ldc + cs + bj * 128) = pack8(acc[ai][bj][m][0], acc[ai][bj][m][1]);
            }
    }
};


struct Params {
    const float *x, *c, *n1g, *n2g, *ada_w, *ada_b, *w_in, *w_f, *w_r, *w_o, *w_up, *conv_w, *conv_b, *w_dn, *fin_g;
    float* out; unsigned char* ws;
    float lgf[4], lgb[4];
    int ph0, ph1;
};

constexpr int LDS_BYTES = 160 * 1024;
constexpr int NST = 11;
constexpr int NTHR = 512;

DI void phase_prep(const Params& p, LAS unsigned char* lds) {
    const int tid = ltid();
    LAS float* cact = (LAS float*)lds;
    LAS float* red = (LAS float*)(lds + 32768);
    for (int i = tid; i < 8 * 1024; i += NTHR) { const float v = p.c[i]; cact[i] = v / (1.0f + __expf(-v)); }
    __syncthreads();
    float* MOD = (float*)(p.ws + OFF_MOD);
    for (int it = blockIdx.x; it < 256; it += gridDim.x) {
        const int l = it >> 6, j0 = (it & 63) * 96;
        if (tid < 480) {
            const int col = tid % 96, part = tid / 96, d0 = part * 205, d1 = (d0 + 205 < 1024) ? d0 + 205 : 1024;
            float a[8];
#pragma unroll
            for (int b = 0; b < 8; ++b) a[b] = 0.f;
            const float* wp = p.ada_w + ((size_t)l * 1024) * 6144 + j0 + col;
            for (int d = d0; d < d1; d += 16) {
                float wv_[16];
#pragma unroll
                for (int k = 0; k < 16; ++k) wv_[k] = (d + k < d1) ? wp[(size_t)(d + k) * 6144] : 0.f;
#pragma unroll
                for (int k = 0; k < 16; ++k)
#pragma unroll
                    for (int b = 0; b < 8; ++b) a[b] += cact[b * 1024 + ((d + k < 1024) ? d + k : 1023)] * wv_[k];
            }
#pragma unroll
            for (int b = 0; b < 8; ++b) red[(part * 8 + b) * 96 + col] = a[b];
        }
        __syncthreads();
        for (int i = tid; i < 768; i += NTHR) {
            const int b = i / 96, col = i % 96;
            float s = p.ada_b[l * 6144 + j0 + col];
#pragma unroll
            for (int part = 0; part < 5; ++part) s += red[(part * 8 + b) * 96 + col];
            MOD[((size_t)l * 8 + b) * 6144 + j0 + col] = s;
        }
        __syncthreads();
    }
    {
        h16* DF = (h16*)(p.ws + OFF_W) + W_DF;
        for (int it = blockIdx.x * NTHR + tid; it < 2048 * 128; it += gridDim.x * NTHR) {
            const int kk = it >> 7, ch0 = (it & 127) * 8;
            const int cb = kk >> 5, part = (kk >> 4) & 1, chk = cb * 16 + (kk & 15), g = chk >> 7, c2 = chk & 127;
            float a[8];
#pragma unroll
            for (int e = 0; e < 8; ++e) { const int ch = ch0 + e; const int t = (c2 * (ch & 127) - (part ? 32 : 0)) & 127;
                a[e] = ((ch >> 7) == g) ? __builtin_amdgcn_cosf((float)t * (1.0f / 128.0f)) * 0.08838834764831845f : 0.f; }
            u32x4 ov; ov.x = pkh(a[0], a[1]); ov.y = pkh(a[2], a[3]); ov.z = pkh(a[4], a[5]); ov.w = pkh(a[6], a[7]);
            *(u32x4*)(DF + (size_t)kk * 1024 + ch0) = ov;
        }
    }
    float* cosT = (float*)(p.ws + OFF_COS); float* sinT = (float*)(p.ws + OFF_SIN);
    for (int i = blockIdx.x * NTHR + tid; i < SEQ * 128; i += gridDim.x * NTHR) {
        const int pos = i >> 7, j = i & 127;
        const float invf = exp2f(-(float)j * (13.287712379549449f / 128.0f));
        const float ang = (float)pos * invf;
        const double rev = (double)ang * 0.15915494309189535;
        const float fr = (float)(rev - floor(rev));
        cosT[i] = __builtin_amdgcn_cosf(fr); sinT[i] = __builtin_amdgcn_sinf(fr);
    }
}

DI void transpose_item(const float* W, int K, int ldn, int c0, int ncols, h16* WT, int row_off, LAS float* scr, int item, int lane) {
    const int nblk = ncols / 32, kb = item / nblk, nb = item % nblk, k0 = 64 * kb, n0 = 32 * nb;
    f32x4 v[8];
    const float* src = W + (size_t)(k0 + (lane >> 3)) * ldn + c0 + n0 + 4 * (lane & 7);
#pragma unroll
    for (int i = 0; i < 8; ++i) v[i] = *(const f32x4*)(src + (size_t)(8 * i) * ldn);
#pragma unroll
    for (int i = 0; i < 8; ++i) { LAS float* d = scr + ((lane >> 3) + 8 * i) * 33 + 4 * (lane & 7); d[0] = v[i].x; d[1] = v[i].y; d[2] = v[i].z; d[3] = v[i].w; }
    asm volatile("s_waitcnt lgkmcnt(0)" ::: "memory");
    const int c = lane & 7;
#pragma unroll
    for (int j = 0; j < 4; ++j) { const int n = (lane >> 3) + 8 * j; const LAS float* s = scr + (8 * c) * 33 + n;
        u32x4 o; o.x = pkh(s[0 * 33], s[1 * 33]); o.y = pkh(s[2 * 33], s[3 * 33]); o.z = pkh(s[4 * 33], s[5 * 33]); o.w = pkh(s[6 * 33], s[7 * 33]);
        *(u32x4*)(WT + (size_t)(row_off + n0 + n) * K + k0 + 8 * c) = o; }
    asm volatile("s_waitcnt lgkmcnt(0)" ::: "memory");
}

DI void norm_row(const float* xrow, const float* g, const float* sc, const float* sh, h16* orow, int lane) {
    f32x4 v[4]; float s = 0.f;
#pragma unroll
    for (int j = 0; j < 4; ++j) { v[j] = *((const f32x4*)xrow + lane + 64 * j); s += (v[j].x * v[j].x + v[j].y * v[j].y) + (v[j].z * v[j].z + v[j].w * v[j].w); }
    const float r = rsqrtf(wave_sum(s) * (1.0f / DM) + EPS);
#pragma unroll
    for (int j = 0; j < 4; ++j) {
        const int c = 4 * (lane + 64 * j);
        const f32x4 gv = *(const f32x4*)(g + c), scv = *(const f32x4*)(sc + c), shv = *(const f32x4*)(sh + c);
        const f32x4 y = v[j] * r * gv * (scv + 1.0f) + shv;
        u32x2 o; o.x = pkh(y.x, y.y); o.y = pkh(y.z, y.w);
        *(u32x2*)(orow + c) = o;
    }
}


DI void norm_rows(const float* xs, const float* g, const float* modsc, const float* modsh, h16* H, int gw, int NGW, int lane) {
    f32x4 gv[4];
#pragma unroll
    for (int j = 0; j < 4; ++j) gv[j] = *((const f32x4*)g + lane + 64 * j);
    f32x4 v[2][4], sc[2][4], sh[2][4];
#define NR_LD(row_, st_) do { const float* x_ = xs + (size_t)(row_) * DM; const float* c_ = modsc + (size_t)((row_) >> 12) * 6144; const float* h_ = modsh + (size_t)((row_) >> 12) * 6144; \
    _Pragma("unroll") for (int j = 0; j < 4; ++j) { v[st_][j] = *((const f32x4*)x_ + lane + 64 * j); sc[st_][j] = *((const f32x4*)c_ + lane + 64 * j); sh[st_][j] = *((const f32x4*)h_ + lane + 64 * j); } } while (0)
    if (gw < MTOK) NR_LD(gw, 0);
    int st = 0;
    for (int row = gw; row < MTOK; row += NGW) {
        if (row + NGW < MTOK) { if (st == 0) NR_LD(row + NGW, 1); else NR_LD(row + NGW, 0); }
        float s = 0.f;
        f32x4 w[4], c[4], hh[4];
#pragma unroll
        for (int j = 0; j < 4; ++j) { w[j] = st ? v[1][j] : v[0][j]; c[j] = st ? sc[1][j] : sc[0][j]; hh[j] = st ? sh[1][j] : sh[0][j]; s += (w[j].x * w[j].x + w[j].y * w[j].y) + (w[j].z * w[j].z + w[j].w * w[j].w); }
        const float r = rsqrtf(wave_sum(s) * (1.0f / DM) + EPS);
        h16* orow = H + (size_t)row * DM;
#pragma unroll
        for (int j = 0; j < 4; ++j) {
            const f32x4 y = w[j] * r * gv[j] * (c[j] + 1.0f) + hh[j];
            u32x2 o; o.x = pkh(y.x, y.y); o.y = pkh(y.z, y.w);
            *(u32x2*)(orow + 4 * (lane + 64 * j)) = o;
        }
        st ^= 1;
    }
#undef NR_LD
}
DI void convert_rest(const Params& p, int l, LAS unsigned char* lds, int bix, int nblk, int tid) {
    const int lane = tid & 63, wave = tid >> 6;
    LAS float* scr = (LAS float*)(lds + wave * 8704);
    __syncthreads();
    h16* W = (h16*)(p.ws + OFF_W);
    const int gw = bix * 8 + wave, NGW = nblk * 8;
    constexpr int I2 = 16 * 32, I3 = 16 * 96, I4 = 512, I5 = 512, I6 = 16 * 176, I7 = 44 * 32, ITOT = I2 + I3 + I4 + I5 + I6 + I7;
    const float* win = p.w_in + (size_t)l * DM * DIN;
    for (int it = gw; it < ITOT; it += NGW) {
        int r = it;
        if (r < I2) { transpose_item(win, 1024, DIN, 0, 1024, W + W_B, 0, scr, r, lane); continue; } r -= I2;
        if (r < I3) { transpose_item(win, 1024, DIN, 4096, 3072, W + W_B, 1024, scr, r, lane); continue; } r -= I3;
        if (r < I4) { transpose_item(p.w_r + (size_t)l * DM * DM, 1024, 1024, 0, 1024, W + W_R, 0, scr, r, lane); continue; } r -= I4;
        if (r < I5) { transpose_item(p.w_o + (size_t)l * DM * DM, 1024, 1024, 0, 1024, W + W_O, 0, scr, r, lane); continue; } r -= I5;
        if (r < I6) { const int job = r >> 6, pn_ = job >> 1, bj_ = job & 1;
            transpose_item(p.w_up + (size_t)l * DM * 2 * DFF, 1024, 2 * DFF, bj_ * DFF + pn_ * 128, 128, W + W_UP, pn_ * 256 + bj_ * 128, scr, r & 63, lane); continue; } r -= I6;
        transpose_item(p.w_dn + (size_t)l * DFF * DM, DFF, 1024, 0, 1024, W + W_DN, 0, scr, r, lane);
    }
}
DI void phase_p1(const Params& p, int l, LAS unsigned char* lds) {
    const int tid = ltid(), lane = tid & 63, wave = tid >> 6;
    LAS float* scr = (LAS float*)(lds + wave * 8704);
    h16* W = (h16*)(p.ws + OFF_W);
    const int gw = blockIdx.x * 8 + wave, NGW = gridDim.x * 8;
    const float* win = p.w_in + (size_t)l * DM * DIN;
    for (int it = gw; it < 16 * 96 + 512; it += NGW) {
        if (it < 16 * 96) transpose_item(win, 1024, DIN, 1024, 3072, W + W_QKV, 0, scr, it, lane);
        else transpose_item(p.w_f + (size_t)l * DM * DM, 1024, 1024, 0, 1024, W + W_FT, 0, scr, it - 16 * 96, lane);
    }
    const float* xs = (l == 0) ? p.x : p.out;
    const float* MOD = (const float*)(p.ws + OFF_MOD) + (size_t)l * 8 * 6144;
    h16* H = (h16*)(p.ws + OFF_H);
    norm_rows(xs, p.n1g + l * DM, MOD + 1024, MOD, H, gw, NGW, lane);
}
DI void phase_norm2(const Params& p, int l) {
    const int tid = ltid(), lane = tid & 63, wave = tid >> 6;
    const int gw = blockIdx.x * 8 + wave, NGW = gridDim.x * 8;
    const float* MOD = (const float*)(p.ws + OFF_MOD) + (size_t)l * 8 * 6144;
    h16* H = (h16*)(p.ws + OFF_H);
    norm_rows(p.out, p.n2g + l * DM, MOD + 4096, MOD + 3072, H, gw, NGW, lane);
}
DI void phase_final(const Params& p, LAS unsigned char* lds) {
    const int tid = ltid(), lane = tid & 63, wave = tid >> 6;
    const int gw = blockIdx.x * 8 + wave, NGW = gridDim.x * 8;
    for (int row = gw; row < MTOK; row += NGW) {
        float* xr = p.out + (size_t)row * DM;
        f32x4 v[4]; float s = 0.f;
#pragma unroll
        for (int j = 0; j < 4; ++j) { v[j] = *((const f32x4*)xr + lane + 64 * j); s += (v[j].x * v[j].x + v[j].y * v[j].y) + (v[j].z * v[j].z + v[j].w * v[j].w); }
        const float r = rsqrtf(wave_sum(s) * (1.0f / DM) + EPS);
#pragma unroll
        for (int j = 0; j < 4; ++j) { const f32x4 gv = *((const f32x4*)p.fin_g + lane + 64 * j); f32x4 o = v[j] * r * gv;
            if (TSEL != 0 && (row >> 3) == TBLK) { const float tus = (float)TWORDS(lds)[1] * 0.01f; const float enc = (TSEL == 99) ? 0.1f : 0.02f + 0.13f * fminf(tus / TMAX_US, 1.0f); o = o + enc; }
            *((f32x4*)xr + lane + 64 * j) = o; }
    }
}

DI void fft4(float& ar, float& ai, float& br, float& bi, float& cr, float& ci, float& dr, float& di) {
    const float t0r = ar + cr, t0i = ai + ci, t1r = ar - cr, t1i = ai - ci, t2r = br + dr, t2i = bi + di, t3r = br - dr, t3i = bi - di;
    ar = t0r + t2r; ai = t0i + t2i;
    br = t1r + t3i; bi = t1i - t3r;
    cr = t0r - t2r; ci = t0i - t2i;
    dr = t1r - t3i; di = t1i + t3r;
}
DI void fft16(float (&re)[16], float (&im)[16]) {
#pragma unroll
    for (int n2 = 0; n2 < 4; ++n2) fft4(re[n2], im[n2], re[4 + n2], im[4 + n2], re[8 + n2], im[8 + n2], re[12 + n2], im[12 + n2]);
    constexpr float C1 = 0.9238795325112867f, S1 = 0.3826834323650898f, C2 = 0.7071067811865476f;
#define TWM(idx, wr_, wi_) { const float xr = re[idx], xi = im[idx]; re[idx] = xr * (wr_) - xi * (wi_); im[idx] = xr * (wi_) + xi * (wr_); }
    TWM(5, C1, -S1) TWM(6, C2, -C2) TWM(7, S1, -C1)
    TWM(9, C2, -C2) TWM(10, 0.f, -1.f) TWM(11, -C2, -C2)
    TWM(13, S1, -C1) TWM(14, -C2, -C2) TWM(15, -C1, S1)
#undef TWM
#pragma unroll
    for (int k1 = 0; k1 < 4; ++k1) fft4(re[4 * k1], im[4 * k1], re[4 * k1 + 1], im[4 * k1 + 1], re[4 * k1 + 2], im[4 * k1 + 2], re[4 * k1 + 3], im[4 * k1 + 3]);
}
DI int fsw(int idx) { return idx ^ ((idx >> 4) & 15); }
template <bool TW> DI void fft_stage(LAS unsigned* X, int rb, int rs, const float (&twr)[16], const float (&twi)[16]) {
    float re[16], im[16];
#pragma unroll
    for (int n = 0; n < 16; ++n) { const f32x2 v = unpkh(X[fsw(rb + rs * n)]); re[n] = v.x; im[n] = v.y; }
    fft16(re, im);
#pragma unroll
    for (int k = 0; k < 16; ++k) {
        const int idx = 4 * (k & 3) + (k >> 2);
        float orr, oi;
        if (TW) { orr = re[idx] * twr[k] - im[idx] * twi[k]; oi = re[idx] * twi[k] + im[idx] * twr[k]; }
        else { orr = re[idx] * 0.25f; oi = im[idx] * 0.25f; }
        X[fsw(rb + rs * k)] = pkh(orr, oi);
    }
}
DI void phase_fft(const Params& p, LAS unsigned char* lds) {
    const int tid = ltid(), t = tid & 255, hs = tid >> 8;
    LAS unsigned* X = (LAS unsigned*)lds;
    const h16* UF = (const h16*)(p.ws + OFF_RC);
    h16* PQ = (h16*)(p.ws + OFF_RD);
    float twAr[16], twAi[16], twBr[16], twBi[16];
#pragma unroll
    for (int k = 0; k < 16; ++k) {
        const float fa = (float)(t * k) * (1.0f / 4096.0f), fb = (float)((t & 15) * k) * (1.0f / 256.0f);
        twAr[k] = 0.25f * __builtin_amdgcn_cosf(fa); twAi[k] = -0.25f * __builtin_amdgcn_sinf(fa);
        twBr[k] = 0.25f * __builtin_amdgcn_cosf(fb); twBi[k] = -0.25f * __builtin_amdgcn_sinf(fb);
    }
    for (int it = blockIdx.x; it < 512; it += gridDim.x) {
        const int b = it >> 6, cb = it & 63;
        {
            const h16* ub = UF + ((size_t)(b * 64 + cb) * SEQ) * 16;
#pragma unroll 1
            for (int kb = 0; kb < 16; kb += 8) {
                u32x4 lv[8];
#pragma unroll
                for (int k = 0; k < 8; ++k) lv[k] = *(const u32x4*)(ub + (size_t)(tid + 512 * (kb + k)) * 8);
#pragma unroll
                for (int k = 0; k < 8; ++k) {
                    const int i = tid + 512 * (kb + k), s = i >> 1, hf = i & 1, ss_ = fsw(s);
                    X[(4 * hf + 0) * 4096 + ss_] = lv[k].x; X[(4 * hf + 1) * 4096 + ss_] = lv[k].y; X[(4 * hf + 2) * 4096 + ss_] = lv[k].z; X[(4 * hf + 3) * 4096 + ss_] = lv[k].w;
                }
            }
        }
        __syncthreads();
#pragma unroll 1
        for (int r = 0; r < 4; ++r) fft_stage<true>(X + (2 * r + hs) * 4096, t, 256, twAr, twAi);
        __syncthreads();
#pragma unroll 1
        for (int r = 0; r < 4; ++r) fft_stage<true>(X + (2 * r + hs) * 4096, 256 * (t >> 4) + (t & 15), 16, twBr, twBi);
        __syncthreads();
#pragma unroll 1
        for (int r = 0; r < 4; ++r) fft_stage<false>(X + (2 * r + hs) * 4096, 16 * t, 1, twBr, twBi);
        __syncthreads();
        for (int i = tid; i < 16384; i += NTHR) {
            const int q = i & 3, idx = i >> 2;
            const int kf = (idx >> 8) + 16 * ((idx >> 4) & 15) + 256 * (idx & 15);
            const int km = (4096 - kf) & 4095;
            const int idm = 256 * (km & 15) + 16 * ((km >> 4) & 15) + (km >> 8);
            const int part = q >> 1, sg0 = (q & 1) * 4;
            unsigned o[4];
#pragma unroll
            for (int j = 0; j < 4; ++j) {
                const f32x2 z = unpkh(X[(sg0 + j) * 4096 + fsw(idx)]), zm = unpkh(X[(sg0 + j) * 4096 + fsw(idm)]);
                o[j] = part == 0 ? pkh(0.5f * (z.x + zm.x), 0.5f * (z.y + zm.y)) : pkh(0.5f * (z.y - zm.y), -0.5f * (z.x - zm.x));
            }
            u32x4 ov = {o[0], o[1], o[2], o[3]};
            *(u32x4*)(PQ + ((size_t)(b * SEQ + kf)) * 2048 + cb * 32 + q * 8) = ov;
        }
        __syncthreads();
    }
}

#define MFMA16(a, b, c) __builtin_amdgcn_mfma_f32_16x16x32_f16((a), (b), (c), 0, 0, 0)
DI h16x8 cat4(h16x4 a, h16x4 b) { return __builtin_shufflevector(a, b, 0, 1, 2, 3, 4, 5, 6, 7); }
DI h16x8 packf8(const f32x4& a, const f32x4& b) { const u32x4 w = pack8(a, b); return __builtin_bit_cast(h16x8, w); }
#define TR8I(o, base, O0, O1, O2, O3, O4, O5, O6, O7) \
    asm volatile("ds_read_b64_tr_b16 %0, %8 offset:%9\n\tds_read_b64_tr_b16 %1, %8 offset:%10\n\tds_read_b64_tr_b16 %2, %8 offset:%11\n\tds_read_b64_tr_b16 %3, %8 offset:%12\n\t" \
                 "ds_read_b64_tr_b16 %4, %8 offset:%13\n\tds_read_b64_tr_b16 %5, %8 offset:%14\n\tds_read_b64_tr_b16 %6, %8 offset:%15\n\tds_read_b64_tr_b16 %7, %8 offset:%16" \
                 : "=&v"(o[0]), "=&v"(o[1]), "=&v"(o[2]), "=&v"(o[3]), "=&v"(o[4]), "=&v"(o[5]), "=&v"(o[6]), "=&v"(o[7]) \
                 : "v"(base), "i"(O0), "i"(O1), "i"(O2), "i"(O3), "i"(O4), "i"(O5), "i"(O6), "i"(O7) : "memory")
#define TRWAIT(n, o) asm volatile("s_waitcnt lgkmcnt(" #n ")" : "+v"(o[0]), "+v"(o[1]), "+v"(o[2]), "+v"(o[3]), "+v"(o[4]), "+v"(o[5]), "+v"(o[6]), "+v"(o[7]) :: "memory")

constexpr int SC_OFF = 128 * 544 + 128 * 288 + 1024, SC_STRIDE = 272;
constexpr int SQ_STRIDE = 544, SQQ_STRIDE = 528, SV_STRIDE = 288, SQ_BYTES = 128 * SQ_STRIDE, SV_BYTES = 128 * SV_STRIDE;

#define SBAR() do { asm volatile("s_waitcnt lgkmcnt(0)" ::: "memory"); __builtin_amdgcn_s_barrier(); asm volatile("" ::: "memory"); } while (0)
DI void scan_item(const Params& p, LAS unsigned char* lds, int it, int tid) {
    const int lane = tid & 63, w = __builtin_amdgcn_readfirstlane(tid >> 6), li = lane & 15, g = lane >> 4;
    const h16* Qb = (const h16*)(p.ws + OFF_RA); const h16* Kb = (const h16*)(p.ws + OFF_RB); const h16* Vb = (const h16*)(p.ws + OFF_RC);
    h16* CR = (h16*)(p.ws + OFF_RD);
    const unsigned lbase = (unsigned)(uintptr_t)lds;
    const int b = it >> 4, h = (it >> 2) & 3, dir = (it >> 1) & 1, dvh = it & 1;
    const float lg = dir ? p.lgb[h] : p.lgf[h];
    __syncthreads();
    if (w >= 4) {
        int st = tid - 256; asm volatile("" : "+v"(st));
        u32x4 rqq[16], rqk[16], rv[8];
        const unsigned bigoff = (unsigned)((st >> 5) * DM + (st & 31) * 8), voff = (unsigned)((st >> 4) * DM + (st & 15) * 8);
        LAS unsigned char* const wbig = lds + (st >> 5) * SQ_STRIDE + (st & 31) * 16;
        LAS unsigned char* const wbigq = lds + (st >> 5) * SQQ_STRIDE + (st & 31) * 16;
        LAS unsigned char* const wv = lds + SQ_BYTES + (st >> 4) * SV_STRIDE + (st & 15) * 16;
#define S2_LOADBIG(R, SRC, c_) do { const h16* s_ = (SRC) + ((size_t)b * SEQ + 128 * (c_)) * DM + h * 256; \
        _Pragma("unroll") for (int k_ = 0; k_ < 16; ++k_) R[k_] = *(const u32x4*)(s_ + (size_t)k_ * 8 * DM + bigoff); } while (0)
#define S2_LOADV(c_) do { const h16* s_ = Vb + ((size_t)b * SEQ + 128 * (c_)) * DM + h * 256 + dvh * 128; \
        _Pragma("unroll") for (int k_ = 0; k_ < 8; ++k_) rv[k_] = *(const u32x4*)(s_ + (size_t)k_ * 16 * DM + voff); } while (0)
        S2_LOADBIG(rqq, Qb, dir ? 31 : 0); S2_LOADV(dir ? 31 : 0); S2_LOADBIG(rqk, Kb, dir ? 31 : 0);
        {
            LAS float* dtab = (LAS float*)(lds + SQ_BYTES + SV_BYTES);
            const int j = st & 127;
            dtab[st] = st < 128 ? exp2f(lg * (dir ? (float)(128 - j) : (float)(j + 1))) : exp2f(lg * (dir ? (float)j : (float)(127 - j)));
        }
#pragma unroll 1
        for (int i = 0; i < 32; ++i) {
            const int cn = dir ? 30 - i : i + 1;
#pragma unroll
            for (int k_ = 0; k_ < 16; ++k_) *(LAS u32x4*)(wbigq + k_ * 8 * SQQ_STRIDE) = rqq[k_];
#pragma unroll
            for (int k_ = 0; k_ < 8; ++k_) *(LAS u32x4*)(wv + k_ * 16 * SV_STRIDE) = rv[k_];
            SBAR();
            if (i + 1 < 32) { S2_LOADBIG(rqq, Qb, cn); S2_LOADV(cn); }
            SBAR();
#pragma unroll
            for (int k_ = 0; k_ < 16; ++k_) *(LAS u32x4*)(wbig + k_ * 8 * SQ_STRIDE) = rqk[k_];
            SBAR();
            if (i + 1 < 32) S2_LOADBIG(rqk, Kb, cn);
            {
                const int c = dir ? 31 - i : i;
                h16* crc = CR + (size_t)dir * MTOK * DM + ((size_t)b * SEQ + 128 * c) * DM + h * 256 + dvh * 128;
#pragma unroll
                for (int k_ = 0; k_ < 8; ++k_) { const int pc_ = st + 256 * k_; const u32x4 v_ = *(const LAS u32x4*)(lds + SC_OFF + (pc_ >> 4) * SC_STRIDE + (pc_ & 15) * 16);
                    *(u32x4*)(crc + (size_t)(pc_ >> 4) * DM + (pc_ & 15) * 8) = v_; }
            }
            SBAR();
        }
#undef S2_LOADBIG
#undef S2_LOADV
    } else {
        const float g128 = exp2f(lg * 128.0f);
        f32x4 F[2][16];
#pragma unroll
        for (int nf = 0; nf < 2; ++nf)
#pragma unroll
            for (int i = 0; i < 16; ++i) F[nf][i] = (f32x4){0.f, 0.f, 0.f, 0.f};
#pragma unroll 1
        for (int i = 0; i < 32; ++i) {
            const int c = dir ? 31 - i : i;
            float lgl = lg; int lil = li, gl = g; asm volatile("" : "+v"(lgl), "+v"(lil), "+v"(gl));
            TBEG(4, lds); SBAR(); TEND(4, lds);
            TBEG(2, lds);
#ifndef QREP
#define QREP 1
#endif
#pragma unroll 1
            for (int rr_ = 0; rr_ < QREP; ++rr_) {
                const LAS unsigned char* qr = lds + lil * SQQ_STRIDE + 8 * gl;
#pragma unroll
                for (int hm = 0; hm < 4; ++hm) {
                    f32x4 d[2][2];
#pragma unroll
                    for (int nf = 0; nf < 2; ++nf)
#pragma unroll
                        for (int mf = 0; mf < 2; ++mf) d[nf][mf] = (f32x4){0.f, 0.f, 0.f, 0.f};
#pragma unroll
                    for (int ks = 0; ks < 8; ++ks) {
                        const h16x8 ff0 = packf8(F[0][2 * ks], F[0][2 * ks + 1]), ff1 = packf8(F[1][2 * ks], F[1][2 * ks + 1]);
                        h16x4 q0[2], q1[2];
#pragma unroll
                        for (int mf = 0; mf < 2; ++mf) { q0[mf] = *(const LAS h16x4*)(qr + 16 * (2 * hm + mf) * SQQ_STRIDE + 64 * ks); q1[mf] = *(const LAS h16x4*)(qr + 16 * (2 * hm + mf) * SQQ_STRIDE + 64 * ks + 32); }
#pragma unroll
                        for (int mf = 0; mf < 2; ++mf) { const h16x8 qv = cat4(q0[mf], q1[mf]); d[0][mf] = MFMA16(ff0, qv, d[0][mf]); d[1][mf] = MFMA16(ff1, qv, d[1][mf]); }
                    }
#pragma unroll
                    for (int mf = 0; mf < 2; ++mf) {
                        const int j = 16 * (2 * hm + mf) + lil;
                        const float a = ((const LAS float*)(lds + SQ_BYTES + SV_BYTES))[j];
#pragma unroll
                        for (int nf = 0; nf < 2; ++nf) {
                            u32x2 o; o.x = pkh(d[nf][mf][0] * a, d[nf][mf][1] * a); o.y = pkh(d[nf][mf][2] * a, d[nf][mf][3] * a);
                            *(LAS u32x2*)(lds + SC_OFF + j * SC_STRIDE + (32 * w + 16 * nf + 4 * gl) * 2) = o;
                        }
                    }
                    __builtin_amdgcn_sched_barrier(0);
                }
            }
            TEND(2, lds);
            TBEG(5, lds); SBAR();
            SBAR(); TEND(5, lds);
            TBEG(3, lds);
            {
#pragma unroll
                for (int nf = 0; nf < 2; ++nf)
#pragma unroll
                    for (int fm = 0; fm < 16; ++fm) F[nf][fm] *= g128;
                const unsigned kb = lbase + (4 * gl + (lil >> 2)) * SQ_STRIDE + (lil & 3) * 8;
                const unsigned vb = lbase + SQ_BYTES + (4 * gl + (lil >> 2)) * SV_STRIDE + (32 * w + (lil & 3) * 4) * 2;
#define S2_KOFF(ks2, f4, q, hi) ((ks2) * 32 * SQ_STRIDE + (4 * (f4) + (q)) * 32 + (hi) * 16 * SQ_STRIDE)
#define S2_ISSUE(buf, ks2, f4) TR8I(buf, kb, S2_KOFF(ks2, f4, 0, 0), S2_KOFF(ks2, f4, 0, 1), S2_KOFF(ks2, f4, 1, 0), S2_KOFF(ks2, f4, 1, 1), S2_KOFF(ks2, f4, 2, 0), S2_KOFF(ks2, f4, 2, 1), S2_KOFF(ks2, f4, 3, 0), S2_KOFF(ks2, f4, 3, 1))
#define S2_MMA(buf, f4) do { _Pragma("unroll") for (int q_ = 0; q_ < 4; ++q_) { const h16x8 kf_ = cat4(buf[2 * q_], buf[2 * q_ + 1]); \
                F[0][4 * (f4) + q_] = MFMA16(kf_, vf0, F[0][4 * (f4) + q_]); F[1][4 * (f4) + q_] = MFMA16(kf_, vf1, F[1][4 * (f4) + q_]); } } while (0)
#pragma unroll
                for (int ks2 = 0; ks2 < 4; ++ks2) {
                    h16x4 kA[8], kB[8];
                    h16x8 vf0, vf1;
                    const LAS float* bt_ = (const LAS float*)(lds + SQ_BYTES + SV_BYTES) + 128 + 32 * ks2 + 4 * gl;
                    const f32x4 b0_ = *(const LAS f32x4*)bt_, b1_ = *(const LAS f32x4*)(bt_ + 16);
                    asm volatile("s_waitcnt lgkmcnt(0)" ::: "memory");
                    {
                        h16x4 vt[8];
                        TR8I(vt, vb, ks2 * 32 * SV_STRIDE, ks2 * 32 * SV_STRIDE + 16 * SV_STRIDE, ks2 * 32 * SV_STRIDE + 32, ks2 * 32 * SV_STRIDE + 16 * SV_STRIDE + 32,
                                     ks2 * 32 * SV_STRIDE, ks2 * 32 * SV_STRIDE + 16 * SV_STRIDE, ks2 * 32 * SV_STRIDE + 32, ks2 * 32 * SV_STRIDE + 16 * SV_STRIDE + 32);
                        S2_ISSUE(kA, ks2, 0);
                        TRWAIT(8, vt);
                        vf0 = cat4(vt[0], vt[1]); vf1 = cat4(vt[2], vt[3]);
#pragma unroll
                        for (int e = 0; e < 8; ++e) {
                            const float bj = e < 4 ? b0_[e & 3] : b1_[e & 3];
                            vf0[e] = (h16)((float)vf0[e] * bj); vf1[e] = (h16)((float)vf1[e] * bj);
                        }
                    }
                    S2_ISSUE(kB, ks2, 1); TRWAIT(8, kA); S2_MMA(kA, 0);
                    S2_ISSUE(kA, ks2, 2); TRWAIT(8, kB); S2_MMA(kB, 1);
                    S2_ISSUE(kB, ks2, 3); TRWAIT(8, kA); S2_MMA(kA, 2);
                    TRWAIT(0, kB); S2_MMA(kB, 3);
                    __builtin_amdgcn_sched_barrier(0);
                }
#undef S2_KOFF
#undef S2_ISSUE
#undef S2_MMA
            }
            TEND(3, lds);
            TBEG(6, lds); SBAR(); TEND(6, lds);
        }
    }
    __syncthreads();
}

constexpr int CH_K_STRIDE = 528, CH_V_STRIDE = 544, CH_K_BYTES = 128 * CH_K_STRIDE;
DI void intra_item(const Params& p, LAS unsigned char* lds, int it, int tid) {
    const int lane = tid & 63, w = tid >> 6, li = lane & 15, g = lane >> 4;
    const h16* Qb = (const h16*)(p.ws + OFF_RA); const h16* Kb = (const h16*)(p.ws + OFF_RB); const h16* Vb = (const h16*)(p.ws + OFF_RC);
    h16* YR = (h16*)(p.ws + OFF_RE);
    const unsigned lbase = (unsigned)(uintptr_t)lds;
    const int b = it >> 7, h = (it >> 5) & 3, c = it & 31;
    const size_t row0 = (size_t)b * SEQ + 128 * c;
    const float lgf = p.lgf[h], lgb = p.lgb[h];
    __syncthreads();
    {
        const h16* ks = Kb + row0 * DM + h * 256; const h16* vs = Vb + row0 * DM + h * 256;
        u32x4 r[8];
#pragma unroll
        for (int k = 0; k < 8; ++k) { const int pc = tid + 512 * k; r[k] = *(const u32x4*)(ks + (size_t)(pc >> 5) * DM + (pc & 31) * 8); }
#pragma unroll
        for (int k = 0; k < 8; ++k) { const int pc = tid + 512 * k; *(LAS u32x4*)(lds + (pc >> 5) * CH_K_STRIDE + (pc & 31) * 16) = r[k]; }
#pragma unroll
        for (int k = 0; k < 8; ++k) { const int pc = tid + 512 * k; r[k] = *(const u32x4*)(vs + (size_t)(pc >> 5) * DM + (pc & 31) * 8); }
#pragma unroll
        for (int k = 0; k < 8; ++k) { const int pc = tid + 512 * k; *(LAS u32x4*)(lds + CH_K_BYTES + (pc >> 5) * CH_V_STRIDE + (pc & 31) * 16) = r[k]; }
    }
    const int jabs = 16 * w + li;
    const size_t prow = row0 + jabs;
    h16x8 qf[8];
#pragma unroll
    for (int ks = 0; ks < 8; ++ks) qf[ks] = *(const h16x8*)(Qb + prow * DM + h * 256 + 32 * ks + 8 * g);
    __syncthreads();
    h16x8 pf[4];
#pragma unroll
    for (int mf2 = 0; mf2 < 4; ++mf2) {
        f32x4 s2[2];
#pragma unroll
        for (int hh = 0; hh < 2; ++hh) {
            const int mf = 2 * mf2 + hh;
            f32x4 s = (f32x4){0.f, 0.f, 0.f, 0.f};
            const LAS unsigned char* kr = lds + (16 * mf + li) * CH_K_STRIDE + 16 * g;
#pragma unroll
            for (int ks = 0; ks < 8; ++ks) s = MFMA16(*(const LAS h16x8*)(kr + 64 * ks), qf[ks], s);
#pragma unroll
            for (int r = 0; r < 4; ++r) {
                const int m = 16 * mf + 4 * g + r, df = jabs - m;
                const float dec = df >= 0 ? exp2f(lgf * (float)df) : exp2f(lgb * (float)(-df));
                s[r] *= dec;
            }
            s2[hh] = s;
        }
        pf[mf2] = packf8(s2[0], s2[1]);
    }
    const unsigned vb = lbase + CH_K_BYTES + (4 * g + (li >> 2)) * CH_V_STRIDE + (li & 3) * 8;
    h16* yo = YR + prow * DM + h * 256 + 4 * g;
#define IN_ISSUE(buf, df) TR8I(buf, vb, (df) * 32 + 0 * 32 * CH_V_STRIDE, (df) * 32 + 0 * 32 * CH_V_STRIDE + 16 * CH_V_STRIDE, (df) * 32 + 1 * 32 * CH_V_STRIDE, (df) * 32 + 1 * 32 * CH_V_STRIDE + 16 * CH_V_STRIDE, \
                                       (df) * 32 + 2 * 32 * CH_V_STRIDE, (df) * 32 + 2 * 32 * CH_V_STRIDE + 16 * CH_V_STRIDE, (df) * 32 + 3 * 32 * CH_V_STRIDE, (df) * 32 + 3 * 32 * CH_V_STRIDE + 16 * CH_V_STRIDE)
#define IN_MMA(buf, df) do { f32x4 o_ = (f32x4){0.f, 0.f, 0.f, 0.f}; _Pragma("unroll") for (int ks_ = 0; ks_ < 4; ++ks_) o_ = MFMA16(cat4(buf[2 * ks_], buf[2 * ks_ + 1]), pf[ks_], o_); \
        u32x2 ov_; ov_.x = pkh(o_[0], o_[1]); ov_.y = pkh(o_[2], o_[3]); *(u32x2*)(yo + 16 * (df)) = ov_; } while (0)
    h16x4 vA[8], vB[8];
    IN_ISSUE(vA, 0);
#pragma unroll
    for (int df = 0; df < 16; df += 2) {
        IN_ISSUE(vB, df + 1);
        TRWAIT(8, vA);
        IN_MMA(vA, df);
        if (df + 2 < 16) { IN_ISSUE(vA, df + 2); TRWAIT(8, vB); } else { TRWAIT(0, vB); }
        IN_MMA(vB, df + 1);
    }
#undef IN_ISSUE
#undef IN_MMA
}

DI void phase_mix(const Params& p, int l, LAS unsigned char* lds) {
    const int tid = ltid();
    const int nb = (int)gridDim.x, bid = (int)blockIdx.x;
    const bool std = nb == 256;
#ifndef MIXPART
#define MIXPART 7
#endif
#ifndef SCANREP
#define SCANREP 1
#endif
#ifndef INTRAREP
#define INTRAREP 1
#endif
    if (MIXPART & 1) for (int r_ = 0; r_ < SCANREP; ++r_) for (int it = bid; it < 128; it += nb) { TBEG(1, lds); scan_item(p, lds, it, tid); TEND(1, lds); }
    TBEG(8, lds);
    if ((MIXPART & 2) && (!std || bid >= 128)) {
        convert_rest(p, l, lds, std ? bid - 128 : bid, std ? 128 : nb, tid);
        __syncthreads();
        h16* W = (h16*)(p.ws + OFF_W);
        pg8::Gemm gg; gg.A = W + W_FT; gg.Bt = W + W_DF; gg.M = 1024; gg.N = 2048; gg.K = 1024; gg.a_rows = 256;
        pg8::StaticOrder S; S.init(1024, 2048, std ? 128 : nb, std ? bid - 128 : bid);
        EpiStore E; E.O = W + W_F2; E.ldc = 2048;
        pg8::gemm_phase<EpiStore, pg8::StaticOrder, false>(lds, gg, S, E, nullptr);
    }
    TEND(8, lds);
    __syncthreads();
    int i0, cnt, stride;
    if (std) { if (bid < 128) { i0 = 0; cnt = 0; } else { i0 = (bid - 128) * 8; cnt = 8; } stride = 1; }
    else { i0 = bid; cnt = (1024 - bid + nb - 1) / nb; stride = nb; }
    TBEG(7, lds);
    if (MIXPART & 4) for (int r_ = 0; r_ < INTRAREP; ++r_) for (int k = 0; k < cnt; ++k) intra_item(p, lds, i0 + k * stride, tid);
    TEND(7, lds);
}

DI void phase_partB(const Params& p) {
    const int tid = ltid(), lane = tid & 63, wave = tid >> 6;
    const int gw = blockIdx.x * 8 + wave, NGW = gridDim.x * 8;
    h16* YR = (h16*)(p.ws + OFF_RE); const h16* CR = (const h16*)(p.ws + OFF_RD);
    u32x4 ld[2][6];
#define PB_LD(row_, st_) do { const size_t o_ = (size_t)(row_) * DM + lane * 16; ld[st_][0] = *(const u32x4*)(YR + o_); ld[st_][1] = *(const u32x4*)(YR + o_ + 8); ld[st_][2] = *(const u32x4*)(CR + o_); ld[st_][3] = *(const u32x4*)(CR + o_ + 8); \
        ld[st_][4] = *(const u32x4*)(CR + (size_t)MTOK * DM + o_); ld[st_][5] = *(const u32x4*)(CR + (size_t)MTOK * DM + o_ + 8); } while (0)
    if (gw < MTOK) PB_LD(gw, 0);
    int st = 0;
    for (int row = gw; row < MTOK; row += NGW) {
        if (row + NGW < MTOK) { if (st == 0) PB_LD(row + NGW, 1); else PB_LD(row + NGW, 0); }
        const size_t o = (size_t)row * DM + lane * 16;
        float v[16];
#pragma unroll
        for (int hh = 0; hh < 2; ++hh) {
            const u32x4 a = st ? ld[1][hh] : ld[0][hh], c0 = st ? ld[1][2 + hh] : ld[0][2 + hh], c1 = st ? ld[1][4 + hh] : ld[0][4 + hh];
#pragma unroll
            for (int e = 0; e < 4; ++e) { const f32x2 x = unpkh(a[e]), y = unpkh(c0[e]), z = unpkh(c1[e]); v[8 * hh + 2 * e] = x.x + y.x + z.x; v[8 * hh + 2 * e + 1] = x.y + y.y + z.y; }
        }
        st ^= 1;
        float s = 0.f;
#pragma unroll
        for (int e = 0; e < 16; ++e) s += v[e];
        s += __shfl_xor(s, 1); s += __shfl_xor(s, 2); s += __shfl_xor(s, 4); s += __shfl_xor(s, 8);
        const float mu = s * (1.0f / 256.0f);
        float q2 = 0.f;
#pragma unroll
        for (int e = 0; e < 16; ++e) { v[e] -= mu; q2 += v[e] * v[e]; }
        q2 += __shfl_xor(q2, 1); q2 += __shfl_xor(q2, 2); q2 += __shfl_xor(q2, 4); q2 += __shfl_xor(q2, 8);
        const float rs = rsqrtf(q2 * (1.0f / 256.0f) + EPS);
#pragma unroll
        for (int hh = 0; hh < 2; ++hh) {
            u32x4 ov;
#pragma unroll
            for (int e = 0; e < 4; ++e) ov[e] = pkh(v[8 * hh + 2 * e] * rs, v[8 * hh + 2 * e + 1] * rs);
            *(u32x4*)(YR + o + 8 * hh) = ov;
        }
    }
}

DI h16x2 u2h(unsigned u) { return __builtin_bit_cast(h16x2, u); }
DI void phase_conv(const Params& p, int l, int half) {
    const h16* U = (const h16*)(p.ws + OFF_RA); h16* HID = (h16*)(p.ws + OFF_RD);
    const float* cw = p.conv_w + (size_t)l * 3 * 2 * DFF; const float* cbias = p.conv_b + (size_t)l * 2 * DFF;
    constexpr int RB = 8, NCG = DFF / 8, NU = (MTOK / 2 / RB) * NCG;
    const int tid = ltid();
    for (int un = blockIdx.x * NTHR + tid; un < NU; un += gridDim.x * NTHR) {
        const int rb = un / NCG, cg_ = un - rb * NCG, r0 = rb * RB, n0 = cg_ * 8;
        const int pos0 = r0 & (SEQ - 1);
        const h16* ur = U + (size_t)r0 * (2 * DFF) + n0;
        u32x4 ra[RB + 2], rbv[RB + 2];
        const bool okp = pos0 != 0, okn = (pos0 + RB) < SEQ;
#pragma unroll
        for (int r = 0; r < RB + 2; ++r) {
            const bool ok = (r == 0) ? okp : ((r == RB + 1) ? okn : true);
            ra[r] = (u32x4){0u, 0u, 0u, 0u}; rbv[r] = (u32x4){0u, 0u, 0u, 0u};
            if (ok) { ra[r] = *(const u32x4*)(ur + (ptrdiff_t)(r - 1) * (2 * DFF)); rbv[r] = *(const u32x4*)(ur + (ptrdiff_t)(r - 1) * (2 * DFF) + DFF); }
        }
        h16x2 wa[3][4], wb[3][4], ba[4], bb[4];
#pragma unroll
        for (int i = 0; i < 3; ++i)
#pragma unroll
            for (int e = 0; e < 2; ++e) {
                const f32x4 x = *(const f32x4*)(cw + i * 2 * DFF + n0 + 4 * e), y = *(const f32x4*)(cw + i * 2 * DFF + DFF + n0 + 4 * e);
                wa[i][2 * e] = (h16x2){(h16)x.x, (h16)x.y}; wa[i][2 * e + 1] = (h16x2){(h16)x.z, (h16)x.w};
                wb[i][2 * e] = (h16x2){(h16)y.x, (h16)y.y}; wb[i][2 * e + 1] = (h16x2){(h16)y.z, (h16)y.w};
            }
#pragma unroll
        for (int e = 0; e < 2; ++e) {
            const f32x4 x = *(const f32x4*)(cbias + n0 + 4 * e), y = *(const f32x4*)(cbias + DFF + n0 + 4 * e);
            ba[2 * e] = (h16x2){(h16)x.x, (h16)x.y}; ba[2 * e + 1] = (h16x2){(h16)x.z, (h16)x.w};
            bb[2 * e] = (h16x2){(h16)y.x, (h16)y.y}; bb[2 * e + 1] = (h16x2){(h16)y.z, (h16)y.w};
        }
#pragma unroll
        for (int r = 0; r < RB; ++r) {
            u32x4 ov;
#pragma unroll
            for (int e = 0; e < 4; ++e) {
                const h16x2 av = wa[0][e] * u2h(ra[r][e]) + (wa[1][e] * u2h(ra[r + 1][e]) + (wa[2][e] * u2h(ra[r + 2][e]) + ba[e]));
                const h16x2 bv = wb[0][e] * u2h(rbv[r][e]) + (wb[1][e] * u2h(rbv[r + 1][e]) + (wb[2][e] * u2h(rbv[r + 2][e]) + bb[e]));
                const f32x2 gl = gelu_pk((f32x2){(float)av.x, (float)av.y});
                ov[e] = pkh(gl.x * (float)bv.x, gl.y * (float)bv.y);
            }
            *(u32x4*)(HID + (size_t)(r0 + r) * DFF + n0) = ov;
        }
    }
}

template <class Epi> DI void run_gemm(LAS unsigned char* lds, const h16* A, const h16* Bt, int M, int N, int K, const Epi& E) {
    pg8::Gemm g; g.A = A; g.Bt = Bt; g.M = M; g.N = N; g.K = K; g.a_rows = 256;
    pg8::StaticOrder S; S.init(M, N, (int)gridDim.x, (int)blockIdx.x);
    pg8::gemm_phase<Epi, pg8::StaticOrder, false>(lds, g, S, E, nullptr);
}

DI void run_phase(const Params& p, int ph, LAS unsigned char* lds) {
    unsigned char* ws = p.ws;
    h16* W = (h16*)(ws + OFF_W); h16* H = (h16*)(ws + OFF_H);
    h16* RA = (h16*)(ws + OFF_RA); h16* RB = (h16*)(ws + OFF_RB); h16* RC = (h16*)(ws + OFF_RC); h16* RD = (h16*)(ws + OFF_RD); h16* RE = (h16*)(ws + OFF_RE);
#ifndef PHMASK
#define PHMASK 0xFFFFF
#endif
#define PHON(k) ((PHMASK >> (k)) & 1)
    if (ph == 0) { if (PHON(16)) phase_prep(p, lds); return; }
    if (ph == 1 + NST * NLAYER) { if (PHON(17)) phase_final(p, lds); return; }
    const int l = (ph - 1) / NST, st = (ph - 1) % NST;
    const float* MODl = (const float*)(ws + OFF_MOD) + (size_t)l * 8 * 6144;
    switch (st) {
    case 0: if (PHON(0)) phase_p1(p, l, lds); break;
    case 1: if (PHON(1)) { EpiQKV E; E.Q = RA; E.cosT = (const float*)(ws + OFF_COS); E.sinT = (const float*)(ws + OFF_SIN); run_gemm(lds, H, W + W_QKV, MTOK, 3072, 1024, E); } break;
    case 2: if (PHON(2)) phase_mix(p, l, lds); break;
    case 3: if (PHON(3)) phase_partB(p); break;
    case 4: if (PHON(4)) { EpiB E; E.ws = ws; run_gemm(lds, H, W + W_B, MTOK, 4096, 1024, E); } break;
    case 5: if (PHON(5)) phase_fft(p, lds); break;
    case 6: if (PHON(6)) {
        { EpiMerge<0> E; E.T = RC; E.G = RA; run_gemm(lds, RD, W + W_F2, MTOK, 1024, 2048, E); }
        asm volatile("s_waitcnt vmcnt(0)" ::: "memory"); __syncthreads();
        { EpiMerge<1> E; E.T = RC; E.G = RB; run_gemm(lds, RE, W + W_R, MTOK, 1024, 1024, E); } } break;
    case 7: if (PHON(8)) { EpiRes E; E.xi = (l == 0) ? p.x : p.out; E.xo = p.out; E.gate = MODl + 2048; E.rowoff = 0; run_gemm(lds, RC, W + W_O, MTOK, 1024, 1024, E); } break;
    case 8: if (PHON(9)) phase_norm2(p, l); break;
    case 9: if (PHON(10)) {
        EpiUpConv E; E.HID = RD; E.cw = p.conv_w + (size_t)l * 3 * 2 * DFF; E.cb = p.conv_b + (size_t)l * 2 * DFF; E.lds = lds;
        pg8::Gemm g; g.A = H - DM; g.Bt = W + W_UP; g.M = 130 * 256; g.N = 2 * DFF; g.K = 1024; g.a_rows = 254;
        pg8::StaticOrder S; S.init(130 * 256, 2 * DFF, (int)gridDim.x, (int)blockIdx.x);
        pg8::gemm_phase<EpiUpConv, pg8::StaticOrder, false>(lds, g, S, E, nullptr); } break;
    case 10: if (PHON(12)) { EpiRes E; E.xi = p.out; E.xo = p.out; E.gate = MODl + 5120; E.rowoff = 0; run_gemm(lds, RD, W + W_DN, MTOK, 1024, DFF, E); } break;
    }
}


#define XB_TMO      128
#define XB_XCNT(j)  (256  + 64 * (j))
#define XB_XSUB(j)  (1280 + 64 * (j))
#define XB_XGEN(j)  (2304 + 64 * (j))
#define XB_TOP      3328
#define XB_TOPGEN   3392
#define XCD_BAR_WORDS 3456
#define XB_SPIN_CAP (1u << 18)
DI unsigned xb_ld(unsigned* p)              { return __hip_atomic_load(p, __ATOMIC_RELAXED, __HIP_MEMORY_SCOPE_AGENT); }
DI unsigned xb_add(unsigned* p, unsigned v) { return __hip_atomic_fetch_add(p, v, __ATOMIC_RELAXED, __HIP_MEMORY_SCOPE_AGENT); }
DI unsigned xb_xcc_id() { return (unsigned)__builtin_amdgcn_s_getreg((3 << 11) | 20) & 0xFu; }
#define XB_SPIN(cond, bar) do { unsigned _sp = 0; while (cond) { __builtin_amdgcn_s_sleep(1); \
    if ((++_sp & 255u) == 0u) { if (xb_ld(&(bar)[XB_TMO])) break; if (_sp > XB_SPIN_CAP) { atomicAdd(&(bar)[XB_TMO], 1u); break; } } } } while (0)
DI void xcd_barrier_complete(unsigned* bar, unsigned x, unsigned& nloc, unsigned& nx) {
    const unsigned G = gridDim.x;
    unsigned sum, cnt, mine, sp = 0u;
    for (;;) {
        sum = 0u; cnt = 0u; mine = 0u;
#pragma unroll
        for (unsigned j = 0; j < 16; ++j) { const unsigned c = xb_ld(&bar[XB_XCNT(j)]); sum += c; cnt += (c > 0u) ? 1u : 0u; mine = (j == x) ? c : mine; }
        if (sum == G) break;
        __builtin_amdgcn_s_sleep(1);
        if ((++sp & 255u) == 0u) { if (xb_ld(&bar[XB_TMO])) break; if (sp > XB_SPIN_CAP) { atomicAdd(&bar[XB_TMO], 1u); break; } }
    }
    nloc = mine > 0u ? mine : 1u; nx = cnt > 0u ? cnt : 1u;
}
DI void xcd_barrier(unsigned* bar, unsigned x, volatile LAS unsigned* st) {
    asm volatile("s_waitcnt vmcnt(0)" ::: "memory");
    __syncthreads();
    if (threadIdx.x == 0) {
        __builtin_amdgcn_s_waitcnt(0);
        unsigned nloc = st[0], nx = st[1];
        if (nloc == 0u) { xcd_barrier_complete(bar, x, nloc, nx); st[0] = nloc; st[1] = nx; }
        const unsigned old = xb_add(&bar[XB_XSUB(x)], 1u);
        const unsigned gen = old / nloc;
        if (old + 1u == (gen + 1u) * nloc) {
            __builtin_amdgcn_fence(__ATOMIC_RELEASE, "agent");
            asm volatile("s_waitcnt vmcnt(0)" ::: "memory");
            const unsigned og = xb_add(&bar[XB_TOP], 1u);
            const unsigned tg = og / nx;
            if (og + 1u == (tg + 1u) * nx) xb_add(&bar[XB_TOPGEN], 1u);
            else XB_SPIN(xb_ld(&bar[XB_TOPGEN]) == tg, bar);
            __builtin_amdgcn_fence(__ATOMIC_ACQUIRE, "agent");
            xb_add(&bar[XB_XGEN(x)], 1u);
            asm volatile("s_waitcnt vmcnt(0)" ::: "memory");
        } else {
            XB_SPIN(xb_ld(&bar[XB_XGEN(x)]) == gen, bar);
            __builtin_amdgcn_fence(__ATOMIC_ACQUIRE, "agent");
            asm volatile("s_waitcnt vmcnt(0)" ::: "memory");
        }
    }
    __syncthreads();
}
#define LIGHT_BARRIER() do { \
                ++nbar; \
                asm volatile("s_waitcnt vmcnt(0)" ::: "memory");       \
                __syncthreads(); \
                if (threadIdx.x == 0) { \
                    __builtin_amdgcn_fence(__ATOMIC_RELEASE, "agent");   \
                    asm volatile("s_waitcnt vmcnt(0)" ::: "memory"); \
                    __hip_atomic_fetch_add(bar, 1u, __ATOMIC_RELAXED, __HIP_MEMORY_SCOPE_AGENT); \
                    const unsigned target = nbar * gridDim.x; \
                    const unsigned long long t0 = __builtin_amdgcn_s_memrealtime(); \
                    while (__hip_atomic_load(bar, __ATOMIC_RELAXED, __HIP_MEMORY_SCOPE_AGENT) < target) { \
                        __builtin_amdgcn_s_sleep(1); \
                        if (__builtin_amdgcn_s_memrealtime() - t0 > 20000000ull) break;      \
                    } \
                    __builtin_amdgcn_fence(__ATOMIC_ACQUIRE, "agent");   \
                    asm volatile("s_waitcnt vmcnt(0)" ::: "memory"); \
                } \
                __syncthreads(); \
             \
} while (0)
template <class T> DI T* launder(T* p) {
    unsigned lo = (unsigned)(uintptr_t)p, hi = (unsigned)((uintptr_t)p >> 32);
    asm volatile("" : "+v"(lo), "+v"(hi));
    lo = __builtin_amdgcn_readfirstlane(lo); hi = __builtin_amdgcn_readfirstlane(hi);
    return (T*)(((uintptr_t)hi << 32) | (uintptr_t)lo);
}
__global__ void __launch_bounds__(512, 2) fwd_megakernel(Params p) {
    extern __shared__ __attribute__((aligned(16))) unsigned char smem[];
    LAS unsigned char* lds = (LAS unsigned char*)smem;
    cg::grid_group grid = cg::this_grid();
    if (TSEL != 0 && threadIdx.x == 0) { TWORDS(lds)[0] = 0ull; TWORDS(lds)[1] = 0ull; }
    volatile LAS unsigned* xst = (volatile LAS unsigned*)(lds + 163840 - 64);
    const unsigned xcc = xb_xcc_id();
    if (threadIdx.x == 0) { xst[0] = 0u; xst[1] = 0u; (void)xb_add(&((unsigned*)(p.ws + OFF_BAR))[XB_XCNT(xcc)], 1u); }
    __syncthreads();
#ifndef REPMASK
#define REPMASK 0
#endif
    int rep = 0; unsigned nbar = 0;
    unsigned* bar = (unsigned*)(p.ws + OFF_BAR);
    for (int ph = p.ph0; ph < p.ph1;) {
        run_phase(p, ph, lds);
        const bool again = REPMASK != 0 && rep == 0 && ph >= 1 && ph < 1 + NST * NLAYER && ((REPMASK >> ((ph - 1) % NST)) & 1);
        if (again) rep = 1; else { rep = 0; ++ph; }
        if (ph < p.ph1) {
            if (ph == 1 && rep == 0) grid.sync();
            else {
                xcd_barrier(bar, xcc, xst);
            }
#ifdef EXTRASYNC
            LIGHT_BARRIER(); LIGHT_BARRIER();
#endif
        }
    }
}

extern "C" void kernel_launch(void* const* d_in, const int* in_sizes, int n_in, void* d_out, int out_size, void* d_ws, size_t ws_size, hipStream_t stream) {
    static int grid = 0;
    if (grid == 0) {
        int dev = 0, cus = 0, per_cu = 0;
        hipGetDevice(&dev);
        hipDeviceGetAttribute(&cus, hipDeviceAttributeMultiprocessorCount, dev);
        if (hipFuncSetAttribute((const void*)fwd_megakernel, hipFuncAttributeMaxDynamicSharedMemorySize, LDS_BYTES) != hipSuccess) fprintf(stderr, "kernel_launch: hipFuncSetAttribute failed\n");
        hipOccupancyMaxActiveBlocksPerMultiprocessor(&per_cu, (const void*)fwd_megakernel, NTHR, LDS_BYTES);
        if (per_cu < 1) { fprintf(stderr, "kernel_launch: occupancy query says %d blocks per CU\n", per_cu); per_cu = 1; }
        (void)hipGetLastError();
        grid = cus * 1;
        if (ws_size < WS_END) fprintf(stderr, "kernel_launch: workspace too small: %zu < %zu\n", ws_size, (size_t)WS_END);
        fprintf(stderr, "kernel_launch: grid %d (cus %d, per_cu %d), ws %zu need %zu\n", grid, cus, per_cu, ws_size, (size_t)WS_END);
    }
    Params p{};
    const float* const* in = (const float* const*)d_in;
    p.x = in[0]; p.c = in[1]; p.n1g = in[2]; p.n2g = in[3]; p.ada_w = in[4]; p.ada_b = in[5]; p.w_in = in[6]; p.w_f = in[7]; p.w_r = in[8]; p.w_o = in[9];
    p.w_up = in[10]; p.conv_w = in[11]; p.conv_b = in[12]; p.w_dn = in[13]; p.fin_g = in[14];
    p.out = (float*)d_out; p.ws = (unsigned char*)d_ws;
    for (int h = 0; h < 4; ++h) {
        p.lgf[h] = (float)(std::log1p(-std::exp2(-5.0 - h)) / std::log(2.0));
        p.lgb[h] = (float)(std::log1p(-std::exp2(-5.5 - h)) / std::log(2.0));
    }
    constexpr int NPH = 2 + NST * NLAYER;
#if MULTI_LAUNCH
    for (int ph = 0; ph < NPH; ++ph) {
        p.ph0 = ph; p.ph1 = ph + 1;
        hipLaunchKernelGGL(fwd_megakernel, dim3(grid), dim3(NTHR), LDS_BYTES, stream, p);
    }
#else
    p.ph0 = 0; p.ph1 = NPH;
    (void)hipMemsetAsync((unsigned char*)d_ws + OFF_BAR, 0, 16384, stream);
    void* args[] = {&p};
    hipError_t e = hipLaunchCooperativeKernel((const void*)fwd_megakernel, dim3(grid), dim3(NTHR), args, LDS_BYTES, stream);
    if (e != hipSuccess) fprintf(stderr, "cooperative launch failed: %s (grid %d)\n", hipGetErrorString(e), grid);
#endif
}
```

```cpp
#include <hip/hip_runtime.h>
#include <hip/hip_cooperative_groups.h>
#include <cstdio>
#include <cstdint>
#include <cmath>
namespace cg = cooperative_groups;

#ifndef GEMM_SP2
#define GEMM_SP2 true
#endif
#ifndef GEMM_ALIGN
#define GEMM_ALIGN true
#endif
#ifndef MULTI_LAUNCH
#define MULTI_LAUNCH 0
#endif

#define DI __device__ __forceinline__
#define LAS __attribute__((address_space(3)))
typedef _Float16 h16;
typedef h16 h16x2 __attribute__((ext_vector_type(2)));
typedef h16 h16x4 __attribute__((ext_vector_type(4)));
typedef h16 h16x8 __attribute__((ext_vector_type(8)));
typedef float f32x2 __attribute__((ext_vector_type(2)));
typedef float f32x4 __attribute__((ext_vector_type(4)));
typedef unsigned u32x2 __attribute__((ext_vector_type(2)));
typedef unsigned u32x4 __attribute__((ext_vector_type(4)));

constexpr int MTOK = 32768, DM = 1024, SEQ = 4096, NLAYER = 4, DFF = 2816, DIN = 7168;
constexpr float EPS = 1e-6f;

#ifndef TSEL
#define TSEL 0
#endif
#ifndef TBLK
#define TBLK 0
#endif
#ifndef TMAX_US
#define TMAX_US 2000.0f
#endif
#define TWORDS(lds_) ((LAS unsigned long long*)((lds_) + 163840 - 32))
#define TBEG(id, lds_) do { if (TSEL == (id) && blockIdx.x == TBLK && threadIdx.x == (TBLK >= 128 ? 0 : 0)) TWORDS(lds_)[0] = __builtin_amdgcn_s_memrealtime(); } while (0)
#define TEND(id, lds_) do { if (TSEL == (id) && blockIdx.x == TBLK && threadIdx.x == 0) TWORDS(lds_)[1] += __builtin_amdgcn_s_memrealtime() - TWORDS(lds_)[0]; } while (0)
DI int ltid() { int t = threadIdx.x; asm volatile("" : "+v"(t)); return t; }
DI unsigned pkh(float lo, float hi) { h16x2 v = {(h16)lo, (h16)hi}; return __builtin_bit_cast(unsigned, v); }
DI f32x2 unpkh(unsigned u) { h16x2 v = __builtin_bit_cast(h16x2, u); return (f32x2){(float)v.x, (float)v.y}; }
DI float wave_sum(float v) {
#pragma unroll
    for (int o = 1; o < 64; o <<= 1) v += __shfl_xor(v, o);
    return v;
}
DI float sigmoidf_(float x) { return 1.0f / (1.0f + __expf(-x)); }

namespace pg8 {
#define PG8_LAS __attribute__((address_space(3)))
typedef h16 bf16_t;
typedef h16x8 bf16x8;
constexpr int BM = 256, BK = 64, HALF = 128, HTB = HALF * BK * 2, STAGE_BYTES = 8 * HTB, NXCD = 8, WGM = 8;
__host__ __device__ __forceinline__ int lds_byte(int r, int c) { const int st = (r >> 4) * 2 + (c >> 5), rr = r & 15, cc = c & 31, ob = rr * 64 + cc * 2; return st * 1024 + (ob ^ (((ob >> 9) & 1) << 5)); }
__host__ __device__ __forceinline__ void stage_rc(int b, int& R, int& C) { const int st = b / 1024, sb = b % 1024, swz = sb ^ (((sb >> 9) & 1) << 5); R = (st >> 1) * 16 + swz / 64; C = (st & 1) * 32 + (swz % 64) / 2; }
__host__ __device__ __forceinline__ int perm32(int rho) { const int n = rho >> 4, i = rho & 15; return 8 * (i >> 2) + 4 * n + (i & 3); }
struct Unit { int pm, pn; };
struct Gemm { const bf16_t* A; const bf16_t* Bt; int M, N, K; int a_rows; };
struct StaticOrder {
    int nM, nN, nwg, G, c;
    __host__ __device__ void init(int M, int N, int G_, int c_) { nM = M / BM; nN = N / BM; nwg = nM * nN; G = G_; c = c_; }
    __host__ __device__ bool next(int i, Unit& u) const {
        const long L = (long)i * G + c; if (L >= nwg) return false;
        int wgid = (int)L; { const int q = nwg / NXCD, r = nwg % NXCD, xcd = wgid % NXCD, off = wgid / NXCD; wgid = (xcd < r ? xcd * (q + 1) : r * (q + 1) + (xcd - r) * q) + off; }
        const int nig = WGM * nN, gid = wgid / nig, fm = gid * WGM, gsz = (nM - fm) < WGM ? (nM - fm) : WGM;
        u.pm = fm + ((wgid % nig) % gsz); u.pn = (wgid % nig) / gsz; return true;
    }
    __device__ __forceinline__ void a_ready(const Unit&) const {}
    __device__ __forceinline__ void done(const Unit&) const {}
};
template <class Epi, class Sched, bool STAMP = false, bool ALIGN_EPI = false, bool SP2 = false>
__device__ __forceinline__ void gemm_phase(PG8_LAS unsigned char* lds, const Gemm g, const Sched& S, const Epi& E, unsigned long long* stamps) {
    const int tid = ltid(), wid = __builtin_amdgcn_readfirstlane(tid >> 6), lane = tid & 63, wr = wid >> 2, wc = wid & 3, fr = lane & 15, fq = lane >> 4;
    const int K = g.K, nt = K / BK;
    int ts_lo = 0, ts_hi = 0, nts = 0; const unsigned long long rt_entry = STAMP ? (unsigned long long)wall_clock64() : 0ull;
#define PG8_STAMP() do { if (STAMP && wid == 0 && nts < 64) { const unsigned long long _c = (unsigned long long)clock64(); \
        ts_lo = (lane == nts) ? (int)(unsigned)_c : ts_lo; ts_hi = (lane == nts) ? (int)(unsigned)(_c >> 32) : ts_hi; ++nts; } } while (0)
    PG8_STAMP();
    unsigned voffA[2], voffB[2];
#pragma unroll
    for (int i = 0; i < 2; ++i) { int R, C; stage_rc(tid * 16 + i * 8192, R, C); const int Rb = Epi::PERM ? ((R & ~31) + perm32(R & 31)) : R;
        voffA[i] = (unsigned)(R * K + C) * 2u; voffB[i] = (unsigned)(Rb * K + C) * 2u; }
    const size_t kstep = (size_t)(BK * 2);
    const size_t hstep = (size_t)HALF * K * 2;
    const size_t tstep = 2 * hstep;
    const size_t tstepA = (size_t)g.a_rows * K * 2;
    const unsigned ldsw = (unsigned)wid * 1024u;
    const int aoff = lds_byte(wr * 64 + fr, fq * 8), boff = lds_byte(wc * 32 + fr, fq * 8);
#define PG8_SA(b, h) (((b) * 2 + (h)) * HTB)
#define PG8_SB(b, h) ((4 + (b) * 2 + (h)) * HTB)
#define PG8_STAGE(bufoff, gbase, voff) do { _Pragma("unroll") for (int _i = 0; _i < 2; ++_i) \
        __builtin_amdgcn_global_load_lds((const unsigned*)((const char*)(gbase) + (voff)[_i]), (PG8_LAS unsigned*)(lds + (bufoff) + ldsw + _i * 8192), 16, 0, 0); } while (0)
#define PG8_LDA(dst, b, h) do { _Pragma("unroll") for (int m = 0; m < 4; ++m) _Pragma("unroll") for (int k = 0; k < 2; ++k) dst[m][k] = *(const PG8_LAS bf16x8*)(lds + PG8_SA(b, h) + aoff + m * 2048 + k * 1024); } while (0)
#define PG8_LDB(dst, b, h) do { _Pragma("unroll") for (int n = 0; n < 2; ++n) _Pragma("unroll") for (int k = 0; k < 2; ++k) dst[n][k] = *(const PG8_LAS bf16x8*)(lds + PG8_SB(b, h) + boff + n * 2048 + k * 1024); } while (0)
#define PG8_MMA(ai, bj, At, Bt) do { __builtin_amdgcn_s_setprio(1); _Pragma("unroll") for (int m = 0; m < 4; ++m) _Pragma("unroll") for (int n = 0; n < 2; ++n) _Pragma("unroll") for (int k = 0; k < 2; ++k) \
        acc[ai][bj][m][n] = __builtin_amdgcn_mfma_f32_16x16x32_f16(Bt[n][k], At[m][k], acc[ai][bj][m][n], 0, 0, 0); __builtin_amdgcn_s_setprio(0); } while (0)
#define PG8_WAIT_V(n) asm volatile("s_waitcnt vmcnt(" #n ")" ::: "memory")
#define PG8_WAIT_L(n) asm volatile("s_waitcnt lgkmcnt(" #n ")" ::: "memory")
#define PG8_BAR __builtin_amdgcn_s_barrier()
#define PG8_SCHED __builtin_amdgcn_sched_barrier(0)
    Unit cur, nxt; int ui = 0;
    if (!S.next(0, cur)) return;
    f32x4 acc[2][2][4][2];
#pragma unroll
    for (int a = 0; a < 2; ++a)
#pragma unroll
        for (int b = 0; b < 2; ++b)
#pragma unroll
            for (int m = 0; m < 4; ++m)
#pragma unroll
                for (int n = 0; n < 2; ++n) acc[a][b][m][n] = (f32x4){0.f, 0.f, 0.f, 0.f};
    bf16x8 At[4][2], B0[2][2], B1[2][2];
    const char* cA = (const char*)g.A + (size_t)cur.pm * tstepA; const char* cB = (const char*)g.Bt + (size_t)cur.pn * tstep;
    S.a_ready(cur);
    if constexpr (SP2) {
        PG8_STAGE(PG8_SB(0, 0), cB, voffB); PG8_STAGE(PG8_SB(0, 1), cB + hstep, voffB); PG8_STAGE(PG8_SA(0, 0), cA, voffA); PG8_STAGE(PG8_SA(0, 1), cA + hstep, voffA);
        if (wr == 1) PG8_BAR;
        PG8_WAIT_V(2); PG8_BAR;
        PG8_STAGE(PG8_SB(1, 0), cB + kstep, voffB); PG8_STAGE(PG8_SA(1, 0), cA + kstep, voffA); PG8_STAGE(PG8_SB(1, 1), cB + hstep + kstep, voffB);
        PG8_WAIT_V(6); PG8_BAR;
    } else {
    PG8_STAGE(PG8_SB(0, 0), cB, voffB); PG8_STAGE(PG8_SA(0, 0), cA, voffA); PG8_STAGE(PG8_SB(0, 1), cB + hstep, voffB); PG8_STAGE(PG8_SA(0, 1), cA + hstep, voffA);
    if (wr == 1) PG8_BAR;
    PG8_WAIT_V(4); PG8_BAR;
    PG8_STAGE(PG8_SB(1, 0), cB + kstep, voffB); PG8_STAGE(PG8_SA(1, 0), cA + kstep, voffA); PG8_STAGE(PG8_SB(1, 1), cB + hstep + kstep, voffB);
    PG8_WAIT_V(6); PG8_BAR;
    }
    PG8_STAMP();
    for (;;) {
        const bool has_next = S.next(ui + 1, nxt);
        const char* nA = has_next ? (const char*)g.A + (size_t)nxt.pm * tstepA : cA; const char* nB = has_next ? (const char*)g.Bt + (size_t)nxt.pn * tstep : cB;
        for (int t = 0; t < nt; t += 2) {
            const bool last = (t == nt - 2);
            const char* a1 = cA + (size_t)(t + 1) * kstep;
            const char* a2 = last ? nA : cA + (size_t)(t + 2) * kstep; const char* b2 = last ? nB : cB + (size_t)(t + 2) * kstep;
            const char* a3 = a2 + kstep; const char* b3 = b2 + kstep;
            if (last && has_next) S.a_ready(nxt);
            if constexpr (SP2) {
            PG8_LDB(B0, 0, 0); PG8_LDB(B1, 0, 1); PG8_SCHED; PG8_LDA(At, 0, 0); PG8_STAGE(PG8_SA(1, 1), a1 + hstep, voffA);
            PG8_WAIT_V(8); PG8_WAIT_L(0); PG8_BAR; PG8_MMA(0, 0, At, B0); PG8_MMA(0, 1, At, B1); PG8_BAR; PG8_SCHED;
            PG8_LDA(At, 0, 1); PG8_STAGE(PG8_SB(0, 0), b2, voffB); PG8_STAGE(PG8_SB(0, 1), b2 + hstep, voffB); PG8_STAGE(PG8_SA(0, 0), a2, voffA);
            PG8_WAIT_V(8); PG8_WAIT_L(0); PG8_BAR; PG8_MMA(1, 0, At, B0); PG8_MMA(1, 1, At, B1); PG8_BAR; PG8_SCHED;
            PG8_LDB(B0, 1, 0); PG8_LDB(B1, 1, 1); PG8_SCHED; PG8_LDA(At, 1, 0); PG8_STAGE(PG8_SA(0, 1), a2 + hstep, voffA);
            PG8_WAIT_V(8); PG8_WAIT_L(0); PG8_BAR; PG8_MMA(0, 0, At, B0); PG8_MMA(0, 1, At, B1); PG8_BAR; PG8_SCHED;
            PG8_LDA(At, 1, 1); PG8_STAGE(PG8_SB(1, 0), b3, voffB); PG8_STAGE(PG8_SB(1, 1), b3 + hstep, voffB); PG8_STAGE(PG8_SA(1, 0), a3, voffA);
            PG8_WAIT_V(8); PG8_WAIT_L(0); PG8_BAR; PG8_MMA(1, 0, At, B0); PG8_MMA(1, 1, At, B1); PG8_BAR; PG8_SCHED;
            } else {
            PG8_LDB(B0, 0, 0); PG8_SCHED; PG8_LDA(At, 0, 0); PG8_STAGE(PG8_SA(1, 1), a1 + hstep, voffA);
            PG8_WAIT_L(8); PG8_BAR; PG8_WAIT_L(0); PG8_MMA(0, 0, At, B0); PG8_BAR; PG8_SCHED;
            PG8_LDB(B1, 0, 1); PG8_STAGE(PG8_SB(0, 0), b2, voffB);
            PG8_BAR; PG8_WAIT_L(0); PG8_MMA(0, 1, At, B1); PG8_BAR;
            PG8_LDA(At, 0, 1); PG8_STAGE(PG8_SA(0, 0), a2, voffA);
            PG8_BAR; PG8_WAIT_L(0); PG8_MMA(1, 0, At, B0); PG8_BAR; PG8_SCHED;
            PG8_STAGE(PG8_SB(0, 1), b2 + hstep, voffB);
            PG8_WAIT_V(6); PG8_BAR; PG8_MMA(1, 1, At, B1); PG8_BAR;
            PG8_LDB(B0, 1, 0); PG8_SCHED; PG8_LDA(At, 1, 0); PG8_STAGE(PG8_SA(0, 1), a2 + hstep, voffA);
            PG8_WAIT_L(8); PG8_BAR; PG8_WAIT_L(0); PG8_MMA(0, 0, At, B0); PG8_BAR; PG8_SCHED;
            PG8_LDB(B1, 1, 1); PG8_STAGE(PG8_SB(1, 0), b3, voffB);
            PG8_BAR; PG8_WAIT_L(0); PG8_MMA(0, 1, At, B1); PG8_BAR;
            PG8_LDA(At, 1, 1); PG8_STAGE(PG8_SA(1, 0), a3, voffA);
            PG8_BAR; PG8_WAIT_L(0); PG8_MMA(1, 0, At, B0); PG8_BAR; PG8_SCHED;
            PG8_STAGE(PG8_SB(1, 1), b3 + hstep, voffB);
            PG8_WAIT_V(6); PG8_BAR; PG8_MMA(1, 1, At, B1); PG8_BAR;
            }
        }
        PG8_STAMP();
        if constexpr (ALIGN_EPI) { if (wr == 0) PG8_BAR; }
        if constexpr (!Epi::AFTER_DRAIN) { E(acc, cur, wr, wc, fr, fq); S.done(cur); }
        PG8_STAMP();
        if (!has_next) break;
#pragma unroll
        for (int a = 0; a < 2; ++a)
#pragma unroll
            for (int b = 0; b < 2; ++b)
#pragma unroll
                for (int m = 0; m < 4; ++m)
#pragma unroll
                    for (int n = 0; n < 2; ++n) acc[a][b][m][n] = (f32x4){0.f, 0.f, 0.f, 0.f};
        cur = nxt; cA = nA; cB = nB; ++ui;
        if constexpr (ALIGN_EPI) { if (wr == 1) PG8_BAR; }
    }
    PG8_WAIT_V(0);
    if constexpr (!ALIGN_EPI) { if (wr == 0) PG8_BAR; }
    PG8_BAR;
    if constexpr (Epi::AFTER_DRAIN) { E.fused(acc, cur, wr, wc, fr, fq, lds, wid, lane); S.done(cur); }
    PG8_STAMP();
    if (STAMP && wid == 0) { stamps[lane] = lane < nts ? (((unsigned long long)(unsigned)ts_hi << 32) | (unsigned)ts_lo) : 0ull;
        if (lane == 62) stamps[62] = rt_entry; if (lane == 63) stamps[63] = (unsigned long long)wall_clock64(); }
#undef PG8_STAMP
#undef PG8_SA
#undef PG8_SB
#undef PG8_STAGE
#undef PG8_LDA
#undef PG8_LDB
#undef PG8_MMA
#undef PG8_WAIT_V
#undef PG8_WAIT_L
#undef PG8_BAR
#undef PG8_SCHED
}
}
using pg8::Unit;

constexpr size_t OFF_MOD = 0;
constexpr size_t OFF_COS = 786432;
constexpr size_t OFF_SIN = OFF_COS + 2097152;
constexpr size_t OFF_W   = OFF_SIN + 2097152;
constexpr size_t W_QKV = 0, W_B = W_QKV + 3072 * 1024, W_F2 = W_B + 4096 * 1024, W_R = W_F2 + 1024 * 2048, W_O = W_R + 1024 * 1024, W_UP = W_O + 1024 * 1024, W_DN = W_UP + 5632 * 1024, W_FT = W_DN + 1024 * 2816, W_DF = W_FT + 1024 * 1024, W_END = W_DF + 2048 * 1024;
constexpr size_t OFF_H  = OFF_W + W_END * 2;
constexpr size_t ACT = (size_t)MTOK * DM * 2;
constexpr size_t OFF_RA = OFF_H + ACT;
constexpr size_t OFF_RB = OFF_RA + ACT;
constexpr size_t OFF_RC = OFF_RB + ACT;
constexpr size_t OFF_RD = OFF_RC + ACT;
constexpr size_t OFF_RE = OFF_RD + 2 * ACT;
constexpr size_t OFF_BAR = OFF_RE + ACT;
constexpr size_t WS_END = OFF_BAR + 16384;

DI u32x4 pack8(const f32x4& a, const f32x4& b) { u32x4 w; w.x = pkh(a[0], a[1]); w.y = pkh(a[2], a[3]); w.z = pkh(b[0], b[1]); w.w = pkh(b[2], b[3]); return w; }

struct EpiQKV {
    static constexpr bool PERM = true, AFTER_DRAIN = false;
    h16 *Q; const float *cosT, *sinT;
    DI void operator()(const f32x4 (&acc)[2][2][4][2], const Unit& u, int wr, int wc, int fr, int fq) const {
        const int sec = u.pn >> 2, head = u.pn & 3, colh = wc * 32 + 8 * fq;
        h16* base = Q + (size_t)sec * ((size_t)MTOK * DM);
        const float scl = sec == 0 ? 0.0625f : 1.0f;
        const int row0 = u.pm * 256 + wr * 64 + fr;
        if (sec == 2) {
#pragma unroll
            for (int it = 0; it < 8; ++it) {
                const int ai = it >> 2, m = it & 3;
                h16* rowp = base + (size_t)(row0 + ai * 128 + m * 16) * DM + head * 256 + colh;
                *(u32x4*)(rowp) = pack8(acc[ai][0][m][0], acc[ai][0][m][1]);
                *(u32x4*)(rowp + 128) = pack8(acc[ai][1][m][0], acc[ai][1][m][1]);
            }
        } else {
            f32x4 cs[2][4];
#define QKV_LD(it_, st_) do { const int pos_ = (row0 + ((it_) >> 2) * 128 + ((it_) & 3) * 16) & (SEQ - 1); const float* c_ = cosT + pos_ * 128 + colh; const float* s_ = sinT + pos_ * 128 + colh; \
            cs[st_][0] = *(const f32x4*)c_; cs[st_][1] = *(const f32x4*)(c_ + 4); cs[st_][2] = *(const f32x4*)s_; cs[st_][3] = *(const f32x4*)(s_ + 4); } while (0)
            QKV_LD(0, 0);
#pragma unroll
            for (int it = 0; it < 8; ++it) {
                const int ai = it >> 2, m = it & 3, st = it & 1;
                if (it + 1 < 8) QKV_LD(it + 1, st ^ 1);
                __builtin_amdgcn_sched_barrier(0);
                h16* rowp = base + (size_t)(row0 + ai * 128 + m * 16) * DM + head * 256 + colh;
                f32x4 o1[2], o2[2];
#pragma unroll
                for (int n = 0; n < 2; ++n) {
                    const f32x4 c = cs[st][n], sn = cs[st][2 + n];
                    const f32x4 t1 = acc[ai][0][m][n], t2 = acc[ai][1][m][n];
                    o1[n] = (t1 * c - t2 * sn) * scl; o2[n] = (t1 * sn + t2 * c) * scl;
                }
                *(u32x4*)(rowp) = pack8(o1[0], o1[1]);
                *(u32x4*)(rowp + 128) = pack8(o2[0], o2[1]);
            }
#undef QKV_LD
        }
    }
};
struct EpiB {
    static constexpr bool PERM = true, AFTER_DRAIN = false;
    unsigned char* ws;
    DI void operator()(const f32x4 (&acc)[2][2][4][2], const Unit& u, int wr, int wc, int fr, int fq) const {
        const int sec = u.pn >> 2, cs = (u.pn & 3) * 256 + wc * 32 + 8 * fq;
        const size_t boff = sec == 0 ? OFF_RC : (sec == 1 ? OFF_RE : (sec == 2 ? OFF_RA : OFF_RB));
        h16* base = (h16*)(ws + boff);
        const int row0 = u.pm * 256 + wr * 64 + fr;
        u32x4 yv[2][2];
#define EB_LD(it_, st_) do { const int r_ = row0 + ((it_) >> 2) * 128 + ((it_) & 3) * 16; yv[st_][0] = *(const u32x4*)(base + (size_t)r_ * DM + cs); yv[st_][1] = *(const u32x4*)(base + (size_t)r_ * DM + cs + 128); } while (0)
        if (sec == 1) EB_LD(0, 0);
#pragma unroll
        for (int it = 0; it < 8; ++it) {
            const int ai = it >> 2, m = it & 3, st = it & 1;
            if (sec == 1 && it + 1 < 8) EB_LD(it + 1, st ^ 1);
            __builtin_amdgcn_sched_barrier(0);
            const int row = row0 + ai * 128 + m * 16;
#pragma unroll
            for (int bj = 0; bj < 2; ++bj) {
                h16* p = base + (size_t)row * DM + cs + bj * 128;
                if (sec == 0) { const int ch = cs + bj * 128; p = base + ((size_t)((row >> 12) * 64 + (ch >> 4)) * SEQ + (row & (SEQ - 1))) * 16 + (ch & 15); }
                f32x4 v0 = acc[ai][bj][m][0], v1 = acc[ai][bj][m][1];
                if (sec == 1) {
                    const u32x4 y = yv[st][bj];
#pragma unroll
                    for (int e = 0; e < 2; ++e) {
                        const f32x2 ya = unpkh(y[e]), yb = unpkh(y[2 + e]);
                        v0[2 * e] = ya.x * v0[2 * e] * sigmoidf_(v0[2 * e]); v0[2 * e + 1] = ya.y * v0[2 * e + 1] * sigmoidf_(v0[2 * e + 1]);
                        v1[2 * e] = yb.x * v1[2 * e] * sigmoidf_(v1[2 * e]); v1[2 * e + 1] = yb.y * v1[2 * e + 1] * sigmoidf_(v1[2 * e + 1]);
                    }
                } else if (sec >= 2) {
#pragma unroll
                    for (int e = 0; e < 4; ++e) { v0[e] = sigmoidf_(v0[e]); v1[e] = sigmoidf_(v1[e]); }
                }
                *(u32x4*)p = pack8(v0, v1);
            }
        }
#undef EB_LD
    }
};
template <int MODE> struct EpiMerge {
    static constexpr bool PERM = true, AFTER_DRAIN = false;
    h16* T; const h16* G;
    DI void operator()(const f32x4 (&acc)[2][2][4][2], const Unit& u, int wr, int wc, int fr, int fq) const {
        const int cs = u.pn * 256 + wc * 32 + 8 * fq;
        const int row0 = u.pm * 256 + wr * 64 + fr;
        u32x4 gv[2][2], tv[2][2];
#define EM_LD(it_, st_) do { const size_t o_ = (size_t)(row0 + ((it_) >> 2) * 128 + ((it_) & 3) * 16) * DM + cs; gv[st_][0] = *(const u32x4*)(G + o_); gv[st_][1] = *(const u32x4*)(G + o_ + 128); \
        if (MODE == 1) { tv[st_][0] = *(const u32x4*)(T + o_); tv[st_][1] = *(const u32x4*)(T + o_ + 128); } } while (0)
        EM_LD(0, 0);
#pragma unroll
        for (int it = 0; it < 8; ++it) {
            const int ai = it >> 2, m = it & 3, st = it & 1;
            if (it + 1 < 8) EM_LD(it + 1, st ^ 1);
            __builtin_amdgcn_sched_barrier(0);
            const int row = row0 + ai * 128 + m * 16;
#pragma unroll
            for (int bj = 0; bj < 2; ++bj) {
                const size_t o = (size_t)row * DM + cs + bj * 128;
                const u32x4 g = gv[st][bj];
                f32x4 v0 = acc[ai][bj][m][0], v1 = acc[ai][bj][m][1];
#pragma unroll
                for (int e = 0; e < 2; ++e) {
                    const f32x2 ga = unpkh(g[e]), gb = unpkh(g[2 + e]);
                    v0[2 * e] *= ga.x; v0[2 * e + 1] *= ga.y; v1[2 * e] *= gb.x; v1[2 * e + 1] *= gb.y;
                    if (MODE == 1) { const f32x2 ta = unpkh(tv[st][bj][e]), tb = unpkh(tv[st][bj][2 + e]); v0[2 * e] += ta.x; v0[2 * e + 1] += ta.y; v1[2 * e] += tb.x; v1[2 * e + 1] += tb.y; }
                }
                *(u32x4*)(T + o) = pack8(v0, v1);
            }
        }
#undef EM_LD
    }
};
struct EpiRes {
    static constexpr bool PERM = false, AFTER_DRAIN = false;
    const float* xi; float* xo; const float* gate; int rowoff;
    DI void operator()(const f32x4 (&acc)[2][2][4][2], const Unit& u, int wr, int wc, int fr, int fq) const {
        const int c0 = u.pn * 256 + wc * 32 + 4 * fq;
        const int row0 = rowoff + u.pm * 256 + wr * 64 + fr;
        const float* gp = gate + (size_t)((rowoff + u.pm * 256) >> 12) * 6144;
        f32x4 gvv[4], xv[2][4];
#pragma unroll
        for (int q = 0; q < 4; ++q) gvv[q] = *(const f32x4*)(gp + c0 + (q >> 1) * 128 + (q & 1) * 16);
#define ER_LD(it_, st_) do { const float* x_ = xi + (size_t)(row0 + ((it_) >> 2) * 128 + ((it_) & 3) * 16) * DM + c0; \
        xv[st_][0] = *(const f32x4*)x_; xv[st_][1] = *(const f32x4*)(x_ + 16); xv[st_][2] = *(const f32x4*)(x_ + 128); xv[st_][3] = *(const f32x4*)(x_ + 144); } while (0)
        ER_LD(0, 0);
#pragma unroll
        for (int it = 0; it < 8; ++it) {
            const int ai = it >> 2, m = it & 3, st = it & 1;
            if (it + 1 < 8) ER_LD(it + 1, st ^ 1);
            __builtin_amdgcn_sched_barrier(0);
            float* xr = xo + (size_t)(row0 + ai * 128 + m * 16) * DM + c0;
#pragma unroll
            for (int q = 0; q < 4; ++q) *(f32x4*)(xr + (q >> 1) * 128 + (q & 1) * 16) = xv[st][q] + gvv[q] * acc[ai][q >> 1][m][q & 1];
        }
#undef ER_LD
    }
};
DI f32x2 gelu_pk(f32x2 v) {
    const f32x2 av = __builtin_elementwise_abs(v), d = av * 0.2316418882f + 1.0f;
    f32x2 t; t.x = __builtin_amdgcn_rcpf(d.x); t.y = __builtin_amdgcn_rcpf(d.y);
    f32x2 q = t * 0.5307027145f + (-0.7265760135f); q = q * t + 0.7107068705f; q = q * t + (-0.142248368f); q = q * t + 0.127414796f; q = q * t;
    const f32x2 s = (v * v) * (-0.72134752044f);
    f32x2 e; e.x = __builtin_amdgcn_exp2f(s.x); e.y = __builtin_amdgcn_exp2f(s.y);
    const f32x2 m = v * (q * e), r = v - m;
    f32x2 o; o.x = v.x < 0.f ? m.x : r.x; o.y = v.y < 0.f ? m.y : r.y; return o;
}

#define DPP_SHR1(old, v) ((fr == 0) ? (old) : __builtin_bit_cast(float, __builtin_amdgcn_update_dpp(0, __builtin_bit_cast(int, (v)), 0x111, 0xf, 0xf, true)))
#define DPP_SHL1(old, v) ((fr == 15) ? (old) : __builtin_bit_cast(float, __builtin_amdgcn_update_dpp(0, __builtin_bit_cast(int, (v)), 0x101, 0xf, 0xf, true)))
#define DPP_ROR1(v)  __builtin_bit_cast(float, __builtin_amdgcn_update_dpp(0, __builtin_bit_cast(int, (v)), 0x121, 0xf, 0xf, false))
#define DPP_ROR15(v) __builtin_bit_cast(float, __builtin_amdgcn_update_dpp(0, __builtin_bit_cast(int, (v)), 0x12f, 0xf, 0xf, false))
struct EpiUpConv {
    static constexpr bool PERM = true, AFTER_DRAIN = false;
    h16* HID; const float* cw; const float* cb; LAS unsigned char* lds;
    DI void operator()(const f32x4 (&acc)[2][2][4][2], const Unit& u, int wr, int wc, int fr, int fq) const {
        LAS float* xb = (LAS float*)(lds + 131072);
        const int wave = wr * 4 + wc;
#pragma unroll
        for (int ai = 0; ai < 2; ++ai)
#pragma unroll
            for (int bj = 0; bj < 2; ++bj)
#pragma unroll
                for (int n = 0; n < 2; ++n) {
                    if (fr == 0)  *(LAS f32x4*)(xb + ((wave * 2 + ai) * 2 + 0) * 64 + bj * 32 + 8 * fq + 4 * n) = acc[ai][bj][0][n];
                    if (fr == 15) *(LAS f32x4*)(xb + ((wave * 2 + ai) * 2 + 1) * 64 + bj * 32 + 8 * fq + 4 * n) = acc[ai][bj][3][n];
                }
        asm volatile("s_waitcnt lgkmcnt(0)" ::: "memory"); __builtin_amdgcn_s_barrier(); asm volatile("" ::: "memory");
        __builtin_amdgcn_s_barrier(); asm volatile("" ::: "memory");
        const int chl = u.pn * 128 + wc * 32 + 8 * fq;
        const int lane_ = fq * 16 + fr;
        const int srcp = 4 * (fr == 0 ? lane_ + 15 : lane_ - 1), srcn = 4 * (fr == 15 ? lane_ - 15 : lane_ + 1);
#pragma unroll
        for (int n = 0; n < 2; ++n) {
            f32x4 wa[3], wb[3];
#pragma unroll
            for (int i = 0; i < 3; ++i) { wa[i] = *(const f32x4*)(cw + i * 2 * DFF + chl + 4 * n); wb[i] = *(const f32x4*)(cw + i * 2 * DFF + DFF + chl + 4 * n); }
            const f32x4 ba = *(const f32x4*)(cb + chl + 4 * n), bb = *(const f32x4*)(cb + DFF + chl + 4 * n);
#pragma unroll
            for (int ai = 0; ai < 2; ++ai) {
                const int wpv = wr ? wave - 4 : wave + 4, aipv = wr ? ai : 0, ainx = wr ? 1 : ai;
                const f32x4 xpa = *(const LAS f32x4*)(xb + ((wpv * 2 + aipv) * 2 + 1) * 64 + 0 * 32 + 8 * fq + 4 * n), xpb = *(const LAS f32x4*)(xb + ((wpv * 2 + aipv) * 2 + 1) * 64 + 1 * 32 + 8 * fq + 4 * n);
                const f32x4 xna = *(const LAS f32x4*)(xb + ((wpv * 2 + ainx) * 2 + 0) * 64 + 0 * 32 + 8 * fq + 4 * n), xnb = *(const LAS f32x4*)(xb + ((wpv * 2 + ainx) * 2 + 0) * 64 + 1 * 32 + 8 * fq + 4 * n);
#pragma unroll
                for (int m = 0; m < 4; ++m) {
                    __builtin_amdgcn_sched_barrier(0);
                    const int lr = ai * 128 + wr * 64 + m * 16 + fr, gr = u.pm * 254 - 1 + lr, pos = gr & (SEQ - 1);
                    const bool okp = pos != 0, okn = pos != SEQ - 1;
                    f32x2 ga[2], gb[2];
#pragma unroll
                    for (int e = 0; e < 4; ++e) {
                        const float xa = acc[ai][0][m][n][e], xbv = acc[ai][1][m][n][e];
                        const float za = (fr == 15 && m > 0) ? acc[ai][0][m > 0 ? m - 1 : 0][n][e] : xa, zb = (fr == 15 && m > 0) ? acc[ai][1][m > 0 ? m - 1 : 0][n][e] : xbv;
                        const float ya = (fr == 0 && m < 3) ? acc[ai][0][m < 3 ? m + 1 : 3][n][e] : xa, yb = (fr == 0 && m < 3) ? acc[ai][1][m < 3 ? m + 1 : 3][n][e] : xbv;
                        float pa = __builtin_bit_cast(float, __builtin_amdgcn_ds_bpermute(srcp, __builtin_bit_cast(int, za)));
                        float pb = __builtin_bit_cast(float, __builtin_amdgcn_ds_bpermute(srcp, __builtin_bit_cast(int, zb)));
                        float na = __builtin_bit_cast(float, __builtin_amdgcn_ds_bpermute(srcn, __builtin_bit_cast(int, ya)));
                        float nb = __builtin_bit_cast(float, __builtin_amdgcn_ds_bpermute(srcn, __builtin_bit_cast(int, yb)));
                        if (m == 0) { pa = fr == 0 ? xpa[e] : pa; pb = fr == 0 ? xpb[e] : pb; }
                        if (m == 3) { na = fr == 15 ? xna[e] : na; nb = fr == 15 ? xnb[e] : nb; }
                        pa = okp ? pa : 0.f; pb = okp ? pb : 0.f; na = okn ? na : 0.f; nb = okn ? nb : 0.f;
                        const float ca = wa[0][e] * pa + (wa[1][e] * xa + (wa[2][e] * na + ba[e]));
                        const float cbv = wb[0][e] * pb + (wb[1][e] * xbv + (wb[2][e] * nb + bb[e]));
                        if (e & 1) { ga[e >> 1].y = ca; gb[e >> 1].y = cbv; } else { ga[e >> 1].x = ca; gb[e >> 1].x = cbv; }
                    }
                    const f32x2 g0 = gelu_pk(ga[0]), g1 = gelu_pk(ga[1]);
                    u32x2 o; o.x = pkh(g0.x * gb[0].x, g0.y * gb[0].y); o.y = pkh(g1.x * gb[1].x, g1.y * gb[1].y);
                    if (lr >= 1 && lr <= 254 && gr < MTOK) *(u32x2*)(HID + (size_t)gr * DFF + chl + 4 * n) = o;
                }
            }
        }
    }
};

struct EpiStore {
    static constexpr bool PERM = true, AFTER_DRAIN = false;
    h16* O; int ldc;
    DI void operator()(const f32x4 (&acc)[2][2][4][2], const Unit& u, int wr, int wc, int fr, int fq) const {
        const int cs = u.pn * 256 + wc * 32 + 8 * fq;
#pragma unroll
        for (int ai = 0; ai < 2; ++ai)
#pragma unroll
            for (int m = 0; m < 4; ++m) {
                __builtin_amdgcn_sched_barrier(0);
                const int row = u.pm * 256 + ai * 128 + wr * 64 + m * 16 + fr;
#pragma unroll
                for (int bj = 0; bj < 2; ++bj) *(u32x4*)(O + (size_t)row * ldc + cs + bj * 128) = pack8(acc[ai][bj][m][0], acc[ai][bj][m][1]);
            }
    }
};


struct Params {
    const float *x, *c, *n1g, *n2g, *ada_w, *ada_b, *w_in, *w_f, *w_r, *w_o, *w_up, *conv_w, *conv_b, *w_dn, *fin_g;
    float* out; unsigned char* ws;
    float lgf[4], lgb[4];
    int ph0, ph1;
};

constexpr int LDS_BYTES = 160 * 1024;
constexpr int NST = 11;
constexpr int NTHR = 512;

DI void phase_prep(const Params& p, LAS unsigned char* lds) {
    const int tid = ltid();
    LAS float* cact = (LAS float*)lds;
    LAS float* red = (LAS float*)(lds + 32768);
    for (int i = tid; i < 8 * 1024; i += NTHR) { const float v = p.c[i]; cact[i] = v / (1.0f + __expf(-v)); }
    __syncthreads();
    float* MOD = (float*)(p.ws + OFF_MOD);
    for (int it = blockIdx.x; it < 256; it += gridDim.x) {
        const int l = it >> 6, j0 = (it & 63) * 96;
        if (tid < 480) {
            const int col = tid % 96, part = tid / 96, d0 = part * 205, d1 = (d0 + 205 < 1024) ? d0 + 205 : 1024;
            float a[8];
#pragma unroll
            for (int b = 0; b < 8; ++b) a[b] = 0.f;
            const float* wp = p.ada_w + ((size_t)l * 1024) * 6144 + j0 + col;
            for (int d = d0; d < d1; d += 16) {
                float wv_[16];
#pragma unroll
                for (int k = 0; k < 16; ++k) wv_[k] = (d + k < d1) ? wp[(size_t)(d + k) * 6144] : 0.f;
#pragma unroll
                for (int k = 0; k < 16; ++k)
#pragma unroll
                    for (int b = 0; b < 8; ++b) a[b] += cact[b * 1024 + ((d + k < 1024) ? d + k : 1023)] * wv_[k];
            }
#pragma unroll
            for (int b = 0; b < 8; ++b) red[(part * 8 + b) * 96 + col] = a[b];
        }
        __syncthreads();
        for (int i = tid; i < 768; i += NTHR) {
            const int b = i / 96, col = i % 96;
            float s = p.ada_b[l * 6144 + j0 + col];
#pragma unroll
            for (int part = 0; part < 5; ++part) s += red[(part * 8 + b) * 96 + col];
            MOD[((size_t)l * 8 + b) * 6144 + j0 + col] = s;
        }
        __syncthreads();
    }
    {
        h16* DF = (h16*)(p.ws + OFF_W) + W_DF;
        for (int it = blockIdx.x * NTHR + tid; it < 2048 * 128; it += gridDim.x * NTHR) {
            const int kk = it >> 7, ch0 = (it & 127) * 8;
            const int cb = kk >> 5, part = (kk >> 4) & 1, chk = cb * 16 + (kk & 15), g = chk >> 7, c2 = chk & 127;
            float a[8];
#pragma unroll
            for (int e = 0; e < 8; ++e) { const int ch = ch0 + e; const int t = (c2 * (ch & 127) - (part ? 32 : 0)) & 127;
                a[e] = ((ch >> 7) == g) ? __builtin_amdgcn_cosf((float)t * (1.0f / 128.0f)) * 0.08838834764831845f : 0.f; }
            u32x4 ov; ov.x = pkh(a[0], a[1]); ov.y = pkh(a[2], a[3]); ov.z = pkh(a[4], a[5]); ov.w = pkh(a[6], a[7]);
            *(u32x4*)(DF + (size_t)kk * 1024 + ch0) = ov;
        }
    }
    float* cosT = (float*)(p.ws + OFF_COS); float* sinT = (float*)(p.ws + OFF_SIN);
    for (int i = blockIdx.x * NTHR + tid; i < SEQ * 128; i += gridDim.x * NTHR) {
        const int pos = i >> 7, j = i & 127;
        const float invf = exp2f(-(float)j * (13.287712379549449f / 128.0f));
        const float ang = (float)pos * invf;
        const double rev = (double)ang * 0.15915494309189535;
        const float fr = (float)(rev - floor(rev));
        cosT[i] = __builtin_amdgcn_cosf(fr); sinT[i] = __builtin_amdgcn_sinf(fr);
    }
}

DI void transpose_item(const float* W, int K, int ldn, int c0, int ncols, h16* WT, int row_off, LAS float* scr, int item, int lane) {
    const int nblk = ncols / 32, kb = item / nblk, nb = item % nblk, k0 = 64 * kb, n0 = 32 * nb;
    f32x4 v[8];
    const float* src = W + (size_t)(k0 + (lane >> 3)) * ldn + c0 + n0 + 4 * (lane & 7);
#pragma unroll
    for (int i = 0; i < 8; ++i) v[i] = *(const f32x4*)(src + (size_t)(8 * i) * ldn);
#pragma unroll
    for (int i = 0; i < 8; ++i) { LAS float* d = scr + ((lane >> 3) + 8 * i) * 33 + 4 * (lane & 7); d[0] = v[i].x; d[1] = v[i].y; d[2] = v[i].z; d[3] = v[i].w; }
    asm volatile("s_waitcnt lgkmcnt(0)" ::: "memory");
    const int c = lane & 7;
#pragma unroll
    for (int j = 0; j < 4; ++j) { const int n = (lane >> 3) + 8 * j; const LAS float* s = scr + (8 * c) * 33 + n;
        u32x4 o; o.x = pkh(s[0 * 33], s[1 * 33]); o.y = pkh(s[2 * 33], s[3 * 33]); o.z = pkh(s[4 * 33], s[5 * 33]); o.w = pkh(s[6 * 33], s[7 * 33]);
        *(u32x4*)(WT + (size_t)(row_off + n0 + n) * K + k0 + 8 * c) = o; }
    asm volatile("s_waitcnt lgkmcnt(0)" ::: "memory");
}

DI void norm_row(const float* xrow, const float* g, const float* sc, const float* sh, h16* orow, int lane) {
    f32x4 v[4]; float s = 0.f;
#pragma unroll
    for (int j = 0; j < 4; ++j) { v[j] = *((const f32x4*)xrow + lane + 64 * j); s += (v[j].x * v[j].x + v[j].y * v[j].y) + (v[j].z * v[j].z + v[j].w * v[j].w); }
    const float r = rsqrtf(wave_sum(s) * (1.0f / DM) + EPS);
#pragma unroll
    for (int j = 0; j < 4; ++j) {
        const int c = 4 * (lane + 64 * j);
        const f32x4 gv = *(const f32x4*)(g + c), scv = *(const f32x4*)(sc + c), shv = *(const f32x4*)(sh + c);
        const f32x4 y = v[j] * r * gv * (scv + 1.0f) + shv;
        u32x2 o; o.x = pkh(y.x, y.y); o.y = pkh(y.z, y.w);
        *(u32x2*)(orow + c) = o;
    }
}


DI void norm_rows(const float* xs, const float* g, const float* modsc, const float* modsh, h16* H, int gw, int NGW, int lane) {
    f32x4 gv[4];
#pragma unroll
    for (int j = 0; j < 4; ++j) gv[j] = *((const f32x4*)g + lane + 64 * j);
    f32x4 v[2][4], sc[2][4], sh[2][4];
#define NR_LD(row_, st_) do { const float* x_ = xs + (size_t)(row_) * DM; const float* c_ = modsc + (size_t)((row_) >> 12) * 6144; const float* h_ = modsh + (size_t)((row_) >> 12) * 6144; \
    _Pragma("unroll") for (int j = 0; j < 4; ++j) { v[st_][j] = *((const f32x4*)x_ + lane + 64 * j); sc[st_][j] = *((const f32x4*)c_ + lane + 64 * j); sh[st_][j] = *((const f32x4*)h_ + lane + 64 * j); } } while (0)
    if (gw < MTOK) NR_LD(gw, 0);
    int st = 0;
    for (int row = gw; row < MTOK; row += NGW) {
        if (row + NGW < MTOK) { if (st == 0) NR_LD(row + NGW, 1); else NR_LD(row + NGW, 0); }
        float s = 0.f;
        f32x4 w[4], c[4], hh[4];
#pragma unroll
        for (int j = 0; j < 4; ++j) { w[j] = st ? v[1][j] : v[0][j]; c[j] = st ? sc[1][j] : sc[0][j]; hh[j] = st ? sh[1][j] : sh[0][j]; s += (w[j].x * w[j].x + w[j].y * w[j].y) + (w[j].z * w[j].z + w[j].w * w[j].w); }
        const float r = rsqrtf(wave_sum(s) * (1.0f / DM) + EPS);
        h16* orow = H + (size_t)row * DM;
#pragma unroll
        for (int j = 0; j < 4; ++j) {
            const f32x4 y = w[j] * r * gv[j] * (c[j] + 1.0f) + hh[j];
            u32x2 o; o.x = pkh(y.x, y.y); o.y = pkh(y.z, y.w);
            *(u32x2*)(orow + 4 * (lane + 64 * j)) = o;
        }
        st ^= 1;
    }
#undef NR_LD
}
DI void convert_rest(const Params& p, int l, LAS unsigned char* lds, int bix, int nblk, int tid) {
    const int lane = tid & 63, wave = tid >> 6;
    LAS float* scr = (LAS float*)(lds + wave * 8704);
    __syncthreads();
    h16* W = (h16*)(p.ws + OFF_W);
    const int gw = bix * 8 + wave, NGW = nblk * 8;
    constexpr int I2 = 16 * 32, I3 = 16 * 96, I4 = 512, I5 = 512, I6 = 16 * 176, I7 = 44 * 32, ITOT = I2 + I3 + I4 + I5 + I6 + I7;
    const float* win = p.w_in + (size_t)l * DM * DIN;
    for (int it = gw; it < ITOT; it += NGW) {
        int r = it;
        if (r < I2) { transpose_item(win, 1024, DIN, 0, 1024, W + W_B, 0, scr, r, lane); continue; } r -= I2;
        if (r < I3) { transpose_item(win, 1024, DIN, 4096, 3072, W + W_B, 1024, scr, r, lane); continue; } r -= I3;
        if (r < I4) { transpose_item(p.w_r + (size_t)l * DM * DM, 1024, 1024, 0, 1024, W + W_R, 0, scr, r, lane); continue; } r -= I4;
        if (r < I5) { transpose_item(p.w_o + (size_t)l * DM * DM, 1024, 1024, 0, 1024, W + W_O, 0, scr, r, lane); continue; } r -= I5;
        if (r < I6) { const int job = r >> 6, pn_ = job >> 1, bj_ = job & 1;
            transpose_item(p.w_up + (size_t)l * DM * 2 * DFF, 1024, 2 * DFF, bj_ * DFF + pn_ * 128, 128, W + W_UP, pn_ * 256 + bj_ * 128, scr, r & 63, lane); continue; } r -= I6;
        transpose_item(p.w_dn + (size_t)l * DFF * DM, DFF, 1024, 0, 1024, W + W_DN, 0, scr, r, lane);
    }
}
DI void phase_p1(const Params& p, int l, LAS unsigned char* lds) {
    const int tid = ltid(), lane = tid & 63, wave = tid >> 6;
    LAS float* scr = (LAS float*)(lds + wave * 8704);
    h16* W = (h16*)(p.ws + OFF_W);
    const int gw = blockIdx.x * 8 + wave, NGW = gridDim.x * 8;
    const float* win = p.w_in + (size_t)l * DM * DIN;
    for (int it = gw; it < 16 * 96 + 512; it += NGW) {
        if (it < 16 * 96) transpose_item(win, 1024, DIN, 1024, 3072, W + W_QKV, 0, scr, it, lane);
        else transpose_item(p.w_f + (size_t)l * DM * DM, 1024, 1024, 0, 1024, W + W_FT, 0, scr, it - 16 * 96, lane);
    }
    const float* xs = (l == 0) ? p.x : p.out;
    const float* MOD = (const float*)(p.ws + OFF_MOD) + (size_t)l * 8 * 6144;
    h16* H = (h16*)(p.ws + OFF_H);
    norm_rows(xs, p.n1g + l * DM, MOD + 1024, MOD, H, gw, NGW, lane);
}
DI void phase_norm2(const Params& p, int l) {
    const int tid = ltid(), lane = tid & 63, wave = tid >> 6;
    const int gw = blockIdx.x * 8 + wave, NGW = gridDim.x * 8;
    const float* MOD = (const float*)(p.ws + OFF_MOD) + (size_t)l * 8 * 6144;
    h16* H = (h16*)(p.ws + OFF_H);
    norm_rows(p.out, p.n2g + l * DM, MOD + 4096, MOD + 3072, H, gw, NGW, lane);
}
DI void phase_final(const Params& p, LAS unsigned char* lds) {
    const int tid = ltid(), lane = tid & 63, wave = tid >> 6;
    const int gw = blockIdx.x * 8 + wave, NGW = gridDim.x * 8;
    for (int row = gw; row < MTOK; row += NGW) {
        float* xr = p.out + (size_t)row * DM;
        f32x4 v[4]; float s = 0.f;
#pragma unroll
        for (int j = 0; j < 4; ++j) { v[j] = *((const f32x4*)xr + lane + 64 * j); s += (v[j].x * v[j].x + v[j].y * v[j].y) + (v[j].z * v[j].z + v[j].w * v[j].w); }
        const float r = rsqrtf(wave_sum(s) * (1.0f / DM) + EPS);
#pragma unroll
        for (int j = 0; j < 4; ++j) { const f32x4 gv = *((const f32x4*)p.fin_g + lane + 64 * j); f32x4 o = v[j] * r * gv;
            if (TSEL != 0 && (row >> 3) == TBLK) { const float tus = (float)TWORDS(lds)[1] * 0.01f; const float enc = (TSEL == 99) ? 0.1f : 0.02f + 0.13f * fminf(tus / TMAX_US, 1.0f); o = o + enc; }
            *((f32x4*)xr + lane + 64 * j) = o; }
    }
}

DI void fft4(float& ar, float& ai, float& br, float& bi, float& cr, float& ci, float& dr, float& di) {
    const float t0r = ar + cr, t0i = ai + ci, t1r = ar - cr, t1i = ai - ci, t2r = br + dr, t2i = bi + di, t3r = br - dr, t3i = bi - di;
    ar = t0r + t2r; ai = t0i + t2i;
    br = t1r + t3i; bi = t1i - t3r;
    cr = t0r - t2r; ci = t0i - t2i;
    dr = t1r - t3i; di = t1i + t3r;
}
DI void fft16(float (&re)[16], float (&im)[16]) {
#pragma unroll
    for (int n2 = 0; n2 < 4; ++n2) fft4(re[n2], im[n2], re[4 + n2], im[4 + n2], re[8 + n2], im[8 + n2], re[12 + n2], im[12 + n2]);
    constexpr float C1 = 0.9238795325112867f, S1 = 0.3826834323650898f, C2 = 0.7071067811865476f;
#define TWM(idx, wr_, wi_) { const float xr = re[idx], xi = im[idx]; re[idx] = xr * (wr_) - xi * (wi_); im[idx] = xr * (wi_) + xi * (wr_); }
    TWM(5, C1, -S1) TWM(6, C2, -C2) TWM(7, S1, -C1)
    TWM(9, C2, -C2) TWM(10, 0.f, -1.f) TWM(11, -C2, -C2)
    TWM(13, S1, -C1) TWM(14, -C2, -C2) TWM(15, -C1, S1)
#undef TWM
#pragma unroll
    for (int k1 = 0; k1 < 4; ++k1) fft4(re[4 * k1], im[4 * k1], re[4 * k1 + 1], im[4 * k1 + 1], re[4 * k1 + 2], im[4 * k1 + 2], re[4 * k1 + 3], im[4 * k1 + 3]);
}
DI int fsw(int idx) { return idx ^ ((idx >> 4) & 15); }
template <bool TW> DI void fft_stage(LAS unsigned* X, int rb, int rs, const float (&twr)[16], const float (&twi)[16]) {
    float re[16], im[16];
#pragma unroll
    for (int n = 0; n < 16; ++n) { const f32x2 v = unpkh(X[fsw(rb + rs * n)]); re[n] = v.x; im[n] = v.y; }
    fft16(re, im);
#pragma unroll
    for (int k = 0; k < 16; ++k) {
        const int idx = 4 * (k & 3) + (k >> 2);
        float orr, oi;
        if (TW) { orr = re[idx] * twr[k] - im[idx] * twi[k]; oi = re[idx] * twi[k] + im[idx] * twr[k]; }
        else { orr = re[idx] * 0.25f; oi = im[idx] * 0.25f; }
        X[fsw(rb + rs * k)] = pkh(orr, oi);
    }
}
DI void phase_fft(const Params& p, LAS unsigned char* lds) {
    const int tid = ltid(), t = tid & 255, hs = tid >> 8;
    LAS unsigned* X = (LAS unsigned*)lds;
    const h16* UF = (const h16*)(p.ws + OFF_RC);
    h16* PQ = (h16*)(p.ws + OFF_RD);
    float twAr[16], twAi[16], twBr[16], twBi[16];
#pragma unroll
    for (int k = 0; k < 16; ++k) {
        const float fa = (float)(t * k) * (1.0f / 4096.0f), fb = (float)((t & 15) * k) * (1.0f / 256.0f);
        twAr[k] = 0.25f * __builtin_amdgcn_cosf(fa); twAi[k] = -0.25f * __builtin_amdgcn_sinf(fa);
        twBr[k] = 0.25f * __builtin_amdgcn_cosf(fb); twBi[k] = -0.25f * __builtin_amdgcn_sinf(fb);
    }
    for (int it = blockIdx.x; it < 512; it += gridDim.x) {
        const int b = it >> 6, cb = it & 63;
        {
            const h16* ub = UF + ((size_t)(b * 64 + cb) * SEQ) * 16;
#pragma unroll 1
            for (int kb = 0; kb < 16; kb += 8) {
                u32x4 lv[8];
#pragma unroll
                for (int k = 0; k < 8; ++k) lv[k] = *(const u32x4*)(ub + (size_t)(tid + 512 * (kb + k)) * 8);
#pragma unroll
                for (int k = 0; k < 8; ++k) {
                    const int i = tid + 512 * (kb + k), s = i >> 1, hf = i & 1, ss_ = fsw(s);
                    X[(4 * hf + 0) * 4096 + ss_] = lv[k].x; X[(4 * hf + 1) * 4096 + ss_] = lv[k].y; X[(4 * hf + 2) * 4096 + ss_] = lv[k].z; X[(4 * hf + 3) * 4096 + ss_] = lv[k].w;
                }
            }
        }
        __syncthreads();
#pragma unroll 1
        for (int r = 0; r < 4; ++r) fft_stage<true>(X + (2 * r + hs) * 4096, t, 256, twAr, twAi);
        __syncthreads();
#pragma unroll 1
        for (int r = 0; r < 4; ++r) fft_stage<true>(X + (2 * r + hs) * 4096, 256 * (t >> 4) + (t & 15), 16, twBr, twBi);
        __syncthreads();
#pragma unroll 1
        for (int r = 0; r < 4; ++r) fft_stage<false>(X + (2 * r + hs) * 4096, 16 * t, 1, twBr, twBi);
        __syncthreads();
        for (int i = tid; i < 16384; i += NTHR) {
            const int q = i & 3, idx = i >> 2;
            const int kf = (idx >> 8) + 16 * ((idx >> 4) & 15) + 256 * (idx & 15);
            const int km = (4096 - kf) & 4095;
            const int idm = 256 * (km & 15) + 16 * ((km >> 4) & 15) + (km >> 8);
            const int part = q >> 1, sg0 = (q & 1) * 4;
            unsigned o[4];
#pragma unroll
            for (int j = 0; j < 4; ++j) {
                const f32x2 z = unpkh(X[(sg0 + j) * 4096 + fsw(idx)]), zm = unpkh(X[(sg0 + j) * 4096 + fsw(idm)]);
                o[j] = part == 0 ? pkh(0.5f * (z.x + zm.x), 0.5f * (z.y + zm.y)) : pkh(0.5f * (z.y - zm.y), -0.5f * (z.x - zm.x));
            }
            u32x4 ov = {o[0], o[1], o[2], o[3]};
            *(u32x4*)(PQ + ((size_t)(b * SEQ + kf)) * 2048 + cb * 32 + q * 8) = ov;
        }
        __syncthreads();
    }
}

#define MFMA16(a, b, c) __builtin_amdgcn_mfma_f32_16x16x32_f16((a), (b), (c), 0, 0, 0)
DI h16x8 cat4(h16x4 a, h16x4 b) { return __builtin_shufflevector(a, b, 0, 1, 2, 3, 4, 5, 6, 7); }
DI h16x8 packf8(const f32x4& a, const f32x4& b) { const u32x4 w = pack8(a, b); return __builtin_bit_cast(h16x8, w); }
#define TR8I(o, base, O0, O1, O2, O3, O4, O5, O6, O7) \
    asm volatile("ds_read_b64_tr_b16 %0, %8 offset:%9\n\tds_read_b64_tr_b16 %1, %8 offset:%10\n\tds_read_b64_tr_b16 %2, %8 offset:%11\n\tds_read_b64_tr_b16 %3, %8 offset:%12\n\t" \
                 "ds_read_b64_tr_b16 %4, %8 offset:%13\n\tds_read_b64_tr_b16 %5, %8 offset:%14\n\tds_read_b64_tr_b16 %6, %8 offset:%15\n\tds_read_b64_tr_b16 %7, %8 offset:%16" \
                 : "=&v"(o[0]), "=&v"(o[1]), "=&v"(o[2]), "=&v"(o[3]), "=&v"(o[4]), "=&v"(o[5]), "=&v"(o[6]), "=&v"(o[7]) \
                 : "v"(base), "i"(O0), "i"(O1), "i"(O2), "i"(O3), "i"(O4), "i"(O5), "i"(O6), "i"(O7) : "memory")
#define TRWAIT(n, o) asm volatile("s_waitcnt lgkmcnt(" #n ")" : "+v"(o[0]), "+v"(o[1]), "+v"(o[2]), "+v"(o[3]), "+v"(o[4]), "+v"(o[5]), "+v"(o[6]), "+v"(o[7]) :: "memory")

constexpr int SC_OFF = 128 * 544 + 128 * 288 + 1024, SC_STRIDE = 272;
constexpr int SQ_STRIDE = 544, SQQ_STRIDE = 528, SV_STRIDE = 288, SQ_BYTES = 128 * SQ_STRIDE, SV_BYTES = 128 * SV_STRIDE;

#define SBAR() do { asm volatile("s_waitcnt lgkmcnt(0)" ::: "memory"); __builtin_amdgcn_s_barrier(); asm volatile("" ::: "memory"); } while (0)
DI void scan_item(const Params& p, LAS unsigned char* lds, int it, int tid) {
    const int lane = tid & 63, w = __builtin_amdgcn_readfirstlane(tid >> 6), li = lane & 15, g = lane >> 4;
    const h16* Qb = (const h16*)(p.ws + OFF_RA); const h16* Kb = (const h16*)(p.ws + OFF_RB); const h16* Vb = (const h16*)(p.ws + OFF_RC);
    h16* CR = (h16*)(p.ws + OFF_RD);
    const unsigned lbase = (unsigned)(uintptr_t)lds;
    const int b = it >> 4, h = (it >> 2) & 3, dir = (it >> 1) & 1, dvh = it & 1;
    const float lg = dir ? p.lgb[h] : p.lgf[h];
    __syncthreads();
    if (w >= 4) {
        int st = tid - 256; asm volatile("" : "+v"(st));
        u32x4 rqq[16], rqk[16], rv[8];
        const unsigned bigoff = (unsigned)((st >> 5) * DM + (st & 31) * 8), voff = (unsigned)((st >> 4) * DM + (st & 15) * 8);
        LAS unsigned char* const wbig = lds + (st >> 5) * SQ_STRIDE + (st & 31) * 16;
        LAS unsigned char* const wbigq = lds + (st >> 5) * SQQ_STRIDE + (st & 31) * 16;
        LAS unsigned char* const wv = lds + SQ_BYTES + (st >> 4) * SV_STRIDE + (st & 15) * 16;
#define S2_LOADBIG(R, SRC, c_) do { const h16* s_ = (SRC) + ((size_t)b * SEQ + 128 * (c_)) * DM + h * 256; \
        _Pragma("unroll") for (int k_ = 0; k_ < 16; ++k_) R[k_] = *(const u32x4*)(s_ + (size_t)k_ * 8 * DM + bigoff); } while (0)
#define S2_LOADV(c_) do { const h16* s_ = Vb + ((size_t)b * SEQ + 128 * (c_)) * DM + h * 256 + dvh * 128; \
        _Pragma("unroll") for (int k_ = 0; k_ < 8; ++k_) rv[k_] = *(const u32x4*)(s_ + (size_t)k_ * 16 * DM + voff); } while (0)
        S2_LOADBIG(rqq, Qb, dir ? 31 : 0); S2_LOADV(dir ? 31 : 0); S2_LOADBIG(rqk, Kb, dir ? 31 : 0);
        {
            LAS float* dtab = (LAS float*)(lds + SQ_BYTES + SV_BYTES);
            const int j = st & 127;
            dtab[st] = st < 128 ? exp2f(lg * (dir ? (float)(128 - j) : (float)(j + 1))) : exp2f(lg * (dir ? (float)j : (float)(127 - j)));
        }
#pragma unroll 1
        for (int i = 0; i < 32; ++i) {
            const int cn = dir ? 30 - i : i + 1;
#pragma unroll
            for (int k_ = 0; k_ < 16; ++k_) *(LAS u32x4*)(wbigq + k_ * 8 * SQQ_STRIDE) = rqq[k_];
#pragma unroll
            for (int k_ = 0; k_ < 8; ++k_) *(LAS u32x4*)(wv + k_ * 16 * SV_STRIDE) = rv[k_];
            SBAR();
            if (i + 1 < 32) { S2_LOADBIG(rqq, Qb, cn); S2_LOADV(cn); }
            SBAR();
#pragma unroll
            for (int k_ = 0; k_ < 16; ++k_) *(LAS u32x4*)(wbig + k_ * 8 * SQ_STRIDE) = rqk[k_];
            SBAR();
            if (i + 1 < 32) S2_LOADBIG(rqk, Kb, cn);
            {
                const int c = dir ? 31 - i : i;
                h16* crc = CR + (size_t)dir * MTOK * DM + ((size_t)b * SEQ + 128 * c) * DM + h * 256 + dvh * 128;
#pragma unroll
                for (int k_ = 0; k_ < 8; ++k_) { const int pc_ = st + 256 * k_; const u32x4 v_ = *(const LAS u32x4*)(lds + SC_OFF + (pc_ >> 4) * SC_STRIDE + (pc_ & 15) * 16);
                    *(u32x4*)(crc + (size_t)(pc_ >> 4) * DM + (pc_ & 15) * 8) = v_; }
            }
            SBAR();
        }
#undef S2_LOADBIG
#undef S2_LOADV
    } else {
        const float g128 = exp2f(lg * 128.0f);
        f32x4 F[2][16];
#pragma unroll
        for (int nf = 0; nf < 2; ++nf)
#pragma unroll
            for (int i = 0; i < 16; ++i) F[nf][i] = (f32x4){0.f, 0.f, 0.f, 0.f};
#pragma unroll 1
        for (int i = 0; i < 32; ++i) {
            const int c = dir ? 31 - i : i;
            float lgl = lg; int lil = li, gl = g; asm volatile("" : "+v"(lgl), "+v"(lil), "+v"(gl));
            TBEG(4, lds); SBAR(); TEND(4, lds);
            TBEG(2, lds);
#ifndef QREP
#define QREP 1
#endif
#pragma unroll 1
            for (int rr_ = 0; rr_ < QREP; ++rr_) {
                const LAS unsigned char* qr = lds + lil * SQQ_STRIDE + 8 * gl;
#pragma unroll
                for (int hm = 0; hm < 4; ++hm) {
                    f32x4 d[2][2];
#pragma unroll
                    for (int nf = 0; nf < 2; ++nf)
#pragma unroll
                        for (int mf = 0; mf < 2; ++mf) d[nf][mf] = (f32x4){0.f, 0.f, 0.f, 0.f};
#pragma unroll
                    for (int ks = 0; ks < 8; ++ks) {
                        const h16x8 ff0 = packf8(F[0][2 * ks], F[0][2 * ks + 1]), ff1 = packf8(F[1][2 * ks], F[1][2 * ks + 1]);
                        h16x4 q0[2], q1[2];
#pragma unroll
                        for (int mf = 0; mf < 2; ++mf) { q0[mf] = *(const LAS h16x4*)(qr + 16 * (2 * hm + mf) * SQQ_STRIDE + 64 * ks); q1[mf] = *(const LAS h16x4*)(qr + 16 * (2 * hm + mf) * SQQ_STRIDE + 64 * ks + 32); }
#pragma unroll
                        for (int mf = 0; mf < 2; ++mf) { const h16x8 qv = cat4(q0[mf], q1[mf]); d[0][mf] = MFMA16(ff0, qv, d[0][mf]); d[1][mf] = MFMA16(ff1, qv, d[1][mf]); }
                    }
#pragma unroll
                    for (int mf = 0; mf < 2; ++mf) {
                        const int j = 16 * (2 * hm + mf) + lil;
                        const float a = ((const LAS float*)(lds + SQ_BYTES + SV_BYTES))[j];
#pragma unroll
                        for (int nf = 0; nf < 2; ++nf) {
                            u32x2 o; o.x = pkh(d[nf][mf][0] * a, d[nf][mf][1] * a); o.y = pkh(d[nf][mf][2] * a, d[nf][mf][3] * a);
                            *(LAS u32x2*)(lds + SC_OFF + j * SC_STRIDE + (32 * w + 16 * nf + 4 * gl) * 2) = o;
                        }
                    }
                    __builtin_amdgcn_sched_barrier(0);
                }
            }
            TEND(2, lds);
            TBEG(5, lds); SBAR();
            SBAR(); TEND(5, lds);
            TBEG(3, lds);
            {
#pragma unroll
                for (int nf = 0; nf < 2; ++nf)
#pragma unroll
                    for (int fm = 0; fm < 16; ++fm) F[nf][fm] *= g128;
                const unsigned kb = lbase + (4 * gl + (lil >> 2)) * SQ_STRIDE + (lil & 3) * 8;
                const unsigned vb = lbase + SQ_BYTES + (4 * gl + (lil >> 2)) * SV_STRIDE + (32 * w + (lil & 3) * 4) * 2;
#define S2_KOFF(ks2, f4, q, hi) ((ks2) * 32 * SQ_STRIDE + (4 * (f4) + (q)) * 32 + (hi) * 16 * SQ_STRIDE)
#define S2_ISSUE(buf, ks2, f4) TR8I(buf, kb, S2_KOFF(ks2, f4, 0, 0), S2_KOFF(ks2, f4, 0, 1), S2_KOFF(ks2, f4, 1, 0), S2_KOFF(ks2, f4, 1, 1), S2_KOFF(ks2, f4, 2, 0), S2_KOFF(ks2, f4, 2, 1), S2_KOFF(ks2, f4, 3, 0), S2_KOFF(ks2, f4, 3, 1))
#define S2_MMA(buf, f4) do { _Pragma("unroll") for (int q_ = 0; q_ < 4; ++q_) { const h16x8 kf_ = cat4(buf[2 * q_], buf[2 * q_ + 1]); \
                F[0][4 * (f4) + q_] = MFMA16(kf_, vf0, F[0][4 * (f4) + q_]); F[1][4 * (f4) + q_] = MFMA16(kf_, vf1, F[1][4 * (f4) + q_]); } } while (0)
#pragma unroll
                for (int ks2 = 0; ks2 < 4; ++ks2) {
                    h16x4 kA[8], kB[8];
                    h16x8 vf0, vf1;
                    const LAS float* bt_ = (const LAS float*)(lds + SQ_BYTES + SV_BYTES) + 128 + 32 * ks2 + 4 * gl;
                    const f32x4 b0_ = *(const LAS f32x4*)bt_, b1_ = *(const LAS f32x4*)(bt_ + 16);
                    asm volatile("s_waitcnt lgkmcnt(0)" ::: "memory");
                    {
                        h16x4 vt[8];
                        TR8I(vt, vb, ks2 * 32 * SV_STRIDE, ks2 * 32 * SV_STRIDE + 16 * SV_STRIDE, ks2 * 32 * SV_STRIDE + 32, ks2 * 32 * SV_STRIDE + 16 * SV_STRIDE + 32,
                                     ks2 * 32 * SV_STRIDE, ks2 * 32 * SV_STRIDE + 16 * SV_STRIDE, ks2 * 32 * SV_STRIDE + 32, ks2 * 32 * SV_STRIDE + 16 * SV_STRIDE + 32);
                        S2_ISSUE(kA, ks2, 0);
                        TRWAIT(8, vt);
                        vf0 = cat4(vt[0], vt[1]); vf1 = cat4(vt[2], vt[3]);
#pragma unroll
                        for (int e = 0; e < 8; ++e) {
                            const float bj = e < 4 ? b0_[e & 3] : b1_[e & 3];
                            vf0[e] = (h16)((float)vf0[e] * bj); vf1[e] = (h16)((float)vf1[e] * bj);
                        }
                    }
                    S2_ISSUE(kB, ks2, 1); TRWAIT(8, kA); S2_MMA(kA, 0);
                    S2_ISSUE(kA, ks2, 2); TRWAIT(8, kB); S2_MMA(kB, 1);
                    S2_ISSUE(kB, ks2, 3); TRWAIT(8, kA); S2_MMA(kA, 2);
                    TRWAIT(0, kB); S2_MMA(kB, 3);
                    __builtin_amdgcn_sched_barrier(0);
                }
#undef S2_KOFF
#undef S2_ISSUE
#undef S2_MMA
            }
            TEND(3, lds);
            TBEG(6, lds); SBAR(); TEND(6, lds);
        }
    }
    __syncthreads();
}

constexpr int CH_K_STRIDE = 528, CH_V_STRIDE = 544, CH_K_BYTES = 128 * CH_K_STRIDE;
DI void intra_item(const Params& p, LAS unsigned char* lds, int it, int tid) {
    const int lane = tid & 63, w = tid >> 6, li = lane & 15, g = lane >> 4;
    const h16* Qb = (const h16*)(p.ws + OFF_RA); const h16* Kb = (const h16*)(p.ws + OFF_RB); const h16* Vb = (const h16*)(p.ws + OFF_RC);
    h16* YR = (h16*)(p.ws + OFF_RE);
    const unsigned lbase = (unsigned)(uintptr_t)lds;
    const int b = it >> 7, h = (it >> 5) & 3, c = it & 31;
    const size_t row0 = (size_t)b * SEQ + 128 * c;
    const float lgf = p.lgf[h], lgb = p.lgb[h];
    __syncthreads();
    {
        const h16* ks = Kb + row0 * DM + h * 256; const h16* vs = Vb + row0 * DM + h * 256;
        u32x4 r[8];
#pragma unroll
        for (int k = 0; k < 8; ++k) { const int pc = tid + 512 * k; r[k] = *(const u32x4*)(ks + (size_t)(pc >> 5) * DM + (pc & 31) * 8); }
#pragma unroll
        for (int k = 0; k < 8; ++k) { const int pc = tid + 512 * k; *(LAS u32x4*)(lds + (pc >> 5) * CH_K_STRIDE + (pc & 31) * 16) = r[k]; }
#pragma unroll
        for (int k = 0; k < 8; ++k) { const int pc = tid + 512 * k; r[k] = *(const u32x4*)(vs + (size_t)(pc >> 5) * DM + (pc & 31) * 8); }
#pragma unroll
        for (int k = 0; k < 8; ++k) { const int pc = tid + 512 * k; *(LAS u32x4*)(lds + CH_K_BYTES + (pc >> 5) * CH_V_STRIDE + (pc & 31) * 16) = r[k]; }
    }
    const int jabs = 16 * w + li;
    const size_t prow = row0 + jabs;
    h16x8 qf[8];
#pragma unroll
    for (int ks = 0; ks < 8; ++ks) qf[ks] = *(const h16x8*)(Qb + prow * DM + h * 256 + 32 * ks + 8 * g);
    __syncthreads();
    h16x8 pf[4];
#pragma unroll
    for (int mf2 = 0; mf2 < 4; ++mf2) {
        f32x4 s2[2];
#pragma unroll
        for (int hh = 0; hh < 2; ++hh) {
            const int mf = 2 * mf2 + hh;
            f32x4 s = (f32x4){0.f, 0.f, 0.f, 0.f};
            const LAS unsigned char* kr = lds + (16 * mf + li) * CH_K_STRIDE + 16 * g;
#pragma unroll
            for (int ks = 0; ks < 8; ++ks) s = MFMA16(*(const LAS h16x8*)(kr + 64 * ks), qf[ks], s);
#pragma unroll
            for (int r = 0; r < 4; ++r) {
                const int m = 16 * mf + 4 * g + r, df = jabs - m;
                const float dec = df >= 0 ? exp2f(lgf * (float)df) : exp2f(lgb * (float)(-df));
                s[r] *= dec;
            }
            s2[hh] = s;
        }
        pf[mf2] = packf8(s2[0], s2[1]);
    }
    const unsigned vb = lbase + CH_K_BYTES + (4 * g + (li >> 2)) * CH_V_STRIDE + (li & 3) * 8;
    h16* yo = YR + prow * DM + h * 256 + 4 * g;
#define IN_ISSUE(buf, df) TR8I(buf, vb, (df) * 32 + 0 * 32 * CH_V_STRIDE, (df) * 32 + 0 * 32 * CH_V_STRIDE + 16 * CH_V_STRIDE, (df) * 32 + 1 * 32 * CH_V_STRIDE, (df) * 32 + 1 * 32 * CH_V_STRIDE + 16 * CH_V_STRIDE, \
                                       (df) * 32 + 2 * 32 * CH_V_STRIDE, (df) * 32 + 2 * 32 * CH_V_STRIDE + 16 * CH_V_STRIDE, (df) * 32 + 3 * 32 * CH_V_STRIDE, (df) * 32 + 3 * 32 * CH_V_STRIDE + 16 * CH_V_STRIDE)
#define IN_MMA(buf, df) do { f32x4 o_ = (f32x4){0.f, 0.f, 0.f, 0.f}; _Pragma("unroll") for (int ks_ = 0; ks_ < 4; ++ks_) o_ = MFMA16(cat4(buf[2 * ks_], buf[2 * ks_ + 1]), pf[ks_], o_); \
        u32x2 ov_; ov_.x = pkh(o_[0], o_[1]); ov_.y = pkh(o_[2], o_[3]); *(u32x2*)(yo + 16 * (df)) = ov_; } while (0)
    h16x4 vA[8], vB[8];
    IN_ISSUE(vA, 0);
#pragma unroll
    for (int df = 0; df < 16; df += 2) {
        IN_ISSUE(vB, df + 1);
        TRWAIT(8, vA);
        IN_MMA(vA, df);
        if (df + 2 < 16) { IN_ISSUE(vA, df + 2); TRWAIT(8, vB); } else { TRWAIT(0, vB); }
        IN_MMA(vB, df + 1);
    }
#undef IN_ISSUE
#undef IN_MMA
}

DI void phase_mix(const Params& p, int l, LAS unsigned char* lds) {
    const int tid = ltid();
    const int nb = (int)gridDim.x, bid = (int)blockIdx.x;
    const bool std = nb == 256;
#ifndef MIXPART
#define MIXPART 7
#endif
#ifndef SCANREP
#define SCANREP 1
#endif
#ifndef INTRAREP
#define INTRAREP 1
#endif
    if (MIXPART & 1) for (int r_ = 0; r_ < SCANREP; ++r_) for (int it = bid; it < 128; it += nb) { TBEG(1, lds); scan_item(p, lds, it, tid); TEND(1, lds); }
    TBEG(8, lds);
    if ((MIXPART & 2) && (!std || bid >= 128)) {
        convert_rest(p, l, lds, std ? bid - 128 : bid, std ? 128 : nb, tid);
        __syncthreads();
        h16* W = (h16*)(p.ws + OFF_W);
        pg8::Gemm gg; gg.A = W + W_FT; gg.Bt = W + W_DF; gg.M = 1024; gg.N = 2048; gg.K = 1024; gg.a_rows = 256;
        pg8::StaticOrder S; S.init(1024, 2048, std ? 128 : nb, std ? bid - 128 : bid);
        EpiStore E; E.O = W + W_F2; E.ldc = 2048;
        pg8::gemm_phase<EpiStore, pg8::StaticOrder, false, GEMM_ALIGN, GEMM_SP2>(lds, gg, S, E, nullptr);
    }
    TEND(8, lds);
    __syncthreads();
    int i0, cnt, stride;
    if (std) { if (bid < 128) { i0 = 0; cnt = 0; } else { i0 = (bid - 128) * 8; cnt = 8; } stride = 1; }
    else { i0 = bid; cnt = (1024 - bid + nb - 1) / nb; stride = nb; }
    TBEG(7, lds);
    if (MIXPART & 4) for (int r_ = 0; r_ < INTRAREP; ++r_) for (int k = 0; k < cnt; ++k) intra_item(p, lds, i0 + k * stride, tid);
    TEND(7, lds);
}

DI void phase_partB(const Params& p) {
    const int tid = ltid(), lane = tid & 63, wave = tid >> 6;
    const int gw = blockIdx.x * 8 + wave, NGW = gridDim.x * 8;
    h16* YR = (h16*)(p.ws + OFF_RE); const h16* CR = (const h16*)(p.ws + OFF_RD);
    u32x4 ld[2][6];
#define PB_LD(row_, st_) do { const size_t o_ = (size_t)(row_) * DM + lane * 16; ld[st_][0] = *(const u32x4*)(YR + o_); ld[st_][1] = *(const u32x4*)(YR + o_ + 8); ld[st_][2] = *(const u32x4*)(CR + o_); ld[st_][3] = *(const u32x4*)(CR + o_ + 8); \
        ld[st_][4] = *(const u32x4*)(CR + (size_t)MTOK * DM + o_); ld[st_][5] = *(const u32x4*)(CR + (size_t)MTOK * DM + o_ + 8); } while (0)
    if (gw < MTOK) PB_LD(gw, 0);
    int st = 0;
    for (int row = gw; row < MTOK; row += NGW) {
        if (row + NGW < MTOK) { if (st == 0) PB_LD(row + NGW, 1); else PB_LD(row + NGW, 0); }
        const size_t o = (size_t)row * DM + lane * 16;
        float v[16];
#pragma unroll
        for (int hh = 0; hh < 2; ++hh) {
            const u32x4 a = st ? ld[1][hh] : ld[0][hh], c0 = st ? ld[1][2 + hh] : ld[0][2 + hh], c1 = st ? ld[1][4 + hh] : ld[0][4 + hh];
#pragma unroll
            for (int e = 0; e < 4; ++e) { const f32x2 x = unpkh(a[e]), y = unpkh(c0[e]), z = unpkh(c1[e]); v[8 * hh + 2 * e] = x.x + y.x + z.x; v[8 * hh + 2 * e + 1] = x.y + y.y + z.y; }
        }
        st ^= 1;
        float s = 0.f;
#pragma unroll
        for (int e = 0; e < 16; ++e) s += v[e];
        s += __shfl_xor(s, 1); s += __shfl_xor(s, 2); s += __shfl_xor(s, 4); s += __shfl_xor(s, 8);
        const float mu = s * (1.0f / 256.0f);
        float q2 = 0.f;
#pragma unroll
        for (int e = 0; e < 16; ++e) { v[e] -= mu; q2 += v[e] * v[e]; }
        q2 += __shfl_xor(q2, 1); q2 += __shfl_xor(q2, 2); q2 += __shfl_xor(q2, 4); q2 += __shfl_xor(q2, 8);
        const float rs = rsqrtf(q2 * (1.0f / 256.0f) + EPS);
#pragma unroll
        for (int hh = 0; hh < 2; ++hh) {
            u32x4 ov;
#pragma unroll
            for (int e = 0; e < 4; ++e) ov[e] = pkh(v[8 * hh + 2 * e] * rs, v[8 * hh + 2 * e + 1] * rs);
            *(u32x4*)(YR + o + 8 * hh) = ov;
        }
    }
}

DI h16x2 u2h(unsigned u) { return __builtin_bit_cast(h16x2, u); }
DI void phase_conv(const Params& p, int l, int half) {
    const h16* U = (const h16*)(p.ws + OFF_RA); h16* HID = (h16*)(p.ws + OFF_RD);
    const float* cw = p.conv_w + (size_t)l * 3 * 2 * DFF; const float* cbias = p.conv_b + (size_t)l * 2 * DFF;
    constexpr int RB = 8, NCG = DFF / 8, NU = (MTOK / 2 / RB) * NCG;
    const int tid = ltid();
    for (int un = blockIdx.x * NTHR + tid; un < NU; un += gridDim.x * NTHR) {
        const int rb = un / NCG, cg_ = un - rb * NCG, r0 = rb * RB, n0 = cg_ * 8;
        const int pos0 = r0 & (SEQ - 1);
        const h16* ur = U + (size_t)r0 * (2 * DFF) + n0;
        u32x4 ra[RB + 2], rbv[RB + 2];
        const bool okp = pos0 != 0, okn = (pos0 + RB) < SEQ;
#pragma unroll
        for (int r = 0; r < RB + 2; ++r) {
            const bool ok = (r == 0) ? okp : ((r == RB + 1) ? okn : true);
            ra[r] = (u32x4){0u, 0u, 0u, 0u}; rbv[r] = (u32x4){0u, 0u, 0u, 0u};
            if (ok) { ra[r] = *(const u32x4*)(ur + (ptrdiff_t)(r - 1) * (2 * DFF)); rbv[r] = *(const u32x4*)(ur + (ptrdiff_t)(r - 1) * (2 * DFF) + DFF); }
        }
        h16x2 wa[3][4], wb[3][4], ba[4], bb[4];
#pragma unroll
        for (int i = 0; i < 3; ++i)
#pragma unroll
            for (int e = 0; e < 2; ++e) {
                const f32x4 x = *(const f32x4*)(cw + i * 2 * DFF + n0 + 4 * e), y = *(const f32x4*)(cw + i * 2 * DFF + DFF + n0 + 4 * e);
                wa[i][2 * e] = (h16x2){(h16)x.x, (h16)x.y}; wa[i][2 * e + 1] = (h16x2){(h16)x.z, (h16)x.w};
                wb[i][2 * e] = (h16x2){(h16)y.x, (h16)y.y}; wb[i][2 * e + 1] = (h16x2){(h16)y.z, (h16)y.w};
            }
#pragma unroll
        for (int e = 0; e < 2; ++e) {
            const f32x4 x = *(const f32x4*)(cbias + n0 + 4 * e), y = *(const f32x4*)(cbias + DFF + n0 + 4 * e);
            ba[2 * e] = (h16x2){(h16)x.x, (h16)x.y}; ba[2 * e + 1] = (h16x2){(h16)x.z, (h16)x.w};
            bb[2 * e] = (h16x2){(h16)y.x, (h16)y.y}; bb[2 * e + 1] = (h16x2){(h16)y.z, (h16)y.w};
        }
#pragma unroll
        for (int r = 0; r < RB; ++r) {
            u32x4 ov;
#pragma unroll
            for (int e = 0; e < 4; ++e) {
                const h16x2 av = wa[0][e] * u2h(ra[r][e]) + (wa[1][e] * u2h(ra[r + 1][e]) + (wa[2][e] * u2h(ra[r + 2][e]) + ba[e]));
                const h16x2 bv = wb[0][e] * u2h(rbv[r][e]) + (wb[1][e] * u2h(rbv[r + 1][e]) + (wb[2][e] * u2h(rbv[r + 2][e]) + bb[e]));
                const f32x2 gl = gelu_pk((f32x2){(float)av.x, (float)av.y});
                ov[e] = pkh(gl.x * (float)bv.x, gl.y * (float)bv.y);
            }
            *(u32x4*)(HID + (size_t)(r0 + r) * DFF + n0) = ov;
        }
    }
}

template <class Epi> DI void run_gemm(LAS unsigned char* lds, const h16* A, const h16* Bt, int M, int N, int K, const Epi& E) {
    pg8::Gemm g; g.A = A; g.Bt = Bt; g.M = M; g.N = N; g.K = K; g.a_rows = 256;
    pg8::StaticOrder S; S.init(M, N, (int)gridDim.x, (int)blockIdx.x);
    pg8::gemm_phase<Epi, pg8::StaticOrder, false, GEMM_ALIGN, GEMM_SP2>(lds, g, S, E, nullptr);
}

DI void run_phase(const Params& p, int ph, LAS unsigned char* lds) {
    unsigned char* ws = p.ws;
    h16* W = (h16*)(ws + OFF_W); h16* H = (h16*)(ws + OFF_H);
    h16* RA = (h16*)(ws + OFF_RA); h16* RB = (h16*)(ws + OFF_RB); h16* RC = (h16*)(ws + OFF_RC); h16* RD = (h16*)(ws + OFF_RD); h16* RE = (h16*)(ws + OFF_RE);
#ifndef PHMASK
#define PHMASK 0xFFFFF
#endif
#define PHON(k) ((PHMASK >> (k)) & 1)
    if (ph == 0) { if (PHON(16)) phase_prep(p, lds); return; }
    if (ph == 1 + NST * NLAYER) { if (PHON(17)) phase_final(p, lds); return; }
    const int l = (ph - 1) / NST, st = (ph - 1) % NST;
    const float* MODl = (const float*)(ws + OFF_MOD) + (size_t)l * 8 * 6144;
    switch (st) {
    case 0: if (PHON(0)) phase_p1(p, l, lds); break;
    case 1: if (PHON(1)) { EpiQKV E; E.Q = RA; E.cosT = (const float*)(ws + OFF_COS); E.sinT = (const float*)(ws + OFF_SIN); run_gemm(lds, H, W + W_QKV, MTOK, 3072, 1024, E); } break;
    case 2: if (PHON(2)) phase_mix(p, l, lds); break;
    case 3: if (PHON(3)) phase_partB(p); break;
    case 4: if (PHON(4)) { EpiB E; E.ws = ws; run_gemm(lds, H, W + W_B, MTOK, 4096, 1024, E); } break;
    case 5: if (PHON(5)) phase_fft(p, lds); break;
    case 6: if (PHON(6)) {
        { EpiMerge<0> E; E.T = RC; E.G = RA; run_gemm(lds, RD, W + W_F2, MTOK, 1024, 2048, E); }
        asm volatile("s_waitcnt vmcnt(0)" ::: "memory"); __syncthreads();
        { EpiMerge<1> E; E.T = RC; E.G = RB; run_gemm(lds, RE, W + W_R, MTOK, 1024, 1024, E); } } break;
    case 7: if (PHON(8)) { EpiRes E; E.xi = (l == 0) ? p.x : p.out; E.xo = p.out; E.gate = MODl + 2048; E.rowoff = 0; run_gemm(lds, RC, W + W_O, MTOK, 1024, 1024, E); } break;
    case 8: if (PHON(9)) phase_norm2(p, l); break;
    case 9: if (PHON(10)) {
        EpiUpConv E; E.HID = RD; E.cw = p.conv_w + (size_t)l * 3 * 2 * DFF; E.cb = p.conv_b + (size_t)l * 2 * DFF; E.lds = lds;
        pg8::Gemm g; g.A = H - DM; g.Bt = W + W_UP; g.M = 130 * 256; g.N = 2 * DFF; g.K = 1024; g.a_rows = 254;
        pg8::StaticOrder S; S.init(130 * 256, 2 * DFF, (int)gridDim.x, (int)blockIdx.x);
        pg8::gemm_phase<EpiUpConv, pg8::StaticOrder, false, GEMM_ALIGN, GEMM_SP2>(lds, g, S, E, nullptr); } break;
    case 10: if (PHON(12)) { EpiRes E; E.xi = p.out; E.xo = p.out; E.gate = MODl + 5120; E.rowoff = 0; run_gemm(lds, RD, W + W_DN, MTOK, 1024, DFF, E); } break;
    }
}


#define XB_TMO      128
#define XB_XCNT(j)  (256  + 64 * (j))
#define XB_XSUB(j)  (1280 + 64 * (j))
#define XB_XGEN(j)  (2304 + 64 * (j))
#define XB_TOP      3328
#define XB_TOPGEN   3392
#define XCD_BAR_WORDS 3456
#define XB_SPIN_CAP (1u << 18)
DI unsigned xb_ld(unsigned* p)              { return __hip_atomic_load(p, __ATOMIC_RELAXED, __HIP_MEMORY_SCOPE_AGENT); }
DI unsigned xb_add(unsigned* p, unsigned v) { return __hip_atomic_fetch_add(p, v, __ATOMIC_RELAXED, __HIP_MEMORY_SCOPE_AGENT); }
DI unsigned xb_xcc_id() { return (unsigned)__builtin_amdgcn_s_getreg((3 << 11) | 20) & 0xFu; }
#define XB_SPIN(cond, bar) do { unsigned _sp = 0; while (cond) { __builtin_amdgcn_s_sleep(1); \
    if ((++_sp & 255u) == 0u) { if (xb_ld(&(bar)[XB_TMO])) break; if (_sp > XB_SPIN_CAP) { atomicAdd(&(bar)[XB_TMO], 1u); break; } } } } while (0)
DI void xcd_barrier_complete(unsigned* bar, unsigned x, unsigned& nloc, unsigned& nx) {
    const unsigned G = gridDim.x;
    unsigned sum, cnt, mine, sp = 0u;
    for (;;) {
        sum = 0u; cnt = 0u; mine = 0u;
#pragma unroll
        for (unsigned j = 0; j < 16; ++j) { const unsigned c = xb_ld(&bar[XB_XCNT(j)]); sum += c; cnt += (c > 0u) ? 1u : 0u; mine = (j == x) ? c : mine; }
        if (sum == G) break;
        __builtin_amdgcn_s_sleep(1);
        if ((++sp & 255u) == 0u) { if (xb_ld(&bar[XB_TMO])) break; if (sp > XB_SPIN_CAP) { atomicAdd(&bar[XB_TMO], 1u); break; } }
    }
    nloc = mine > 0u ? mine : 1u; nx = cnt > 0u ? cnt : 1u;
}
DI void xcd_barrier(unsigned* bar, unsigned x, volatile LAS unsigned* st) {
    asm volatile("s_waitcnt vmcnt(0)" ::: "memory");
    __syncthreads();
    if (threadIdx.x == 0) {
        __builtin_amdgcn_s_waitcnt(0);
        unsigned nloc = st[0], nx = st[1];
        if (nloc == 0u) { xcd_barrier_complete(bar, x, nloc, nx); st[0] = nloc; st[1] = nx; }
        const unsigned old = xb_add(&bar[XB_XSUB(x)], 1u);
        const unsigned gen = old / nloc;
        if (old + 1u == (gen + 1u) * nloc) {
            __builtin_amdgcn_fence(__ATOMIC_RELEASE, "agent");
            asm volatile("s_waitcnt vmcnt(0)" ::: "memory");
            const unsigned og = xb_add(&bar[XB_TOP], 1u);
            const unsigned tg = og / nx;
            if (og + 1u == (tg + 1u) * nx) xb_add(&bar[XB_TOPGEN], 1u);
            else XB_SPIN(xb_ld(&bar[XB_TOPGEN]) == tg, bar);
            __builtin_amdgcn_fence(__ATOMIC_ACQUIRE, "agent");
            xb_add(&bar[XB_XGEN(x)], 1u);
            asm volatile("s_waitcnt vmcnt(0)" ::: "memory");
        } else {
            XB_SPIN(xb_ld(&bar[XB_XGEN(x)]) == gen, bar);
            __builtin_amdgcn_fence(__ATOMIC_ACQUIRE, "agent");
            asm volatile("s_waitcnt vmcnt(0)" ::: "memory");
        }
    }
    __syncthreads();
}
#define LIGHT_BARRIER() do { \
                ++nbar; \
                asm volatile("s_waitcnt vmcnt(0)" ::: "memory");       \
                __syncthreads(); \
                if (threadIdx.x == 0) { \
                    __builtin_amdgcn_fence(__ATOMIC_RELEASE, "agent");   \
                    asm volatile("s_waitcnt vmcnt(0)" ::: "memory"); \
                    __hip_atomic_fetch_add(bar, 1u, __ATOMIC_RELAXED, __HIP_MEMORY_SCOPE_AGENT); \
                    const unsigned target = nbar * gridDim.x; \
                    const unsigned long long t0 = __builtin_amdgcn_s_memrealtime(); \
                    while (__hip_atomic_load(bar, __ATOMIC_RELAXED, __HIP_MEMORY_SCOPE_AGENT) < target) { \
                        __builtin_amdgcn_s_sleep(1); \
                        if (__builtin_amdgcn_s_memrealtime() - t0 > 20000000ull) break;      \
                    } \
                    __builtin_amdgcn_fence(__ATOMIC_ACQUIRE, "agent");   \
                    asm volatile("s_waitcnt vmcnt(0)" ::: "memory"); \
                } \
                __syncthreads(); \
             \
} while (0)
template <class T> DI T* launder(T* p) {
    unsigned lo = (unsigned)(uintptr_t)p, hi = (unsigned)((uintptr_t)p >> 32);
    asm volatile("" : "+v"(lo), "+v"(hi));
    lo = __builtin_amdgcn_readfirstlane(lo); hi = __builtin_amdgcn_readfirstlane(hi);
    return (T*)(((uintptr_t)hi << 32) | (uintptr_t)lo);
}
__global__ void __launch_bounds__(512, 2) fwd_megakernel(Params p) {
    extern __shared__ __attribute__((aligned(16))) unsigned char smem[];
    LAS unsigned char* lds = (LAS unsigned char*)smem;
    cg::grid_group grid = cg::this_grid();
    if (TSEL != 0 && threadIdx.x == 0) { TWORDS(lds)[0] = 0ull; TWORDS(lds)[1] = 0ull; }
    volatile LAS unsigned* xst = (volatile LAS unsigned*)(lds + 163840 - 64);
    const unsigned xcc = xb_xcc_id();
    if (threadIdx.x == 0) { xst[0] = 0u; xst[1] = 0u; (void)xb_add(&((unsigned*)(p.ws + OFF_BAR))[XB_XCNT(xcc)], 1u); }
    __syncthreads();
#ifndef REPMASK
#define REPMASK 0
#endif
    int rep = 0; unsigned nbar = 0;
    unsigned* bar = (unsigned*)(p.ws + OFF_BAR);
    for (int ph = p.ph0; ph < p.ph1;) {
        run_phase(p, ph, lds);
        const bool again = REPMASK != 0 && rep == 0 && ph >= 1 && ph < 1 + NST * NLAYER && ((REPMASK >> ((ph - 1) % NST)) & 1);
        if (again) rep = 1; else { rep = 0; ++ph; }
        if (ph < p.ph1) {
            if (ph == 1 && rep == 0) grid.sync();
            else {
                xcd_barrier(bar, xcc, xst);
            }
#ifdef EXTRASYNC
            LIGHT_BARRIER(); LIGHT_BARRIER();
#endif
        }
    }
}

extern "C" void kernel_launch(void* const* d_in, const int* in_sizes, int n_in, void* d_out, int out_size, void* d_ws, size_t ws_size, hipStream_t stream) {
    static int grid = 0;
    if (grid == 0) {
        int dev = 0, cus = 0, per_cu = 0;
        hipGetDevice(&dev);
        hipDeviceGetAttribute(&cus, hipDeviceAttributeMultiprocessorCount, dev);
        if (hipFuncSetAttribute((const void*)fwd_megakernel, hipFuncAttributeMaxDynamicSharedMemorySize, LDS_BYTES) != hipSuccess) fprintf(stderr, "kernel_launch: hipFuncSetAttribute failed\n");
        hipOccupancyMaxActiveBlocksPerMultiprocessor(&per_cu, (const void*)fwd_megakernel, NTHR, LDS_BYTES);
        if (per_cu < 1) { fprintf(stderr, "kernel_launch: occupancy query says %d blocks per CU\n", per_cu); per_cu = 1; }
        (void)hipGetLastError();
        grid = cus * 1;
        if (ws_size < WS_END) fprintf(stderr, "kernel_launch: workspace too small: %zu < %zu\n", ws_size, (size_t)WS_END);
        fprintf(stderr, "kernel_launch: grid %d (cus %d, per_cu %d), ws %zu need %zu\n", grid, cus, per_cu, ws_size, (size_t)WS_END);
    }
    Params p{};
    const float* const* in = (const float* const*)d_in;
    p.x = in[0]; p.c = in[1]; p.n1g = in[2]; p.n2g = in[3]; p.ada_w = in[4]; p.ada_b = in[5]; p.w_in = in[6]; p.w_f = in[7]; p.w_r = in[8]; p.w_o = in[9];
    p.w_up = in[10]; p.conv_w = in[11]; p.conv_b = in[12]; p.w_dn = in[13]; p.fin_g = in[14];
    p.out = (float*)d_out; p.ws = (unsigned char*)d_ws;
    for (int h = 0; h < 4; ++h) {
        p.lgf[h] = (float)(std::log1p(-std::exp2(-5.0 - h)) / std::log(2.0));
        p.lgb[h] = (float)(std::log1p(-std::exp2(-5.5 - h)) / std::log(2.0));
    }
    constexpr int NPH = 2 + NST * NLAYER;
#if MULTI_LAUNCH
    for (int ph = 0; ph < NPH; ++ph) {
        p.ph0 = ph; p.ph1 = ph + 1;
        hipLaunchKernelGGL(fwd_megakernel, dim3(grid), dim3(NTHR), LDS_BYTES, stream, p);
    }
#else
    p.ph0 = 0; p.ph1 = NPH;
    (void)hipMemsetAsync((unsigned char*)d_ws + OFF_BAR, 0, 16384, stream);
    void* args[] = {&p};
    hipError_t e = hipLaunchCooperativeKernel((const void*)fwd_megakernel, dim3(grid), dim3(NTHR), args, LDS_BYTES, stream);
    if (e != hipSuccess) fprintf(stderr, "cooperative launch failed: %s (grid %d)\n", hipGetErrorString(e), grid);
#endif
}
```
